# Optimizing an MI355X kernel written in HIP

```python
import math
import jax, jax.numpy as jnp
from jax import lax
import numpy as np

D_MODEL = 1024
BATCH = 1
SEQ = 16384
DEPTH = 1
DEC_BATCH = 128
DEC_SEQ = 8
PAST_LEN = 16384
PAGE_SIZE = 128

N_Q_HEADS = 8
N_KV_HEADS = 2
HEAD_DIM = 64
Q_PER_KV = N_Q_HEADS // N_KV_HEADS
ATTN_WIDTH = N_Q_HEADS * HEAD_DIM
KV_WIDTH = N_KV_HEADS * HEAD_DIM
WINDOW = 128
ROPE_THETA = 10000.0
SSM_WIDTH = D_MODEL // 2
SSM_GROUP = 16
N_SSM_GROUPS = SSM_WIDTH // SSM_GROUP
SSM_STATE = 64
DT_MIN = 0.001
DT_MAX = 0.1
N_MEM = 256
N_X_HEADS = 4
X_HEAD_DIM = D_MODEL // N_X_HEADS
D_FF = 2816
RMS_EPS = 1e-6
NEG_INF = -1e30
IN_SPLITS = (ATTN_WIDTH, KV_WIDTH, KV_WIDTH, SSM_WIDTH, D_MODEL, D_MODEL)
IN_WIDTH = sum(IN_SPLITS)

kernel_name = 'hybrid_swa_sink_s5_macaron_decoder_step'


def rms_norm(x, g):
    xf = x.astype(jnp.float32)
    y = xf * lax.rsqrt(jnp.mean(xf * xf, axis=-1, keepdims=True) + RMS_EPS) * g.astype(jnp.float32)
    return y.astype(x.dtype)


def swiglu_ffn(h, w_in, w_out):
    a, b = jnp.split(h @ w_in, 2, axis=-1)
    return (jax.nn.silu(a) * b) @ w_out


def rope(x, pos):
    half = HEAD_DIM // 2
    inv = ROPE_THETA ** (-jnp.arange(half, dtype=jnp.float32) / half)
    ang = pos[:, None] * inv[None, :]
    cos = jnp.cos(ang)[None, :, None, :]
    sin = jnp.sin(ang)[None, :, None, :]
    xf = x.astype(jnp.float32)
    x1, x2 = xf[..., :half], xf[..., half:]
    return jnp.concatenate([x1 * cos - x2 * sin, x2 * cos + x1 * sin], axis=-1).astype(x.dtype)


def band_window_attention(q, k_ctx, v_ctx, k_cur, v_cur, ctx_valid, sinks):
    l = q.shape[1]
    k = jnp.concatenate([k_ctx, k_cur], axis=1)
    v = jnp.concatenate([v_ctx, v_cur], axis=1)
    s = jnp.einsum('nqhgd,nkhd->nhgqk', q, k).astype(jnp.float32) * (HEAD_DIM ** -0.5)
    r = jnp.arange(l)[:, None]
    c = jnp.arange(WINDOW + l)[None, :]
    band = (c >= r) & (c <= WINDOW + r)
    avail = (c >= WINDOW) | ctx_valid[:, None, None]
    mask = (band[None] & avail)[:, None, None]
    s = jnp.where(mask, s, NEG_INF)
    sink = sinks.astype(jnp.float32).reshape(1, N_KV_HEADS, Q_PER_KV, 1, 1)
    m = jnp.maximum(jnp.max(s, axis=-1, keepdims=True), sink)
    p = jnp.exp(s - m)
    p = p / (jnp.sum(p, axis=-1, keepdims=True) + jnp.exp(sink - m))
    return jnp.einsum('nhgqk,nkhd->nqhgd', p.astype(v.dtype), v)


def _complex_linear_combine(e1, e2):
    a1r, a1i, b1r, b1i = e1
    a2r, a2i, b2r, b2i = e2
    return (a2r * a1r - a2i * a1i,
            a2r * a1i + a2i * a1r,
            a2r * b1r - a2i * b1i + b2r,
            a2r * b1i + a2i * b1r + b2i)


def s5_scan(u, h0_re, h0_im, a_re, a_im, log_dt, b_re, b_im, c_re, c_im, d_skip):
    f32 = jnp.float32
    a_re = a_re.astype(f32)
    a_im = a_im.astype(f32)
    dt = jnp.exp(log_dt.astype(f32))[:, None]
    mag = jnp.exp(a_re * dt)
    lb_re = mag * jnp.cos(a_im * dt)
    lb_im = mag * jnp.sin(a_im * dt)
    den = a_re * a_re + a_im * a_im
    nr = lb_re - 1.0
    ni = lb_im
    k_re = (nr * a_re + ni * a_im) / den
    k_im = (ni * a_re - nr * a_im) / den
    b_re = b_re.astype(f32)
    b_im = b_im.astype(f32)
    bb_re = k_re[..., None] * b_re - k_im[..., None] * b_im
    bb_im = k_re[..., None] * b_im + k_im[..., None] * b_re
    x_re = jnp.einsum('btgc,gnc->btgn', u, bb_re)
    x_im = jnp.einsum('btgc,gnc->btgn', u, bb_im)
    x_re = x_re.at[:, 0].add(lb_re * h0_re - lb_im * h0_im)
    x_im = x_im.at[:, 0].add(lb_re * h0_im + lb_im * h0_re)
    a_r = jnp.broadcast_to(lb_re, x_re.shape)
    a_i = jnp.broadcast_to(lb_im, x_re.shape)
    _, _, h_re, h_im = lax.associative_scan(_complex_linear_combine, (a_r, a_i, x_re, x_im), axis=1)
    y = (jnp.einsum('btgn,gcn->btgc', h_re, c_re.astype(f32))
         - jnp.einsum('btgn,gcn->btgc', h_im, c_im.astype(f32))
         + d_skip.astype(f32).reshape(N_SSM_GROUPS, SSM_GROUP) * u)
    return y, h_re[:, -1], h_im[:, -1]


def token_mixing(h, offset, ctx_k, ctx_v, h0_re, h0_im, lp):
    bt, t = h.shape[0], h.shape[1]
    cuts = [int(c) for c in np.cumsum(IN_SPLITS)[:-1]]
    q, k, v, u, gate_a, gate_b = jnp.split(h @ lp['w_in'], cuts, axis=-1)
    pos = jnp.arange(t, dtype=jnp.float32) + offset
    q = rope(q.reshape(bt, t, N_Q_HEADS, HEAD_DIM), pos)
    k = rope(k.reshape(bt, t, N_KV_HEADS, HEAD_DIM), pos)
    v = v.reshape(bt, t, N_KV_HEADS, HEAD_DIM)
    sinks = lp['attn_sinks']
    if ctx_k is None:
        nb = t // WINDOW
        qb = q.reshape(bt * nb, WINDOW, N_KV_HEADS, Q_PER_KV, HEAD_DIM)
        kb = k.reshape(bt, nb, WINDOW, N_KV_HEADS, HEAD_DIM)
        vb = v.reshape(bt, nb, WINDOW, N_KV_HEADS, HEAD_DIM)
        k_prev = jnp.concatenate([jnp.zeros_like(kb[:, :1]), kb[:, :-1]], axis=1)
        v_prev = jnp.concatenate([jnp.zeros_like(vb[:, :1]), vb[:, :-1]], axis=1)
        flat = (bt * nb, WINDOW, N_KV_HEADS, HEAD_DIM)
        valid = jnp.tile(jnp.arange(nb) > 0, bt)
        o = band_window_attention(qb, k_prev.reshape(flat), v_prev.reshape(flat),
                                  kb.reshape(flat), vb.reshape(flat), valid, sinks)
        new_k = k[:, -WINDOW:]
        new_v = v[:, -WINDOW:]
    else:
        qs = q.reshape(bt, t, N_KV_HEADS, Q_PER_KV, HEAD_DIM)
        ctx_k = ctx_k.astype(k.dtype)
        ctx_v = ctx_v.astype(v.dtype)
        o = band_window_attention(qs, ctx_k, ctx_v, k, v, jnp.ones((bt,), dtype=bool), sinks)
        new_k = jnp.concatenate([ctx_k, k], axis=1)[:, -WINDOW:]
        new_v = jnp.concatenate([ctx_v, v], axis=1)[:, -WINDOW:]
    y_a = o.reshape(bt, t, ATTN_WIDTH) @ lp['w_attn_up']
    if h0_re is None:
        h0_re = jnp.zeros((bt, N_SSM_GROUPS, SSM_STATE), jnp.float32)
        h0_im = jnp.zeros((bt, N_SSM_GROUPS, SSM_STATE), jnp.float32)
    y_ssm, h_re, h_im = s5_scan(u.reshape(bt, t, N_SSM_GROUPS, SSM_GROUP).astype(jnp.float32),
                                h0_re.astype(jnp.float32), h0_im.astype(jnp.float32),
                                lp['ssm_a_re'], lp['ssm_a_im'], lp['ssm_log_dt'],
                                lp['ssm_b_re'], lp['ssm_b_im'], lp['ssm_c_re'], lp['ssm_c_im'], lp['ssm_d'])
    z = jax.nn.gelu(y_ssm.reshape(bt, t, SSM_WIDTH)).astype(h.dtype)
    glu_a, glu_b = jnp.split(z @ lp['w_ssm_glu'], 2, axis=-1)
    y_b = glu_a * jax.nn.sigmoid(glu_b)
    merged = jax.nn.sigmoid(gate_a) * y_a + jax.nn.sigmoid(gate_b) * y_b
    return merged @ lp['w_out'], new_k, new_v, h_re, h_im


def memory_kv(mem, g_mem, w_xk, w_xv):
    bt, nm = mem.shape[0], mem.shape[1]
    mn = rms_norm(mem, g_mem)
    mk = (mn @ w_xk).reshape(bt, nm, N_X_HEADS, X_HEAD_DIM)
    mv = (mn @ w_xv).reshape(bt, nm, N_X_HEADS, X_HEAD_DIM)
    return mk, mv


def cross_attention(h, mem_k, mem_v, w_xq, w_xo):
    bt, t = h.shape[0], h.shape[1]
    q = (h @ w_xq).reshape(bt, t, N_X_HEADS, X_HEAD_DIM)
    s = jnp.einsum('bqhd,bkhd->bhqk', q, mem_k.astype(q.dtype)).astype(jnp.float32) * (X_HEAD_DIM ** -0.5)
    p = jax.nn.softmax(s, axis=-1).astype(q.dtype)
    o = jnp.einsum('bhqk,bkhd->bqhd', p, mem_v.astype(q.dtype)).reshape(bt, t, D_MODEL)
    return o @ w_xo


def decoder_layer(x, offset, ctx_k, ctx_v, h0_re, h0_im, mem_k, mem_v, lp):
    x = x + 0.5 * swiglu_ffn(rms_norm(x, lp['g_ffn1']), lp['w_ffn1_in'], lp['w_ffn1_out'])
    mix, new_k, new_v, h_re, h_im = token_mixing(rms_norm(x, lp['g_mix']), offset, ctx_k, ctx_v, h0_re, h0_im, lp)
    x = x + mix
    x = x + cross_attention(rms_norm(x, lp['g_xattn']), mem_k, mem_v, lp['w_xq'], lp['w_xo'])
    x = x + 0.5 * swiglu_ffn(rms_norm(x, lp['g_ffn2']), lp['w_ffn2_in'], lp['w_ffn2_out'])
    return x, new_k, new_v, h_re, h_im


def _normal(k, shape, scale):
    return jax.random.normal(k, shape, jnp.float32) * scale


def _gain(k, shape):
    return 1.0 + 0.02 * jax.random.normal(k, shape, jnp.float32)


def setup_inputs(seed: int = 0) -> dict:
    key = jax.random.key(seed)
    ks = iter(jax.random.split(key, 48))
    L = DEPTH
    G, N, GS = N_SSM_GROUPS, SSM_STATE, SSM_GROUP
    a_re = -0.5 * jnp.exp(0.05 * jax.random.normal(next(ks), (L, G, N), jnp.float32))
    a_im = math.pi * jnp.arange(N, dtype=jnp.float32)[None, None, :] + 0.05 * jax.random.normal(next(ks), (L, G, N), jnp.float32)
    log_dt = jax.random.uniform(next(ks), (L, G), jnp.float32, minval=math.log(DT_MIN), maxval=math.log(DT_MAX))
    return {
        'x_prompt': _normal(next(ks), (BATCH, SEQ, D_MODEL), 1.0),
        'x_sample': _normal(next(ks), (DEC_BATCH, DEC_SEQ, D_MODEL), 1.0),
        'cache_win_k': _normal(next(ks), (L, DEC_BATCH, WINDOW, N_KV_HEADS, HEAD_DIM), 1.0),
        'cache_win_v': _normal(next(ks), (L, DEC_BATCH, WINDOW, N_KV_HEADS, HEAD_DIM), 1.0),
        'state_ssm_re': _normal(next(ks), (L, DEC_BATCH, G, N), 0.3),
        'state_ssm_im': _normal(next(ks), (L, DEC_BATCH, G, N), 0.3),
        'cache_mem_k': _normal(next(ks), (L, DEC_BATCH, N_MEM, N_X_HEADS, X_HEAD_DIM), 1.0),
        'cache_mem_v': _normal(next(ks), (L, DEC_BATCH, N_MEM, N_X_HEADS, X_HEAD_DIM), 1.0),
        'mem_prompt': _normal(next(ks), (BATCH, N_MEM, D_MODEL), 1.0),
        'g_ffn1': _gain(next(ks), (L, D_MODEL)),
        'w_ffn1_in': _normal(next(ks), (L, D_MODEL, 2 * D_FF), D_MODEL ** -0.5),
        'w_ffn1_out': _normal(next(ks), (L, D_FF, D_MODEL), D_FF ** -0.5),
        'g_mix': _gain(next(ks), (L, D_MODEL)),
        'w_in': _normal(next(ks), (L, D_MODEL, IN_WIDTH), D_MODEL ** -0.5),
        'attn_sinks': _normal(next(ks), (L, N_Q_HEADS), 0.5),
        'ssm_a_re': a_re,
        'ssm_a_im': a_im,
        'ssm_log_dt': log_dt,
        'ssm_b_re': _normal(next(ks), (L, G, N, GS), (2 * GS) ** -0.5),
        'ssm_b_im': _normal(next(ks), (L, G, N, GS), (2 * GS) ** -0.5),
        'ssm_c_re': _normal(next(ks), (L, G, GS, N), N ** -0.5),
        'ssm_c_im': _normal(next(ks), (L, G, GS, N), N ** -0.5),
        'ssm_d': _normal(next(ks), (L, SSM_WIDTH), 1.0),
        'w_attn_up': _normal(next(ks), (L, ATTN_WIDTH, D_MODEL), ATTN_WIDTH ** -0.5),
        'w_ssm_glu': _normal(next(ks), (L, SSM_WIDTH, 2 * D_MODEL), SSM_WIDTH ** -0.5),
        'w_out': _normal(next(ks), (L, D_MODEL, D_MODEL), D_MODEL ** -0.5),
        'g_xattn': _gain(next(ks), (L, D_MODEL)),
        'g_mem': _gain(next(ks), (L, D_MODEL)),
        'w_xq': _normal(next(ks), (L, D_MODEL, D_MODEL), D_MODEL ** -0.5),
        'w_xk': _normal(next(ks), (L, D_MODEL, D_MODEL), D_MODEL ** -0.5),
        'w_xv': _normal(next(ks), (L, D_MODEL, D_MODEL), D_MODEL ** -0.5),
        'w_xo': _normal(next(ks), (L, D_MODEL, D_MODEL), D_MODEL ** -0.5),
        'g_ffn2': _gain(next(ks), (L, D_MODEL)),
        'w_ffn2_in': _normal(next(ks), (L, D_MODEL, 2 * D_FF), D_MODEL ** -0.5),
        'w_ffn2_out': _normal(next(ks), (L, D_FF, D_MODEL), D_FF ** -0.5),
        'g_final': _gain(next(ks), (D_MODEL,)),
    }


def reference(x_prompt, x_sample, cache_win_k, cache_win_v, state_ssm_re, state_ssm_im,
              cache_mem_k, cache_mem_v, mem_prompt,
              g_ffn1, w_ffn1_in, w_ffn1_out, g_mix, w_in, attn_sinks,
              ssm_a_re, ssm_a_im, ssm_log_dt, ssm_b_re, ssm_b_im, ssm_c_re, ssm_c_im, ssm_d,
              w_attn_up, w_ssm_glu, w_out, g_xattn, g_mem, w_xq, w_xk, w_xv, w_xo,
              g_ffn2, w_ffn2_in, w_ffn2_out, g_final):
    xp = x_prompt
    xs = x_sample
    wk_p, wv_p, sr_p, si_p, mk_p, mv_p = [], [], [], [], [], []
    wk_s, wv_s, sr_s, si_s = [], [], [], []
    for l in range(DEPTH):
        lp = dict(g_ffn1=g_ffn1[l], w_ffn1_in=w_ffn1_in[l], w_ffn1_out=w_ffn1_out[l],
                  g_mix=g_mix[l], w_in=w_in[l], attn_sinks=attn_sinks[l],
                  ssm_a_re=ssm_a_re[l], ssm_a_im=ssm_a_im[l], ssm_log_dt=ssm_log_dt[l],
                  ssm_b_re=ssm_b_re[l], ssm_b_im=ssm_b_im[l], ssm_c_re=ssm_c_re[l], ssm_c_im=ssm_c_im[l],
                  ssm_d=ssm_d[l], w_attn_up=w_attn_up[l], w_ssm_glu=w_ssm_glu[l], w_out=w_out[l],
                  g_xattn=g_xattn[l], w_xq=w_xq[l], w_xo=w_xo[l],
                  g_ffn2=g_ffn2[l], w_ffn2_in=w_ffn2_in[l], w_ffn2_out=w_ffn2_out[l])
        mem_k_p, mem_v_p = memory_kv(mem_prompt, g_mem[l], w_xk[l], w_xv[l])
        xp, nk, nv, hr, hi = decoder_layer(xp, 0, None, None, None, None, mem_k_p, mem_v_p, lp)
        wk_p.append(nk); wv_p.append(nv); sr_p.append(hr); si_p.append(hi)
        mk_p.append(mem_k_p); mv_p.append(mem_v_p)
        xs, nk, nv, hr, hi = decoder_layer(xs, PAST_LEN, cache_win_k[l], cache_win_v[l],
                                           state_ssm_re[l], state_ssm_im[l],
                                           cache_mem_k[l], cache_mem_v[l], lp)
        wk_s.append(nk); wv_s.append(nv); sr_s.append(hr); si_s.append(hi)
    y_prompt = rms_norm(xp, g_final)
    y_sample = rms_norm(xs, g_final)
    return (y_prompt, y_sample,
            jnp.stack(wk_p), jnp.stack(wv_p), jnp.stack(sr_p), jnp.stack(si_p),
            jnp.stack(mk_p), jnp.stack(mv_p),
            jnp.stack(wk_s), jnp.stack(wv_s), jnp.stack(sr_s), jnp.stack(si_s))
```

```cpp
#include <hip/hip_runtime.h>
#include <hip/hip_cooperative_groups.h>
#include <cstdio>
#include <cstring>
namespace cg = cooperative_groups;

#define LAS __attribute__((address_space(3)))
typedef unsigned short bf16_t;
typedef short bf16x8 __attribute__((ext_vector_type(8)));
typedef float f32x4 __attribute__((ext_vector_type(4)));
typedef unsigned u32x4 __attribute__((ext_vector_type(4)));
typedef unsigned u32x2 __attribute__((ext_vector_type(2)));
typedef float f32x2 __attribute__((ext_vector_type(2)));

constexpr int MT = 17408, MP = 16384, DM = 1024, DFF = 2816;
constexpr int SBS = 192;
constexpr int KROWS = 16384 + 128 * SBS + 64;
constexpr int LDS_BYTES = 131072 + 16;

constexpr size_t OFF_Y = 0, OFF_WKP = 17825792, OFF_WVP = 17842176, OFF_SRP = 17858560, OFF_SIP = 17860608,
                 OFF_MKP = 17862656, OFF_MVP = 18124800, OFF_WKS = 18386944, OFF_WVS = 20484096, OFF_SRS = 22581248, OFF_SIS = 22843392;

struct Params {
    const float *x_prompt, *x_sample, *cache_win_k, *cache_win_v, *state_re, *state_im, *cache_mem_k, *cache_mem_v, *mem_prompt;
    const float *g_ffn1, *w_ffn1_in, *w_ffn1_out, *g_mix, *w_in, *sinks, *a_re, *a_im, *log_dt, *b_re, *b_im, *c_re, *c_im, *ssm_d;
    const float *w_attn_up, *w_ssm_glu, *w_out, *g_xattn, *g_mem, *w_xq, *w_xk, *w_xv, *w_xo, *g_ffn2, *w_ffn2_in, *w_ffn2_out, *g_final;
    float* out;
    bf16_t *Wt1, *Wt2, *Wt3, *Wt4, *Wt5, *Wt6, *Wt7, *Wtkv, *Wt8, *Wt9, *Wt10;
    bf16_t *XB, *ACT, *Q, *Kb, *Vt, *SG, *O, *Z, *MERGED, *XQ, *XO, *MEMB, *MK, *MVt;
    float *X, *U, *TMP, *rowss, *rope, *ssmtab, *Schunk, *Carry;
    unsigned* bar;
};

typedef const __attribute__((address_space(4))) Params* PP;
__device__ __forceinline__ PP get_pp() { PP p = (PP)__builtin_amdgcn_kernarg_segment_ptr(); asm volatile("" : "+s"(p)); return p; }
typedef __bf16 bf16v2 __attribute__((ext_vector_type(2)));
typedef float f32v2 __attribute__((ext_vector_type(2)));
__device__ __forceinline__ unsigned cvt_pk_bf16(float lo, float hi) { const f32v2 v = {lo, hi}; const bf16v2 b = __builtin_convertvector(v, bf16v2); return __builtin_bit_cast(unsigned, b); }
__device__ __forceinline__ float sigm(float x) { return __builtin_amdgcn_rcpf(1.0f + __expf(-x)); }
__device__ __forceinline__ float rstd_of(float ss) { return rsqrtf(ss * (1.0f / 1024.0f) + 1e-6f); }
__device__ __forceinline__ int opaque_tid() { int t = threadIdx.x; asm volatile("" : "+v"(t)); return t; }
#define XB_TMO      128
#define XB_XCNT(j)  (256  + 64 * (j))
#define XB_XSUB(j)  (1280 + 64 * (j))
#define XB_XGEN(j)  (2304 + 64 * (j))
#define XB_TOP      3328
#define XB_TOPGEN   3392
#define XCD_BAR_WORDS 3456
#define XB_SPIN_CAP (1u << 18)
__device__ __forceinline__ unsigned xb_ld(unsigned* p)              { return __hip_atomic_load(p, __ATOMIC_RELAXED, __HIP_MEMORY_SCOPE_AGENT); }
__device__ __forceinline__ unsigned xb_add(unsigned* p, unsigned v) { return __hip_atomic_fetch_add(p, v, __ATOMIC_RELAXED, __HIP_MEMORY_SCOPE_AGENT); }
__device__ __forceinline__ unsigned xb_xcc_id() { return (unsigned)__builtin_amdgcn_s_getreg((3 << 11) | 20) & 0xFu; }
#define XB_SPIN(cond, bar) do { unsigned _sp = 0; while (cond) { __builtin_amdgcn_s_sleep(1); \
    if ((++_sp & 255u) == 0u) { if (xb_ld(&(bar)[XB_TMO])) break; if (_sp > XB_SPIN_CAP) { atomicAdd(&(bar)[XB_TMO], 1u); break; } } } } while (0)
__device__ __forceinline__ void xcd_barrier_complete(unsigned* bar, unsigned x, unsigned& nloc, unsigned& nx) {
    const unsigned G = gridDim.x * gridDim.y * gridDim.z;
    unsigned sum, cnt, mine, sp = 0u;
    for (;;) {
        sum = 0u; cnt = 0u; mine = 0u;
#pragma unroll
        for (unsigned j = 0; j < 16; ++j) { const unsigned c = xb_ld(&bar[XB_XCNT(j)]); sum += c; cnt += (c > 0u) ? 1u : 0u; mine = (j == x) ? c : mine; }
        if (sum == G) break;
        __builtin_amdgcn_s_sleep(1);
        if ((++sp & 255u) == 0u) { if (xb_ld(&bar[XB_TMO])) break; if (sp > XB_SPIN_CAP) { atomicAdd(&bar[XB_TMO], 1u); break; } }
    }
    nloc = mine > 0u ? mine : 1u; nx = cnt > 0u ? cnt : 1u;
}
__device__ __forceinline__ void xcd_barrier(unsigned* bar, volatile LAS unsigned* st) {
    asm volatile("s_waitcnt vmcnt(0)" ::: "memory");
    __syncthreads();
    if (threadIdx.x == 0) {
        const unsigned x = xb_xcc_id();
        __builtin_amdgcn_s_waitcnt(0);
        unsigned nloc = st[0], nx = st[1];
        if (nloc == 0u) { xcd_barrier_complete(bar, x, nloc, nx); st[0] = nloc; st[1] = nx; }
        const unsigned old = xb_add(&bar[XB_XSUB(x)], 1u);
        const unsigned gen = old / nloc;
        if (old + 1u == (gen + 1u) * nloc) {
            __builtin_amdgcn_fence(__ATOMIC_RELEASE, "agent");
            asm volatile("s_waitcnt vmcnt(0)" ::: "memory");
            const unsigned og = xb_add(&bar[XB_TOP], 1u);
            const unsigned tg = og / nx;
            if (og + 1u == (tg + 1u) * nx) xb_add(&bar[XB_TOPGEN], 1u);
            else XB_SPIN(xb_ld(&bar[XB_TOPGEN]) == tg, bar);
            __builtin_amdgcn_fence(__ATOMIC_ACQUIRE, "agent");
            xb_add(&bar[XB_XGEN(x)], 1u);
            asm volatile("s_waitcnt vmcnt(0)" ::: "memory");
        } else {
            XB_SPIN(xb_ld(&bar[XB_XGEN(x)]) == gen, bar);
            __builtin_amdgcn_fence(__ATOMIC_ACQUIRE, "agent");
            asm volatile("s_waitcnt vmcnt(0)" ::: "memory");
        }
    }
    __syncthreads();
}
#define GSYNC() xcd_barrier(get_pp()->bar, (volatile LAS unsigned*)(lds + 131072))
__device__ __forceinline__ void wave_lds_sync() { asm volatile("s_waitcnt lgkmcnt(0)" ::: "memory"); __builtin_amdgcn_wave_barrier(); }

namespace pg8 {
constexpr int BM = 256, BK = 64, HALF = 128, HTB = HALF * BK * 2, NXCD = 8, WGM = 8;
__device__ __forceinline__ int lds_byte(int r, int c) { const int st = (r >> 4) * 2 + (c >> 5), rr = r & 15, cc = c & 31, ob = rr * 64 + cc * 2; return st * 1024 + (ob ^ (((ob >> 9) & 1) << 5)); }
__device__ __forceinline__ void stage_rc(int b, int& R, int& C) { const int st = b / 1024, sb = b % 1024, swz = sb ^ (((sb >> 9) & 1) << 5); R = (st >> 1) * 16 + swz / 64; C = (st & 1) * 32 + (swz % 64) / 2; }
struct Unit { int pm, pn; };
struct Gemm { const bf16_t* A; const bf16_t* Bt; int M, N, K; };
struct StaticOrder {
    int nM, nN, nwg, G, c;
    __device__ void init(int M, int N, int G_, int c_) { nM = M / BM; nN = N / BM; nwg = nM * nN; G = G_; c = c_; }
    __device__ bool next(int i, Unit& u) const {
        const long L = (long)i * G + c; if (L >= nwg) return false;
        int wgid = (int)L; { const int q = nwg / NXCD, r = nwg % NXCD, xcd = wgid % NXCD, off = wgid / NXCD; wgid = (xcd < r ? xcd * (q + 1) : r * (q + 1) + (xcd - r) * q) + off; }
        const int nig = WGM * nN, gid = wgid / nig, fm = gid * WGM, gsz = (nM - fm) < WGM ? (nM - fm) : WGM;
        u.pm = fm + ((wgid % nig) % gsz); u.pn = (wgid % nig) / gsz; return true;
    }
};

template <class Epi, class Sched>
__device__ __forceinline__ void gemm_phase(LAS unsigned char* lds, const Gemm g, const Sched& S, const Epi& E) {
    const int tid = opaque_tid(), wid = __builtin_amdgcn_readfirstlane(tid >> 6), lane = tid & 63, wr = wid >> 2, wc = wid & 3, fr = lane & 15, fq = lane >> 4;
    const int K = g.K, nt = K / BK;
    unsigned voffA[2];
#pragma unroll
    for (int i = 0; i < 2; ++i) { int R, C; stage_rc(tid * 16 + i * 8192, R, C); voffA[i] = (unsigned)(R * K + C) * 2u; }
    const size_t kstep = (size_t)(BK * 2);
    const size_t hstep = (size_t)HALF * K * 2;
    const size_t tstep = 2 * hstep;
    const unsigned ldsw = (unsigned)wid * 1024u;
    const int aoff = lds_byte(wr * 64 + fr, fq * 8), boff = lds_byte(wc * 32 + fr, fq * 8);
#define PG8_SA(b, h) (((b) * 2 + (h)) * HTB)
#define PG8_SB(b, h) ((4 + (b) * 2 + (h)) * HTB)
#define PG8_STAGE(bufoff, gbase) do { _Pragma("unroll") for (int _i = 0; _i < 2; ++_i) \
        __builtin_amdgcn_global_load_lds((const unsigned*)((const char*)(gbase) + voffA[_i]), (LAS unsigned*)(lds + (bufoff) + ldsw + _i * 8192), 16, 0, 0); } while (0)
#define PG8_LDA(dst, b, h) do { _Pragma("unroll") for (int m = 0; m < 4; ++m) _Pragma("unroll") for (int k = 0; k < 2; ++k) dst[m][k] = *(const LAS bf16x8*)(lds + PG8_SA(b, h) + aoff + m * 2048 + k * 1024); } while (0)
#define PG8_LDB(dst, b, h) do { _Pragma("unroll") for (int n = 0; n < 2; ++n) _Pragma("unroll") for (int k = 0; k < 2; ++k) dst[n][k] = *(const LAS bf16x8*)(lds + PG8_SB(b, h) + boff + n * 2048 + k * 1024); } while (0)
#define PG8_MMA(ai, bj, At, Bt) do { __builtin_amdgcn_s_setprio(1); _Pragma("unroll") for (int m = 0; m < 4; ++m) _Pragma("unroll") for (int n = 0; n < 2; ++n) _Pragma("unroll") for (int k = 0; k < 2; ++k) \
        acc[ai][bj][m][n] = __builtin_amdgcn_mfma_f32_16x16x32_bf16(Bt[n][k], At[m][k], acc[ai][bj][m][n], 0, 0, 0); __builtin_amdgcn_s_setprio(0); } while (0)
#define PG8_WAIT_V(n) asm volatile("s_waitcnt vmcnt(" #n ")" ::: "memory")
#define PG8_WAIT_L(n) asm volatile("s_waitcnt lgkmcnt(" #n ")" ::: "memory")
#define PG8_BAR __builtin_amdgcn_s_barrier()
#define PG8_SCHED __builtin_amdgcn_sched_barrier(0)
    Unit cur, nxt; int ui = 0;
    if (!S.next(0, cur)) return;
    f32x4 acc[2][2][4][2];
#pragma unroll
    for (int a = 0; a < 2; ++a)
#pragma unroll
        for (int b = 0; b < 2; ++b)
#pragma unroll
            for (int m = 0; m < 4; ++m)
#pragma unroll
                for (int n = 0; n < 2; ++n) acc[a][b][m][n] = (f32x4){0.f, 0.f, 0.f, 0.f};
    bf16x8 At[4][2], B0[2][2], B1[2][2];
    const char* cA = (const char*)g.A + (size_t)cur.pm * tstep; const char* cB = (const char*)g.Bt + (size_t)cur.pn * tstep;
    PG8_STAGE(PG8_SB(0, 0), cB); PG8_STAGE(PG8_SA(0, 0), cA); PG8_STAGE(PG8_SB(0, 1), cB + hstep); PG8_STAGE(PG8_SA(0, 1), cA + hstep);
    if (wr == 1) PG8_BAR;
    PG8_WAIT_V(4); PG8_BAR;
    PG8_STAGE(PG8_SB(1, 0), cB + kstep); PG8_STAGE(PG8_SA(1, 0), cA + kstep); PG8_STAGE(PG8_SB(1, 1), cB + hstep + kstep);
    PG8_WAIT_V(6); PG8_BAR;
    for (;;) {
        const bool has_next = S.next(ui + 1, nxt);
        const char* nA = has_next ? (const char*)g.A + (size_t)nxt.pm * tstep : cA; const char* nB = has_next ? (const char*)g.Bt + (size_t)nxt.pn * tstep : cB;
        for (int t = 0; t < nt; t += 2) {
            const bool last = (t == nt - 2);
            const char* a1 = cA + (size_t)(t + 1) * kstep;
            const char* a2 = last ? nA : cA + (size_t)(t + 2) * kstep; const char* b2 = last ? nB : cB + (size_t)(t + 2) * kstep;
            const char* a3 = a2 + kstep; const char* b3 = b2 + kstep;
            PG8_LDB(B0, 0, 0); PG8_SCHED; PG8_LDA(At, 0, 0); PG8_STAGE(PG8_SA(1, 1), a1 + hstep);
            PG8_WAIT_L(8); PG8_BAR; PG8_WAIT_L(0); PG8_MMA(0, 0, At, B0); PG8_BAR; PG8_SCHED;
            PG8_LDB(B1, 0, 1); PG8_STAGE(PG8_SB(0, 0), b2);
            PG8_BAR; PG8_WAIT_L(0); PG8_MMA(0, 1, At, B1); PG8_BAR;
            PG8_LDA(At, 0, 1); PG8_STAGE(PG8_SA(0, 0), a2);
            PG8_BAR; PG8_WAIT_L(0); PG8_MMA(1, 0, At, B0); PG8_BAR; PG8_SCHED;
            PG8_STAGE(PG8_SB(0, 1), b2 + hstep);
            PG8_WAIT_V(6); PG8_BAR; PG8_MMA(1, 1, At, B1); PG8_BAR;
            PG8_LDB(B0, 1, 0); PG8_SCHED; PG8_LDA(At, 1, 0); PG8_STAGE(PG8_SA(0, 1), a2 + hstep);
            PG8_WAIT_L(8); PG8_BAR; PG8_WAIT_L(0); PG8_MMA(0, 0, At, B0); PG8_BAR; PG8_SCHED;
            PG8_LDB(B1, 1, 1); PG8_STAGE(PG8_SB(1, 0), b3);
            PG8_BAR; PG8_WAIT_L(0); PG8_MMA(0, 1, At, B1); PG8_BAR;
            PG8_LDA(At, 1, 1); PG8_STAGE(PG8_SA(1, 0), a3);
            PG8_BAR; PG8_WAIT_L(0); PG8_MMA(1, 0, At, B0); PG8_BAR; PG8_SCHED;
            PG8_STAGE(PG8_SB(1, 1), b3 + hstep);
            PG8_WAIT_V(6); PG8_BAR; PG8_MMA(1, 1, At, B1); PG8_BAR;
        }
        E(acc, cur, wr, wc, fr, fq);
        if (!has_next) break;
#pragma unroll
        for (int a = 0; a < 2; ++a)
#pragma unroll
            for (int b = 0; b < 2; ++b)
#pragma unroll
                for (int m = 0; m < 4; ++m)
#pragma unroll
                    for (int n = 0; n < 2; ++n) acc[a][b][m][n] = (f32x4){0.f, 0.f, 0.f, 0.f};
        cur = nxt; cA = nA; cB = nB; ++ui;
    }
    PG8_WAIT_V(0);
    if (wr == 0) PG8_BAR;
    PG8_BAR;
#undef PG8_SA
#undef PG8_SB
#undef PG8_STAGE
#undef PG8_LDA
#undef PG8_LDB
#undef PG8_MMA
#undef PG8_WAIT_V
#undef PG8_WAIT_L
#undef PG8_BAR
#undef PG8_SCHED
}
}
using pg8::Unit;
typedef f32x4 AccT[2][2][4][2];

struct EpiSwiglu {
    bf16_t* ACT; const float* rowss;
    __device__ __forceinline__ void operator()(const AccT& acc, const Unit& u, int wr, int wc, int fr, int fq) const {
        const int row0 = u.pm * 256 + wr * 64 + fr;
#pragma unroll
        for (int ai = 0; ai < 2; ++ai)
#pragma unroll
            for (int m = 0; m < 4; ++m) {
                const int r = row0 + ai * 128 + m * 16; const float rs = rowss ? rstd_of(rowss[r]) : 1.0f;
#pragma unroll
                for (int bj = 0; bj < 2; ++bj) {
                    const int col = (u.pn * 8 + bj * 4 + wc) * 16 + fq * 4;
                    float o[4];
#pragma unroll
                    for (int j = 0; j < 4; ++j) { const float a = acc[ai][bj][m][0][j] * rs, b = acc[ai][bj][m][1][j] * rs; o[j] = a * sigm(a) * b; }
                    u32x2 w; w.x = cvt_pk_bf16(o[0], o[1]); w.y = cvt_pk_bf16(o[2], o[3]);
                    *(u32x2*)(ACT + (size_t)r * DFF + col) = w;
                }
            }
    }
};
struct EpiResid {
    const float* src0; const float* src1; float* X; bf16_t* XB; float* rowss_next; float scale;
    __device__ __forceinline__ void operator()(const AccT& acc, const Unit& u, int wr, int wc, int fr, int fq) const {
        const int row0 = u.pm * 256 + wr * 64 + fr; const int col0 = u.pn * 256 + wc * 32 + fq * 4;
#pragma unroll
        for (int ai = 0; ai < 2; ++ai)
#pragma unroll
            for (int m = 0; m < 4; ++m) {
                const int r = row0 + ai * 128 + m * 16;
                const float* xs = (r < MP) ? src0 + (size_t)r * DM : src1 + (size_t)(r - MP) * DM;
                float ss = 0.f;
#pragma unroll
                for (int bj = 0; bj < 2; ++bj)
#pragma unroll
                    for (int n = 0; n < 2; ++n) {
                        const int col = col0 + bj * 128 + n * 16;
                        const f32x4 xo = *(const f32x4*)(xs + col);
                        const f32x4 v = xo + acc[ai][bj][m][n] * scale;
                        *(f32x4*)(X + (size_t)r * DM + col) = v;
                        ss += v[0] * v[0] + v[1] * v[1] + v[2] * v[2] + v[3] * v[3];
                        if (XB) { u32x2 w; w.x = cvt_pk_bf16(v[0], v[1]); w.y = cvt_pk_bf16(v[2], v[3]); *(u32x2*)(XB + (size_t)r * DM + col) = w; }
                    }
                ss += __shfl_xor(ss, 16); ss += __shfl_xor(ss, 32);
                if (fq == 0) __hip_atomic_fetch_add(rowss_next + r, ss, __ATOMIC_RELAXED, __HIP_MEMORY_SCOPE_AGENT);
            }
    }
};
struct EpiWin {
    PP P;
    __device__ __forceinline__ void operator()(const AccT& acc, const Unit& u, int wr, int wc, int fr, int fq) const {
        PP p = P; const float* rowss = p->rowss + MT;
        const int row0 = u.pm * 256 + wr * 64 + fr; const int pn = u.pn;
#pragma unroll
        for (int ai = 0; ai < 2; ++ai)
#pragma unroll
            for (int m = 0; m < 4; ++m) {
                const int r = row0 + ai * 128 + m * 16; const float rs = rstd_of(rowss[r]);
                const bool samp = r >= MP; const int rb = (r - MP) >> 3, rt = (r - MP) & 7;
                const int pos = samp ? MP + rt : r;
                const int krow = samp ? MP + rb * SBS + 128 + rt : r;
#pragma unroll
                for (int bj = 0; bj < 2; ++bj) {
                    if (pn < 2 || (pn == 2 && bj == 0)) {
                        const int grp = wc & 1, d = grp * 16 + fq * 4;
                        const f32x4 cs0 = *(const f32x4*)(p->rope + (size_t)pos * 64 + d * 2), cs1 = *(const f32x4*)(p->rope + (size_t)pos * 64 + d * 2 + 4);
                        const float cc[4] = {cs0[0], cs0[2], cs1[0], cs1[2]}, sn[4] = {cs0[1], cs0[3], cs1[1], cs1[3]};
                        float o1[4], o2[4];
#pragma unroll
                        for (int j = 0; j < 4; ++j) { const float x1 = acc[ai][bj][m][0][j] * rs, x2 = acc[ai][bj][m][1][j] * rs; o1[j] = x1 * cc[j] - x2 * sn[j]; o2[j] = x2 * cc[j] + x1 * sn[j]; }
                        if (pn < 2) {
                            const int head = pn * 4 + bj * 2 + (wc >> 1);
                            u32x2 w1, w2; w1.x = cvt_pk_bf16(o1[0] * 0.125f, o1[1] * 0.125f); w1.y = cvt_pk_bf16(o1[2] * 0.125f, o1[3] * 0.125f);
                            w2.x = cvt_pk_bf16(o2[0] * 0.125f, o2[1] * 0.125f); w2.y = cvt_pk_bf16(o2[2] * 0.125f, o2[3] * 0.125f);
                            bf16_t* qp = p->Q + (size_t)r * 512 + head * 64 + d;
                            *(u32x2*)qp = w1; *(u32x2*)(qp + 32) = w2;
                        } else {
                            const int kvh = wc >> 1;
                            u32x2 w1, w2; w1.x = cvt_pk_bf16(o1[0], o1[1]); w1.y = cvt_pk_bf16(o1[2], o1[3]); w2.x = cvt_pk_bf16(o2[0], o2[1]); w2.y = cvt_pk_bf16(o2[2], o2[3]);
                            bf16_t* kp = p->Kb + (size_t)krow * 128 + kvh * 64 + d;
                            *(u32x2*)kp = w1; *(u32x2*)(kp + 32) = w2;
                            float* op = nullptr;
                            if (samp) op = p->out + OFF_WKS + ((size_t)rb * 128 + 120 + rt) * 128 + kvh * 64 + d;
                            else if (r >= MP - 128) op = p->out + OFF_WKP + (size_t)(r - (MP - 128)) * 128 + kvh * 64 + d;
                            if (op) { *(f32x4*)op = (f32x4){o1[0], o1[1], o1[2], o1[3]}; *(f32x4*)(op + 32) = (f32x4){o2[0], o2[1], o2[2], o2[3]}; }
                        }
                    } else if (pn == 2) {
                        const int kvh = wc >> 1;
                        float* op = nullptr;
                        if (samp) op = p->out + OFF_WVS + ((size_t)rb * 128 + 120 + rt) * 128 + kvh * 64;
                        else if (r >= MP - 128) op = p->out + OFF_WVP + (size_t)(r - (MP - 128)) * 128 + kvh * 64;
#pragma unroll
                        for (int n = 0; n < 2; ++n) {
                            const int d = (wc & 1) * 32 + n * 16 + fq * 4;
                            const f32x4 v = acc[ai][bj][m][n] * rs;
#pragma unroll
                            for (int j = 0; j < 4; ++j) p->Vt[(size_t)(kvh * 64 + d + j) * KROWS + krow] = (bf16_t)(cvt_pk_bf16(v[j], 0.f) & 0xffffu);
                            if (op) *(f32x4*)(op + d) = v;
                        }
                    } else if (pn < 5) {
#pragma unroll
                        for (int n = 0; n < 2; ++n) {
                            const int col = (pn - 3) * 256 + bj * 128 + wc * 32 + n * 16 + fq * 4;
                            *(f32x4*)(p->U + (size_t)r * 512 + col) = acc[ai][bj][m][n] * rs;
                        }
                    } else {
                        const int col = (pn - 5) * 256 + bj * 128 + wc * 32 + fq * 8;
                        const f32x4 a = acc[ai][bj][m][0] * rs, b = acc[ai][bj][m][1] * rs;
                        u32x4 w; w.x = cvt_pk_bf16(sigm(a[0]), sigm(a[1])); w.y = cvt_pk_bf16(sigm(a[2]), sigm(a[3]));
                        w.z = cvt_pk_bf16(sigm(b[0]), sigm(b[1])); w.w = cvt_pk_bf16(sigm(b[2]), sigm(b[3]));
                        *(u32x4*)(p->SG + (size_t)r * 2048 + col) = w;
                    }
                }
            }
    }
};
__device__ __forceinline__ f32x4 ld_bf16x4(const bf16_t* ptr) { const u32x2 w = *(const u32x2*)ptr; f32x4 r; r[0] = __uint_as_float(w.x << 16); r[1] = __uint_as_float(w.x & 0xffff0000u); r[2] = __uint_as_float(w.y << 16); r[3] = __uint_as_float(w.y & 0xffff0000u); return r; }
struct EpiAttnUp {
    float* TMP; const bf16_t* SG;
    __device__ __forceinline__ void operator()(const AccT& acc, const Unit& u, int wr, int wc, int fr, int fq) const {
        const int row0 = u.pm * 256 + wr * 64 + fr; const int col0 = u.pn * 256 + wc * 32 + fq * 4;
#pragma unroll
        for (int ai = 0; ai < 2; ++ai)
#pragma unroll
            for (int m = 0; m < 4; ++m) {
                const int r = row0 + ai * 128 + m * 16;
#pragma unroll
                for (int bj = 0; bj < 2; ++bj)
#pragma unroll
                    for (int n = 0; n < 2; ++n) {
                        const int col = col0 + bj * 128 + n * 16;
                        const f32x4 g = ld_bf16x4(SG + (size_t)r * 2048 + col);
                        *(f32x4*)(TMP + (size_t)r * DM + col) = g * acc[ai][bj][m][n];
                    }
            }
    }
};
struct EpiSsmGlu {
    const float* TMP; const bf16_t* SG; bf16_t* MERGED;
    __device__ __forceinline__ void operator()(const AccT& acc, const Unit& u, int wr, int wc, int fr, int fq) const {
        const int row0 = u.pm * 256 + wr * 64 + fr;
#pragma unroll
        for (int ai = 0; ai < 2; ++ai)
#pragma unroll
            for (int m = 0; m < 4; ++m) {
                const int r = row0 + ai * 128 + m * 16;
#pragma unroll
                for (int bj = 0; bj < 2; ++bj) {
                    const int col = (u.pn * 8 + bj * 4 + wc) * 16 + fq * 4;
                    const f32x4 t = *(const f32x4*)(TMP + (size_t)r * DM + col);
                    const f32x4 g = ld_bf16x4(SG + (size_t)r * 2048 + 1024 + col);
                    float o[4];
#pragma unroll
                    for (int j = 0; j < 4; ++j) { const float ga = acc[ai][bj][m][0][j], gb = acc[ai][bj][m][1][j]; o[j] = t[j] + g[j] * ga * sigm(gb); }
                    u32x2 w; w.x = cvt_pk_bf16(o[0], o[1]); w.y = cvt_pk_bf16(o[2], o[3]);
                    *(u32x2*)(MERGED + (size_t)r * DM + col) = w;
                }
            }
    }
};
struct EpiXq {
    bf16_t* XQ; const float* rowss;
    __device__ __forceinline__ void operator()(const AccT& acc, const Unit& u, int wr, int wc, int fr, int fq) const {
        const int row0 = u.pm * 256 + wr * 64 + fr;
#pragma unroll
        for (int ai = 0; ai < 2; ++ai)
#pragma unroll
            for (int m = 0; m < 4; ++m) {
                const int r = row0 + ai * 128 + m * 16; const float rs = rstd_of(rowss[r]);
#pragma unroll
                for (int bj = 0; bj < 2; ++bj) {
                    const int col = u.pn * 256 + bj * 128 + wc * 32 + fq * 8;
                    const f32x4 a = acc[ai][bj][m][0] * rs, b = acc[ai][bj][m][1] * rs;
                    u32x4 w; w.x = cvt_pk_bf16(a[0], a[1]); w.y = cvt_pk_bf16(a[2], a[3]); w.z = cvt_pk_bf16(b[0], b[1]); w.w = cvt_pk_bf16(b[2], b[3]);
                    *(u32x4*)(XQ + (size_t)r * DM + col) = w;
                }
            }
    }
};
struct EpiMemKV {
    float* out; const float* rowss;
    __device__ __forceinline__ void operator()(const AccT& acc, const Unit& u, int wr, int wc, int fr, int fq) const {
        const int row0 = wr * 64 + fr; const int col0 = (u.pn & 3) * 256 + wc * 32 + fq * 4;
        float* ob = out + (u.pn < 4 ? OFF_MKP : OFF_MVP);
#pragma unroll
        for (int ai = 0; ai < 2; ++ai)
#pragma unroll
            for (int m = 0; m < 4; ++m) {
                const int r = row0 + ai * 128 + m * 16;
#pragma unroll
                for (int bj = 0; bj < 2; ++bj)
#pragma unroll
                    for (int n = 0; n < 2; ++n) *(f32x4*)(ob + (size_t)r * DM + col0 + bj * 128 + n * 16) = acc[ai][bj][m][n];
            }
    }
};
__device__ __forceinline__ void memkv_convert(PP p) {
    const int gt = blockIdx.x * 512 + opaque_tid(), ntot = gridDim.x * 512;
    for (int i = gt; i < 256 * 1024; i += ntot) p->MK[i] = (bf16_t)(cvt_pk_bf16(p->out[OFF_MKP + i], 0.f) & 0xffffu);
    for (int i = gt; i < 256 * 1024; i += ntot) {
        const int r = i & 255, col = i >> 8;
        p->MVt[i] = (bf16_t)(cvt_pk_bf16(p->out[OFF_MVP + (size_t)r * 1024 + col], 0.f) & 0xffffu);
    }
}

struct SmallEpi { const float* src; float* X; bf16_t* XB; float* rowss_next; float scale; const float* rowss; bf16_t* XQ; float* TMP; const bf16_t* SG; bf16_t* MERGED; int ntn; };
template <int EP>
__device__ __forceinline__ void small_gemm_sample(unsigned char* smem, const bf16_t* A, const bf16_t* Bt, int K, const SmallEpi E) {
    const int tid = opaque_tid(), wid = tid >> 6, lane = tid & 63, fr = lane & 15, fq = lane >> 4;
    float* part = (float*)smem;
    const int nks = K >> 8;
    const int ntn = E.ntn ? E.ntn : 16;
    for (int t = blockIdx.x; t < 16 * ntn; t += gridDim.x) {
        const int tm = t / ntn, tn = t - tm * ntn;
        const bf16_t* ap = A + (size_t)(MP + tm * 64 + fr) * K + wid * (K >> 3) + fq * 8;
        const bf16_t* bp = Bt + (size_t)(tn * 64 + fr) * K + wid * (K >> 3) + fq * 8;
        f32x4 acc[4][4];
#pragma unroll
        for (int mi = 0; mi < 4; ++mi)
#pragma unroll
            for (int ni = 0; ni < 4; ++ni) acc[mi][ni] = (f32x4){0.f, 0.f, 0.f, 0.f};
        bf16x8 Af[2][4], Bf[2][4];
#pragma unroll
        for (int i = 0; i < 4; ++i) { Af[0][i] = *(const bf16x8*)(ap + (size_t)(i * 16) * K); Bf[0][i] = *(const bf16x8*)(bp + (size_t)(i * 16) * K); }
        for (int ks = 0; ks < nks; ks += 2) {
            if (ks + 1 < nks) {
#pragma unroll
                for (int i = 0; i < 4; ++i) { Af[1][i] = *(const bf16x8*)(ap + (size_t)(i * 16) * K + (ks + 1) * 32); Bf[1][i] = *(const bf16x8*)(bp + (size_t)(i * 16) * K + (ks + 1) * 32); }
            }
#pragma unroll
            for (int mi = 0; mi < 4; ++mi)
#pragma unroll
                for (int ni = 0; ni < 4; ++ni) acc[mi][ni] = __builtin_amdgcn_mfma_f32_16x16x32_bf16(Af[0][mi], Bf[0][ni], acc[mi][ni], 0, 0, 0);
            if (ks + 1 < nks) {
                if (ks + 2 < nks) {
#pragma unroll
                    for (int i = 0; i < 4; ++i) { Af[0][i] = *(const bf16x8*)(ap + (size_t)(i * 16) * K + (ks + 2) * 32); Bf[0][i] = *(const bf16x8*)(bp + (size_t)(i * 16) * K + (ks + 2) * 32); }
                }
#pragma unroll
                for (int mi = 0; mi < 4; ++mi)
#pragma unroll
                    for (int ni = 0; ni < 4; ++ni) acc[mi][ni] = __builtin_amdgcn_mfma_f32_16x16x32_bf16(Af[1][mi], Bf[1][ni], acc[mi][ni], 0, 0, 0);
            }
        }
        __syncthreads();
#pragma unroll
        for (int mi = 0; mi < 4; ++mi)
#pragma unroll
            for (int ni = 0; ni < 4; ++ni)
#pragma unroll
                for (int j = 0; j < 4; ++j) part[wid * 4096 + (mi * 16 + fq * 4 + j) * 64 + ni * 16 + fr] = acc[mi][ni][j];
        __syncthreads();
        const int m = tid >> 3, n8 = (tid & 7) * 8;
        f32x4 s0 = (f32x4){0.f, 0.f, 0.f, 0.f}, s1 = s0;
#pragma unroll
        for (int w = 0; w < 8; ++w) { s0 += *(const f32x4*)(part + w * 4096 + m * 64 + n8); s1 += *(const f32x4*)(part + w * 4096 + m * 64 + n8 + 4); }
        const int r = MP + tm * 64 + m, c0 = tn * 64 + n8;
        if (EP == 0) {
            const float* xs = E.src + (size_t)(r - MP) * DM + c0;
            const f32x4 v0 = *(const f32x4*)xs + s0 * E.scale, v1 = *(const f32x4*)(xs + 4) + s1 * E.scale;
            *(f32x4*)(E.X + (size_t)r * DM + c0) = v0; *(f32x4*)(E.X + (size_t)r * DM + c0 + 4) = v1;
            if (E.XB) { u32x4 w; w.x = cvt_pk_bf16(v0[0], v0[1]); w.y = cvt_pk_bf16(v0[2], v0[3]); w.z = cvt_pk_bf16(v1[0], v1[1]); w.w = cvt_pk_bf16(v1[2], v1[3]); *(u32x4*)(E.XB + (size_t)r * DM + c0) = w; }
            float ss = v0[0] * v0[0] + v0[1] * v0[1] + v0[2] * v0[2] + v0[3] * v0[3] + v1[0] * v1[0] + v1[1] * v1[1] + v1[2] * v1[2] + v1[3] * v1[3];
            ss += __shfl_xor(ss, 1); ss += __shfl_xor(ss, 2); ss += __shfl_xor(ss, 4);
            if ((tid & 7) == 0) __hip_atomic_fetch_add(E.rowss_next + r, ss, __ATOMIC_RELAXED, __HIP_MEMORY_SCOPE_AGENT);
        } else if (EP == 1) {
            const float rs = rstd_of(E.rowss[r]);
#pragma unroll
            for (int e = 0; e < 8; ++e) {
                const int cp = c0 + e, sl = cp & 31, nn = sl >> 4, ii = sl & 15; const int col = (cp & ~31) + 8 * (ii >> 2) + 4 * nn + (ii & 3);
                const float v = (e < 4 ? s0[e & 3] : s1[e & 3]) * rs;
                E.XQ[(size_t)r * DM + col] = (bf16_t)(cvt_pk_bf16(v, 0.f) & 0xffffu);
            }
        } else if (EP == 2) {
            const f32x4 g0 = ld_bf16x4(E.SG + (size_t)r * 2048 + c0), g1 = ld_bf16x4(E.SG + (size_t)r * 2048 + c0 + 4);
            *(f32x4*)(E.TMP + (size_t)r * DM + c0) = g0 * s0; *(f32x4*)(E.TMP + (size_t)r * DM + c0 + 4) = g1 * s1;
        } else {
            f32x4 b0, b1;
#pragma unroll
            for (int e = 0; e < 4; ++e) { b0[e] = __shfl_down(s0[e], 2); b1[e] = __shfl_down(s1[e], 2); }
            if ((c0 & 16) == 0) {
                const int o = (c0 >> 5) * 16 + (c0 & 15);
                const f32x4 t0 = *(const f32x4*)(E.TMP + (size_t)r * DM + o), t1 = *(const f32x4*)(E.TMP + (size_t)r * DM + o + 4);
                const f32x4 g0 = ld_bf16x4(E.SG + (size_t)r * 2048 + 1024 + o), g1 = ld_bf16x4(E.SG + (size_t)r * 2048 + 1024 + o + 4);
                float m[8];
#pragma unroll
                for (int e = 0; e < 4; ++e) { m[e] = t0[e] + g0[e] * s0[e] * sigm(b0[e]); m[4 + e] = t1[e] + g1[e] * s1[e] * sigm(b1[e]); }
                u32x4 w; w.x = cvt_pk_bf16(m[0], m[1]); w.y = cvt_pk_bf16(m[2], m[3]); w.z = cvt_pk_bf16(m[4], m[5]); w.w = cvt_pk_bf16(m[6], m[7]);
                *(u32x4*)(E.MERGED + (size_t)r * DM + o) = w;
            }
        }
    }
    __syncthreads();
}

__device__ __forceinline__ int src_col(int mode, int H, int np) {
    if (mode == 3) { if (np < 640) { const int pp = np & 63, grp = pp >> 5, s = pp & 31, n = s >> 4, i = s & 15; return (np & ~63) + grp * 16 + i + n * 32; }
                     if (np < 1280) return np; mode = 1; }
    if (mode == 0) return np;
    const int s = np & 31, n = s >> 4, i = s & 15;
    if (mode == 1) return (np & ~31) + 8 * (i >> 2) + 4 * n + (i & 3);
    return n * H + (np >> 5) * 16 + i;
}
__device__ __forceinline__ void sincos_d(double ang, double& s, double& c) {
    const double x = ang * 0.63661977236758134308;
    const double q = rint(x); const double r = (ang - q * 1.57079632679489655800) - q * 6.12323399573676603587e-17;
    const double r2 = r * r;
    double sp = -7.6471637318198164759e-13; sp = sp * r2 + 1.6059043836821614599e-10; sp = sp * r2 - 2.5052108385441718775e-08; sp = sp * r2 + 2.7557319223985890653e-06;
    sp = sp * r2 - 1.9841269841269841270e-04; sp = sp * r2 + 8.3333333333333332177e-03; sp = sp * r2 - 1.6666666666666665741e-01; sp = r + r * r2 * sp;
    double cp = 4.7794773323873852974e-14; cp = cp * r2 - 1.1470745597729724714e-11; cp = cp * r2 + 2.0876756987868098979e-09; cp = cp * r2 - 2.7557319223985888e-07;
    cp = cp * r2 + 2.4801587301587301566e-05; cp = cp * r2 - 1.3888888888888889419e-03; cp = cp * r2 + 4.1666666666666664354e-02; cp = cp * r2 - 0.5; cp = 1.0 + r2 * cp;
    const int qi = ((int)(long long)q) & 3;
    s = (qi == 0) ? sp : (qi == 1) ? cp : (qi == 2) ? -sp : -cp;
    c = (qi == 0) ? cp : (qi == 1) ? -sp : (qi == 2) ? -cp : sp;
}

__device__ __forceinline__ void conv_weight(const float* src, const float* g, bf16_t* dst, int K, int ld, int Np, int mode, int H, float scale, int tile0, int wv, int nwv, int lane) {
    const int nkt = K >> 6, ntile = (Np >> 8) * nkt;
    for (int t = wv - tile0; t < ntile; t += nwv) {
        if (t < 0) continue;
        const int tn = t / nkt, tk = t - tn * nkt; const int n0 = tn * 256 + lane * 4, k0 = tk * 64;
        const float* sp = src + (size_t)k0 * ld + src_col(mode, H, n0);
        bf16_t* dp = dst + (size_t)n0 * K + k0;
#pragma unroll 1
        for (int ss = 0; ss < 4; ++ss) {
            f32x4 v[16];
#pragma unroll
            for (int e = 0; e < 16; ++e) { const float gv = g ? g[k0 + ss * 16 + e] * scale : scale; v[e] = *(const f32x4*)(sp + (size_t)(ss * 16 + e) * ld) * gv; }
#pragma unroll
            for (int q = 0; q < 4; ++q) {
                u32x4 w0, w1;
                w0.x = cvt_pk_bf16(v[0][q], v[1][q]); w0.y = cvt_pk_bf16(v[2][q], v[3][q]); w0.z = cvt_pk_bf16(v[4][q], v[5][q]); w0.w = cvt_pk_bf16(v[6][q], v[7][q]);
                w1.x = cvt_pk_bf16(v[8][q], v[9][q]); w1.y = cvt_pk_bf16(v[10][q], v[11][q]); w1.z = cvt_pk_bf16(v[12][q], v[13][q]); w1.w = cvt_pk_bf16(v[14][q], v[15][q]);
                *(u32x4*)(dp + (size_t)q * K + ss * 16) = w0; *(u32x4*)(dp + (size_t)q * K + ss * 16 + 8) = w1;
            }
        }
    }
}
__device__ __forceinline__ void conv_weight_set(PP p, int set, int wv, int nwv, int lane) {
    if (set == 0) {
        conv_weight(p->w_ffn1_in, p->g_ffn1, p->Wt1, 1024, 5632, 5632, 2, 2816, 1.f, 0, wv, nwv, lane);
        conv_weight(p->w_xk, p->g_mem, p->Wtkv, 1024, 1024, 1024, 0, 0, 1.f, 352 % nwv, wv, nwv, lane);
        conv_weight(p->w_xv, p->g_mem, p->Wtkv + 1024 * 1024, 1024, 1024, 1024, 0, 0, 1.f, 416 % nwv, wv, nwv, lane);
    } else if (set == 1) {
        conv_weight(p->w_ffn1_out, nullptr, p->Wt2, 2816, 1024, 1024, 0, 0, 1.f, 0, wv, nwv, lane);
        conv_weight(p->w_in, p->g_mix, p->Wt3, 1024, 3328, 3328, 3, 0, 1.f, 176 % nwv, wv, nwv, lane);
    } else {
        conv_weight(p->w_attn_up, nullptr, p->Wt4, 512, 1024, 1024, 0, 0, 1.f, 0, wv, nwv, lane);
        conv_weight(p->w_ssm_glu, nullptr, p->Wt5, 512, 2048, 2048, 2, 1024, 1.f, 32 % nwv, wv, nwv, lane);
        conv_weight(p->w_out, nullptr, p->Wt6, 1024, 1024, 1024, 0, 0, 1.f, 96 % nwv, wv, nwv, lane);
        conv_weight(p->w_xq, p->g_xattn, p->Wt7, 1024, 1024, 1024, 1, 0, 0.0625f, 160 % nwv, wv, nwv, lane);
        conv_weight(p->w_xo, nullptr, p->Wt8, 1024, 1024, 1024, 0, 0, 1.f, 224 % nwv, wv, nwv, lane);
        conv_weight(p->w_ffn2_in, p->g_ffn2, p->Wt9, 1024, 5632, 5632, 2, 2816, 1.f, 288 % nwv, wv, nwv, lane);
        conv_weight(p->w_ffn2_out, nullptr, p->Wt10, 2816, 1024, 1024, 0, 0, 1.f, 640 % nwv, wv, nwv, lane);
    }
}
__device__ __forceinline__ void prep_rope(PP p, int wg, int nwg) {
    const int gt = wg * 512 + opaque_tid(), ntot = nwg * 512;
    for (int i = gt; i < 16392 * 32; i += ntot) {
        const int pos = i >> 5, d = i & 31;
        const double inv = exp(-(double)d * (9.21034037197618273607 / 32.0));
        double s, c; sincos_d((double)pos * inv, s, c);
        p->rope[(size_t)i * 2] = (float)c; p->rope[(size_t)i * 2 + 1] = (float)s;
    }
}
__device__ __forceinline__ void prep_tables(PP p, int wg, int nwg) {
    const int tid = opaque_tid(), wid = tid >> 6, lane = tid & 63;
    const int gw = wg * 8 + wid, nw = nwg * 8;
    const int gt = wg * 512 + tid, ntot = nwg * 512;
    for (int gn = gt; gn < 2048; gn += ntot) {
        const int g = gn >> 6;
        const double are = p->a_re[gn], aim = p->a_im[gn], dt = exp((double)p->log_dt[g]);
        double s, c; sincos_d(aim * dt, s, c); const double mag = exp(are * dt);
        const double lbr = mag * c, lbi = mag * s;
        double s64, c64; sincos_d(aim * dt * 64.0, s64, c64); const double mag64 = exp(are * dt * 64.0);
        const double den = are * are + aim * aim, nr = lbr - 1.0, ni = lbi;
        const double kre = (nr * are + ni * aim) / den, kim = (ni * are - nr * aim) / den;
        float* tb = p->ssmtab;
        tb[gn * 2] = (float)lbr; tb[gn * 2 + 1] = (float)lbi;
        tb[4096 + gn * 2] = (float)(mag64 * c64); tb[4096 + gn * 2 + 1] = (float)(mag64 * s64);
#pragma unroll
        for (int ch = 0; ch < 16; ++ch) {
            const double br = p->b_re[gn * 16 + ch], bi = p->b_im[gn * 16 + ch];
            tb[8192 + gn * 32 + ch] = (float)(kre * br - kim * bi);
            tb[8192 + gn * 32 + 16 + ch] = (float)(kre * bi + kim * br);
        }
    }
}
__device__ __forceinline__ void prep_ctx(PP p, int wg, int nwg) {
    const int tid = opaque_tid(), wid = tid >> 6, lane = tid & 63;
    const int gw = wg * 8 + wid, nw = nwg * 8;
    const int gt = wg * 512 + tid, ntot = nwg * 512;
    for (int i4 = gt; i4 < 128 * 128 * 32; i4 += ntot) {
        const int i = i4 * 4; const int cidx = i & 127, w = (i >> 7) & 127, b = i >> 14;
        const f32x4 kv = *(const f32x4*)(p->cache_win_k + i), vv = *(const f32x4*)(p->cache_win_v + i);
        u32x2 kw; kw.x = cvt_pk_bf16(kv[0], kv[1]); kw.y = cvt_pk_bf16(kv[2], kv[3]);
        *(u32x2*)(p->Kb + (size_t)(MP + b * SBS + w) * 128 + cidx) = kw;
        if (w >= 8) { *(f32x4*)(p->out + OFF_WKS + ((size_t)b * 128 + (w - 8)) * 128 + cidx) = kv; *(f32x4*)(p->out + OFF_WVS + ((size_t)b * 128 + (w - 8)) * 128 + cidx) = vv; }
    }
    for (int it = gw; it < 128 * 2 * 16; it += nw) {
        const int cg8 = it & 15, half = (it >> 4) & 1, b = it >> 5; const int w = half * 64 + lane;
        const float* vp = p->cache_win_v + ((size_t)b * 128 + w) * 128 + cg8 * 8;
        const f32x4 v0 = *(const f32x4*)vp, v1 = *(const f32x4*)(vp + 4);
        bf16_t* dp = p->Vt + (size_t)(cg8 * 8) * KROWS + MP + b * SBS + w;
#pragma unroll
        for (int e = 0; e < 4; ++e) { dp[(size_t)e * KROWS] = (bf16_t)(cvt_pk_bf16(v0[e], 0.f) & 0xffffu); dp[(size_t)(e + 4) * KROWS] = (bf16_t)(cvt_pk_bf16(v1[e], 0.f) & 0xffffu); }
    }
}
__device__ __forceinline__ void phase_prep(PP p, unsigned char* smem) {
    const int tid = opaque_tid(), wid = tid >> 6, lane = tid & 63;
    const int gw = blockIdx.x * 8 + wid, nw = gridDim.x * 8;
    const int gt = blockIdx.x * 512 + tid, ntot = gridDim.x * 512;
    conv_weight_set(p, 0, gw, nw, lane);
    for (int r0 = gw; r0 < MT + 256; r0 += 2 * nw) {
        f32x4 v[2][4]; float ss[2];
#pragma unroll
        for (int q = 0; q < 2; ++q) {
            int r = r0 + q * nw; r = r < MT + 256 ? r : r0;
            const float* xs = (r < MP) ? p->x_prompt + (size_t)r * DM : (r < MT) ? p->x_sample + (size_t)(r - MP) * DM : p->mem_prompt + (size_t)(r - MT) * DM;
            ss[q] = 0.f;
#pragma unroll
            for (int i = 0; i < 4; ++i) { v[q][i] = *(const f32x4*)(xs + i * 256 + lane * 4); ss[q] += v[q][i][0] * v[q][i][0] + v[q][i][1] * v[q][i][1] + v[q][i][2] * v[q][i][2] + v[q][i][3] * v[q][i][3]; }
        }
#pragma unroll
        for (int o = 1; o < 64; o <<= 1) { ss[0] += __shfl_xor(ss[0], o); ss[1] += __shfl_xor(ss[1], o); }
#pragma unroll
        for (int q = 0; q < 2; ++q) {
            const int r = r0 + q * nw; if (r >= MT + 256) continue;
            bf16_t* xb = (r < MT) ? p->XB + (size_t)r * DM : p->MEMB + (size_t)(r - MT) * DM;
            const float rs = rstd_of(ss[q]);
#pragma unroll
            for (int i = 0; i < 4; ++i) { u32x2 w; w.x = cvt_pk_bf16(v[q][i][0] * rs, v[q][i][1] * rs); w.y = cvt_pk_bf16(v[q][i][2] * rs, v[q][i][3] * rs); *(u32x2*)(xb + i * 256 + lane * 4) = w; }
        }
    }
    for (int i = gt; i < 4 * MT; i += ntot) p->rowss[MT + i] = 0.f;
    prep_rope(p, blockIdx.x, gridDim.x);
}

__device__ __forceinline__ bf16x8 mk_bf16x8(u32x2 lo, u32x2 hi) { u32x4 w; w.x = lo.x; w.y = lo.y; w.z = hi.x; w.w = hi.y; return __builtin_bit_cast(bf16x8, w); }

__device__ __forceinline__ void swa_item(PP p, int item, int lane) {
    const int fr = lane & 15, fq = lane >> 4;
    int head, kvh, tq, qrow, krow_base, row_hi;
    if (item < 8192) { head = item & 7; const int p0 = (item >> 3) * 16; kvh = head >> 2; tq = fr; qrow = p0 + fr; krow_base = p0 - 128; row_hi = MP + 127; }
    else { const int it = item - 8192; const int b = it >> 2; kvh = (it >> 1) & 1; head = kvh * 4 + (it & 1) * 2 + (fr >> 3); tq = fr & 7; qrow = MP + b * 8 + tq; krow_base = MP + b * SBS; row_hi = krow_base + 135; }
    const float sink = p->sinks[head];
    const bf16_t* Kb = p->Kb + kvh * 64 + fq * 8;
    const bf16_t* Vt = p->Vt + (size_t)(kvh * 64 + fr) * KROWS;
    bf16x8 Qf[2];
#pragma unroll
    for (int ks = 0; ks < 2; ++ks) Qf[ks] = *(const bf16x8*)(p->Q + (size_t)qrow * 512 + head * 64 + ks * 32 + fq * 8);
    float mrun = sink, lrun = (fq == 0) ? 1.f : 0.f;
    f32x4 Oa[4];
#pragma unroll
    for (int db = 0; db < 4; ++db) Oa[db] = (f32x4){0.f, 0.f, 0.f, 0.f};
    const int koff = (fr >> 2) * 8 + (fr & 3);
    const int cstart = krow_base < 0 ? ((-krow_base) >> 5) : 0;
    bf16x8 Kf[2][2], Vf[4];
    auto load_chunk = [&](int cc) {
        const int rbase = krow_base + cc * 32;
#pragma unroll
        for (int kb = 0; kb < 2; ++kb) {
            int kr = rbase + koff + kb * 4; kr = kr < 0 ? 0 : (kr > row_hi ? row_hi : kr);
            const bf16_t* kp = Kb + (size_t)kr * 128;
            Kf[kb][0] = *(const bf16x8*)kp; Kf[kb][1] = *(const bf16x8*)(kp + 32);
        }
        int vt = rbase + fq * 8; vt = vt < 0 ? 0 : (vt > row_hi - 7 ? row_hi - 7 : vt);
#pragma unroll
        for (int db = 0; db < 4; ++db) Vf[db] = *(const bf16x8*)(Vt + (size_t)db * 16 * KROWS + vt);
    };
    load_chunk(cstart);
    for (int cc = cstart; cc < 5; ++cc) {
        const int c0 = cc * 32;
        f32x4 S[2];
#pragma unroll
        for (int kb = 0; kb < 2; ++kb) {
            S[kb] = __builtin_amdgcn_mfma_f32_16x16x32_bf16(Kf[kb][0], Qf[0], (f32x4){0.f, 0.f, 0.f, 0.f}, 0, 0, 0);
            S[kb] = __builtin_amdgcn_mfma_f32_16x16x32_bf16(Kf[kb][1], Qf[1], S[kb], 0, 0, 0);
        }
        bf16x8 Vc[4];
#pragma unroll
        for (int db = 0; db < 4; ++db) Vc[db] = Vf[db];
        if (cc + 1 < 5) load_chunk(cc + 1);
        bool valid[2][4]; float mx = -1e30f;
#pragma unroll
        for (int kb = 0; kb < 2; ++kb)
#pragma unroll
            for (int j = 0; j < 4; ++j) { const int c = c0 + fq * 8 + kb * 4 + j; valid[kb][j] = (c >= tq) && (c <= 128 + tq) && (krow_base + c >= 0); if (valid[kb][j]) mx = fmaxf(mx, S[kb][j]); }
        mx = fmaxf(mx, __shfl_xor(mx, 16)); mx = fmaxf(mx, __shfl_xor(mx, 32));
        const float mnew = fmaxf(mrun, mx); const float alpha = __expf(mrun - mnew); mrun = mnew;
        float ps = 0.f; float pv[2][4];
#pragma unroll
        for (int kb = 0; kb < 2; ++kb)
#pragma unroll
            for (int j = 0; j < 4; ++j) { pv[kb][j] = valid[kb][j] ? __expf(S[kb][j] - mnew) : 0.f; ps += pv[kb][j]; }
        lrun = lrun * alpha + ps;
        u32x4 pw; pw.x = cvt_pk_bf16(pv[0][0], pv[0][1]); pw.y = cvt_pk_bf16(pv[0][2], pv[0][3]); pw.z = cvt_pk_bf16(pv[1][0], pv[1][1]); pw.w = cvt_pk_bf16(pv[1][2], pv[1][3]);
        const bf16x8 Pf = __builtin_bit_cast(bf16x8, pw);
#pragma unroll
        for (int db = 0; db < 4; ++db) {
            Oa[db] = Oa[db] * alpha;
            Oa[db] = __builtin_amdgcn_mfma_f32_16x16x32_bf16(Vc[db], Pf, Oa[db], 0, 0, 0);
        }
    }
    lrun += __shfl_xor(lrun, 16); lrun += __shfl_xor(lrun, 32);
    const float inv = 1.0f / lrun;
#pragma unroll
    for (int db = 0; db < 4; ++db) {
        u32x2 w; w.x = cvt_pk_bf16(Oa[db][0] * inv, Oa[db][1] * inv); w.y = cvt_pk_bf16(Oa[db][2] * inv, Oa[db][3] * inv);
        *(u32x2*)(p->O + (size_t)qrow * 512 + head * 64 + db * 16 + fq * 4) = w;
    }
}

__device__ __forceinline__ void swa_lds_core(const bf16_t* LK, const bf16_t* LV, const bf16x8 Qf0, const bf16x8 Qf1, float sink, int tq, int lbase, int cmin, int krmax, int vtmax, int cstart,
                                             f32x4 (&Oa)[4], float& inv, int fr, int fq) {
    const int koff = (fr >> 2) * 8 + (fr & 3);
    float mrun = sink, lrun = (fq == 0) ? 1.f : 0.f;
#pragma unroll
    for (int db = 0; db < 4; ++db) Oa[db] = (f32x4){0.f, 0.f, 0.f, 0.f};
    for (int cc = cstart; cc < 5; ++cc) {
        const int c0 = cc * 32, rbase = lbase + c0;
        f32x4 S[2];
#pragma unroll
        for (int kb = 0; kb < 2; ++kb) {
            int kr = rbase + koff + kb * 4; kr = kr > krmax ? krmax : kr;
            const bf16_t* kp = LK + kr * 72 + fq * 8;
            S[kb] = __builtin_amdgcn_mfma_f32_16x16x32_bf16(*(const bf16x8*)kp, Qf0, (f32x4){0.f, 0.f, 0.f, 0.f}, 0, 0, 0);
            S[kb] = __builtin_amdgcn_mfma_f32_16x16x32_bf16(*(const bf16x8*)(kp + 32), Qf1, S[kb], 0, 0, 0);
        }
        bool valid[2][4]; float mx = -1e30f;
#pragma unroll
        for (int kb = 0; kb < 2; ++kb)
#pragma unroll
            for (int j = 0; j < 4; ++j) { const int c = c0 + fq * 8 + kb * 4 + j; valid[kb][j] = (c >= tq) && (c <= 128 + tq) && (c >= cmin); if (valid[kb][j]) mx = fmaxf(mx, S[kb][j]); }
        mx = fmaxf(mx, __shfl_xor(mx, 16)); mx = fmaxf(mx, __shfl_xor(mx, 32));
        const float mnew = fmaxf(mrun, mx); const float alpha = __expf(mrun - mnew); mrun = mnew;
        float ps = 0.f; float pv[2][4];
#pragma unroll
        for (int kb = 0; kb < 2; ++kb)
#pragma unroll
            for (int j = 0; j < 4; ++j) { pv[kb][j] = valid[kb][j] ? __expf(S[kb][j] - mnew) : 0.f; ps += pv[kb][j]; }
        lrun = lrun * alpha + ps;
        u32x4 pw; pw.x = cvt_pk_bf16(pv[0][0], pv[0][1]); pw.y = cvt_pk_bf16(pv[0][2], pv[0][3]); pw.z = cvt_pk_bf16(pv[1][0], pv[1][1]); pw.w = cvt_pk_bf16(pv[1][2], pv[1][3]);
        const bf16x8 Pf = __builtin_bit_cast(bf16x8, pw);
        int vt = rbase + fq * 8; vt = vt > vtmax ? vtmax : vt;
#pragma unroll
        for (int db = 0; db < 4; ++db) {
            Oa[db] = Oa[db] * alpha;
            Oa[db] = __builtin_amdgcn_mfma_f32_16x16x32_bf16(*(const bf16x8*)(LV + (db * 16 + fr) * 264 + vt), Pf, Oa[db], 0, 0, 0);
        }
    }
    lrun += __shfl_xor(lrun, 16); lrun += __shfl_xor(lrun, 32);
    inv = 1.0f / lrun;
}
__device__ __forceinline__ void swa_prompt_block(PP p, unsigned char* smem, int item) {
    const int tid = opaque_tid(), wid = tid >> 6, lane = tid & 63, fr = lane & 15, fq = lane >> 4;
    const int kvh = item & 1, tile = item >> 1;
    const int key0 = tile * 128 - 128;
    bf16_t* LK = (bf16_t*)smem; bf16_t* LV = (bf16_t*)(smem + 256 * 144);
    __syncthreads();
#pragma unroll
    for (int j = 0; j < 4; ++j) {
        const int pi = tid + 512 * j;
        { const int row = pi >> 3, cp = pi & 7; int gr = key0 + row; gr = gr < 0 ? 0 : gr;
          *(u32x4*)(LK + row * 72 + cp * 8) = *(const u32x4*)(p->Kb + (size_t)gr * 128 + kvh * 64 + cp * 8); }
        { const int d = pi >> 5, cp = pi & 31; int gk = key0 + cp * 8; gk = gk < 0 ? 0 : gk;
          *(u32x4*)(LV + d * 264 + cp * 8) = *(const u32x4*)(p->Vt + (size_t)(kvh * 64 + d) * KROWS + gk); }
    }
    __syncthreads();
    const int p0 = tile * 128 + wid * 16, lbase = wid * 16;
    const int cstart = (tile == 0) ? ((128 - lbase) >> 5) : 0;
    const int cmin = (key0 + lbase) < 0 ? -(key0 + lbase) : 0;
#pragma unroll 1
    for (int hh = 0; hh < 4; ++hh) {
        const int head = kvh * 4 + hh;
        const bf16_t* qp = p->Q + (size_t)(p0 + fr) * 512 + head * 64 + fq * 8;
        f32x4 Oa[4]; float inv;
        swa_lds_core(LK, LV, *(const bf16x8*)qp, *(const bf16x8*)(qp + 32), p->sinks[head], fr, lbase, cmin, 255, 248, cstart, Oa, inv, fr, fq);
#pragma unroll
        for (int db = 0; db < 4; ++db) {
            u32x2 w; w.x = cvt_pk_bf16(Oa[db][0] * inv, Oa[db][1] * inv); w.y = cvt_pk_bf16(Oa[db][2] * inv, Oa[db][3] * inv);
            *(u32x2*)(p->O + (size_t)(p0 + fr) * 512 + head * 64 + db * 16 + fq * 4) = w;
        }
    }
}
__device__ __forceinline__ void swa_sample_block(PP p, unsigned char* smem, int item) {
    const int tid = opaque_tid(), wid = tid >> 6, lane = tid & 63, fr = lane & 15, fq = lane >> 4;
    const int kvh = item & 1, b = item >> 1;
    const int row0 = MP + b * SBS;
    bf16_t* LK = (bf16_t*)smem; bf16_t* LV = (bf16_t*)(smem + 256 * 144);
    __syncthreads();
    for (int pi = tid; pi < 1088; pi += 512) {
        { const int row = pi >> 3, cp = pi & 7;
          *(u32x4*)(LK + row * 72 + cp * 8) = *(const u32x4*)(p->Kb + (size_t)(row0 + row) * 128 + kvh * 64 + cp * 8); }
        { const int d = pi / 17, cp = pi - d * 17;
          *(u32x4*)(LV + d * 264 + cp * 8) = *(const u32x4*)(p->Vt + (size_t)(kvh * 64 + d) * KROWS + row0 + cp * 8); }
    }
    __syncthreads();
    if (wid < 2) {
        const int head = kvh * 4 + wid * 2 + (fr >> 3), tq = fr & 7, qrow = MP + b * 8 + tq;
        const bf16_t* qp = p->Q + (size_t)qrow * 512 + head * 64 + fq * 8;
        f32x4 Oa[4]; float inv;
        swa_lds_core(LK, LV, *(const bf16x8*)qp, *(const bf16x8*)(qp + 32), p->sinks[head], tq, 0, 0, 135, 128, 0, Oa, inv, fr, fq);
#pragma unroll
        for (int db = 0; db < 4; ++db) {
            u32x2 w; w.x = cvt_pk_bf16(Oa[db][0] * inv, Oa[db][1] * inv); w.y = cvt_pk_bf16(Oa[db][2] * inv, Oa[db][3] * inv);
            *(u32x2*)(p->O + (size_t)qrow * 512 + head * 64 + db * 16 + fq * 4) = w;
        }
    }
}

__device__ __forceinline__ void ssm_stage_u(const float* U, int row0, int g, int ntok, float* us, int lane) {
    if (lane < ntok) {
        const float* gp = U + (size_t)(row0 + lane) * 512 + g * 16;
        const f32x4 v0 = *(const f32x4*)gp, v1 = *(const f32x4*)(gp + 4), v2 = *(const f32x4*)(gp + 8), v3 = *(const f32x4*)(gp + 12);
        float* up = us + lane * 16;
        *(f32x4*)up = v0; *(f32x4*)(up + 4) = v1; *(f32x4*)(up + 8) = v2; *(f32x4*)(up + 12) = v3;
    }
    wave_lds_sync();
}
__device__ __forceinline__ void ssm_pass1(PP p, unsigned char* smem) {
    const int tid = opaque_tid(), wid = tid >> 6, lane = tid & 63;
    float* hb = (float*)(smem + wid * 12800);
    float* us = (float*)(smem + wid * 12800 + 8704);
    const int tsub = lane >> 4, ch = lane & 15;
    for (int item = blockIdx.x * 8 + wid; item < 8192; item += gridDim.x * 8) {
        const int c = item >> 5, g = item & 31, gn = g * 64 + lane;
        ssm_stage_u(p->U, c * 64, g, 64, us, lane);
        f32x4 bX[8];
#pragma unroll
        for (int cb = 0; cb < 8; ++cb) bX[cb] = *(const f32x4*)(p->ssmtab + 8192 + (size_t)(g * 64 + cb * 8 + (ch >> 1)) * 32 + (ch & 1) * 16 + tsub * 4);
        const float lbr = p->ssmtab[gn * 2], lbi = p->ssmtab[gn * 2 + 1];
        float hr = 0.f, hi = 0.f;
        for (int t0 = 0; t0 < 64; t0 += 16) {
            const f32x4 uA = *(const f32x4*)(us + (t0 + ch) * 16 + tsub * 4);
#pragma unroll
            for (int cb = 0; cb < 8; ++cb) {
                f32x4 xv = (f32x4){0.f, 0.f, 0.f, 0.f};
#pragma unroll
                for (int q = 0; q < 4; ++q) xv = __builtin_amdgcn_mfma_f32_16x16x4f32(uA[q], bX[cb][q], xv, 0, 0, 0);
#pragma unroll
                for (int j = 0; j < 4; ++j) hb[(tsub * 4 + j) * 132 + cb * 16 + ch] = xv[j];
            }
            wave_lds_sync();
            f32x2 xq[16];
#pragma unroll
            for (int t = 0; t < 16; ++t) xq[t] = *(const f32x2*)(hb + t * 132 + lane * 2);
#pragma unroll
            for (int t = 0; t < 16; ++t) { const float nr = lbr * hr - lbi * hi + xq[t][0], ni = lbr * hi + lbi * hr + xq[t][1]; hr = nr; hi = ni; }
            wave_lds_sync();
        }
        p->Schunk[((size_t)c * 2048 + gn) * 2] = hr; p->Schunk[((size_t)c * 2048 + gn) * 2 + 1] = hi;
    }
}
__device__ __forceinline__ void ssm_pass2(PP p) {
    const int gn = blockIdx.x * 512 + opaque_tid();
    if (gn >= 2048) return;
    const float lr = p->ssmtab[4096 + gn * 2], li = p->ssmtab[4096 + gn * 2 + 1];
    float hr = 0.f, hi = 0.f;
#pragma unroll 8
    for (int c = 0; c < 256; ++c) {
        p->Carry[((size_t)c * 2048 + gn) * 2] = hr; p->Carry[((size_t)c * 2048 + gn) * 2 + 1] = hi;
        const float sr = p->Schunk[((size_t)c * 2048 + gn) * 2], si = p->Schunk[((size_t)c * 2048 + gn) * 2 + 1];
        const float nr = lr * hr - li * hi + sr, ni = lr * hi + li * hr + si; hr = nr; hi = ni;
    }
    p->out[OFF_SRP + gn] = hr; p->out[OFF_SIP + gn] = hi;
}
__device__ __forceinline__ void ssm_pass3(PP p, unsigned char* smem, int wg, int nwg) {
    const int tid = opaque_tid(), wid = tid >> 6, lane = tid & 63;
    float* hb = (float*)(smem + wid * 12800);
    float* us = (float*)(smem + wid * 12800 + 8704);
    const int tsub = lane >> 4, ch = lane & 15;
    float cHr = 0.f, cHi = 0.f; int cj = 0, cg = -1;
    f32x4 bX[8]; float cB[32]; float lbr = 0.f, lbi = 0.f, lr = 0.f, li = 0.f, dsk = 0.f; int cgc = -1;
    for (int item = wg * 8 + wid; item < 8192 + 4096; item += nwg * 8) {
        int g, row0, ntok, sb = 0, c = 0; float hr, hi;
        if (item < 8192) { c = item >> 5; g = item & 31; row0 = c * 64; ntok = 64; }
        else { const int it = item - 8192; sb = it >> 5; g = it & 31; row0 = MP + sb * 8; ntok = 8; }
        const int gn = g * 64 + lane;
        f32x4 su0, su1, su2, su3;
        if (lane < ntok) { const float* gp = p->U + (size_t)(row0 + lane) * 512 + g * 16; su0 = *(const f32x4*)gp; su1 = *(const f32x4*)(gp + 4); su2 = *(const f32x4*)(gp + 8); su3 = *(const f32x4*)(gp + 12); }
        if (g != cgc) {
            cgc = g;
#pragma unroll
            for (int cb = 0; cb < 8; ++cb) bX[cb] = *(const f32x4*)(p->ssmtab + 8192 + (size_t)(g * 64 + cb * 8 + (ch >> 1)) * 32 + (ch & 1) * 16 + tsub * 4);
            lbr = p->ssmtab[gn * 2]; lbi = p->ssmtab[gn * 2 + 1]; lr = p->ssmtab[4096 + gn * 2]; li = p->ssmtab[4096 + gn * 2 + 1];
#pragma unroll
            for (int i = 0; i < 4; ++i) { const f32x4 a = *(const f32x4*)(p->c_re + (size_t)(g * 16 + ch) * 64 + tsub * 16 + i * 4), b = *(const f32x4*)(p->c_im + (size_t)(g * 16 + ch) * 64 + tsub * 16 + i * 4);
#pragma unroll
                for (int j = 0; j < 4; ++j) { cB[(i * 4 + j) * 2] = a[j]; cB[(i * 4 + j) * 2 + 1] = -b[j]; } }
            dsk = p->ssm_d[g * 16 + ch];
        }
        if (item < 8192) {
            const float* sp = p->Schunk + (size_t)gn * 2;
            if (g != cg || cj > c) { cHr = 0.f; cHi = 0.f; cj = 0; cg = g; }
            int j = cj;
            for (; j + 32 <= c; j += 32) {
                f32x2 sv[32];
#pragma unroll
                for (int e = 0; e < 32; ++e) sv[e] = *(const f32x2*)(sp + (size_t)(j + e) * 4096);
                __builtin_amdgcn_sched_barrier(0);
#pragma unroll
                for (int e = 0; e < 32; ++e) { const float nr = lr * cHr - li * cHi + sv[e][0], ni = lr * cHi + li * cHr + sv[e][1]; cHr = nr; cHi = ni; }
            }
            for (; j + 8 <= c; j += 8) {
                f32x2 sv[8];
#pragma unroll
                for (int e = 0; e < 8; ++e) sv[e] = *(const f32x2*)(sp + (size_t)(j + e) * 4096);
#pragma unroll
                for (int e = 0; e < 8; ++e) { const float nr = lr * cHr - li * cHi + sv[e][0], ni = lr * cHi + li * cHr + sv[e][1]; cHr = nr; cHi = ni; }
            }
            for (; j < c; ++j) { const float sr = sp[(size_t)j * 4096], si = sp[(size_t)j * 4096 + 1]; const float nr = lr * cHr - li * cHi + sr, ni = lr * cHi + li * cHr + si; cHr = nr; cHi = ni; }
            cj = c; hr = cHr; hi = cHi;
        } else { hr = p->state_re[(size_t)sb * 2048 + gn]; hi = p->state_im[(size_t)sb * 2048 + gn]; }
        if (lane < ntok) { float* up = us + lane * 16; *(f32x4*)up = su0; *(f32x4*)(up + 4) = su1; *(f32x4*)(up + 8) = su2; *(f32x4*)(up + 12) = su3; }
        wave_lds_sync();
        for (int t0 = 0; t0 < ntok; t0 += 16) {
            const int nt = (ntok - t0) < 16 ? (ntok - t0) : 16;
            {
                const f32x4 uA = *(const f32x4*)(us + (t0 + ch) * 16 + tsub * 4);
#pragma unroll
                for (int cb = 0; cb < 8; ++cb) {
                    f32x4 xv = (f32x4){0.f, 0.f, 0.f, 0.f};
#pragma unroll
                    for (int q = 0; q < 4; ++q) xv = __builtin_amdgcn_mfma_f32_16x16x4f32(uA[q], bX[cb][q], xv, 0, 0, 0);
#pragma unroll
                    for (int j = 0; j < 4; ++j) hb[(tsub * 4 + j) * 132 + cb * 16 + ch] = xv[j];
                }
            }
            wave_lds_sync();
            for (int tb = 0; tb < nt; tb += 4) {
                f32x2 xq[4];
#pragma unroll
                for (int tt = 0; tt < 4; ++tt) xq[tt] = *(const f32x2*)(hb + (tb + tt) * 132 + lane * 2);
#pragma unroll
                for (int tt = 0; tt < 4; ++tt) {
                    const float nr = lbr * hr - lbi * hi + xq[tt][0], ni = lbr * hi + lbi * hr + xq[tt][1]; hr = nr; hi = ni;
                    *(f32x2*)(hb + (tb + tt) * 132 + lane * 2) = (f32x2){hr, hi};
                }
            }
            wave_lds_sync();
            {
                f32x4 hA[8];
#pragma unroll
                for (int e = 0; e < 8; ++e) hA[e] = *(const f32x4*)(hb + ch * 132 + tsub * 32 + e * 4);
                f32x4 yv = (f32x4){0.f, 0.f, 0.f, 0.f};
#pragma unroll
                for (int e = 0; e < 8; ++e)
#pragma unroll
                    for (int q = 0; q < 4; ++q) yv = __builtin_amdgcn_mfma_f32_16x16x4f32(hA[e][q], cB[e * 4 + q], yv, 0, 0, 0);
#pragma unroll
                for (int j = 0; j < 4; ++j) {
                    const int t = tsub * 4 + j;
                    if (t < nt) {
                        const int row = row0 + t0 + t;
                        const float uval = us[(t0 + t) * 16 + ch];
                        const float y = yv[j] + dsk * uval;
                        const float inner = 0.7978845608028654f * (y + 0.044715f * y * y * y);
                        const float e2 = __expf(2.0f * inner);
                        const float th = 1.0f - 2.0f * __builtin_amdgcn_rcpf(e2 + 1.0f);
                        const float z = 0.5f * y * (1.0f + th);
                        p->Z[(size_t)row * 512 + g * 16 + ch] = (bf16_t)(cvt_pk_bf16(z, 0.f) & 0xffffu);
                    }
                }
            }
            wave_lds_sync();
        }
        if (item >= 8192) { p->out[OFF_SRS + (size_t)sb * 2048 + gn] = hr; p->out[OFF_SIS + (size_t)sb * 2048 + gn] = hi; }
        else if ((item >> 5) == 255) { p->out[OFF_SRP + gn] = hr; p->out[OFF_SIP + gn] = hi; }
    }
}

__device__ __forceinline__ void xattn_prompt_item(PP p, int item, int lane) {
    const int fr = lane & 15, fq = lane >> 4;
    const int h = item & 3, q0 = (item >> 2) * 16;
    bf16x8 Qf[8];
#pragma unroll
    for (int ks = 0; ks < 8; ++ks) Qf[ks] = *(const bf16x8*)(p->XQ + (size_t)(q0 + fr) * DM + h * 256 + ks * 32 + fq * 8);
    const bf16_t* kbase = p->MK + (size_t)((fr >> 2) * 8 + (fr & 3)) * DM + h * 256 + fq * 8;
    f32x4 S[16];
    bf16x8 Kf[2][8];
#pragma unroll
    for (int ks = 0; ks < 8; ++ks) Kf[0][ks] = *(const bf16x8*)(kbase + ks * 32);
#pragma unroll
    for (int kb = 0; kb < 16; ++kb) {
        if (kb + 1 < 16) {
            const bf16_t* kp = kbase + (size_t)(((kb + 1) >> 1) * 32 + ((kb + 1) & 1) * 4) * DM;
#pragma unroll
            for (int ks = 0; ks < 8; ++ks) Kf[(kb + 1) & 1][ks] = *(const bf16x8*)(kp + ks * 32);
        }
        __builtin_amdgcn_sched_barrier(0);
        S[kb] = (f32x4){0.f, 0.f, 0.f, 0.f};
#pragma unroll
        for (int ks = 0; ks < 8; ++ks) S[kb] = __builtin_amdgcn_mfma_f32_16x16x32_bf16(Kf[kb & 1][ks], Qf[ks], S[kb], 0, 0, 0);
        __builtin_amdgcn_sched_barrier(0);
    }
    float mx = -1e30f;
#pragma unroll
    for (int kb = 0; kb < 16; ++kb)
#pragma unroll
        for (int j = 0; j < 4; ++j) mx = fmaxf(mx, S[kb][j]);
    mx = fmaxf(mx, __shfl_xor(mx, 16)); mx = fmaxf(mx, __shfl_xor(mx, 32));
    float l = 0.f;
#pragma unroll
    for (int kb = 0; kb < 16; ++kb)
#pragma unroll
        for (int j = 0; j < 4; ++j) { S[kb][j] = __expf(S[kb][j] - mx); l += S[kb][j]; }
    l += __shfl_xor(l, 16); l += __shfl_xor(l, 32);
    const float inv = 1.0f / l;
    bf16x8 Pf[8];
#pragma unroll
    for (int kk = 0; kk < 8; ++kk) {
        u32x4 pw; pw.x = cvt_pk_bf16(S[2 * kk][0] * inv, S[2 * kk][1] * inv); pw.y = cvt_pk_bf16(S[2 * kk][2] * inv, S[2 * kk][3] * inv);
        pw.z = cvt_pk_bf16(S[2 * kk + 1][0] * inv, S[2 * kk + 1][1] * inv); pw.w = cvt_pk_bf16(S[2 * kk + 1][2] * inv, S[2 * kk + 1][3] * inv);
        Pf[kk] = __builtin_bit_cast(bf16x8, pw);
    }
    const bf16_t* vbase = p->MVt + (size_t)(h * 256 + fr) * 256 + fq * 8;
    bf16x8 Vf[2][4][4];
#pragma unroll
    for (int k4 = 0; k4 < 4; ++k4)
#pragma unroll
        for (int db = 0; db < 4; ++db) Vf[0][k4][db] = *(const bf16x8*)(vbase + (size_t)db * 16 * 256 + k4 * 32);
    f32x4 Oa[4];
#pragma unroll
    for (int bt = 0; bt < 8; ++bt) {
        const int dh = bt >> 1, kh = bt & 1;
        if (bt + 1 < 8) {
            const int dh1 = (bt + 1) >> 1, kh1 = (bt + 1) & 1;
#pragma unroll
            for (int k4 = 0; k4 < 4; ++k4)
#pragma unroll
                for (int db = 0; db < 4; ++db) Vf[(bt + 1) & 1][k4][db] = *(const bf16x8*)(vbase + (size_t)(dh1 * 64 + db * 16) * 256 + (kh1 * 4 + k4) * 32);
        }
        __builtin_amdgcn_sched_barrier(0);
        if (kh == 0) {
#pragma unroll
            for (int db = 0; db < 4; ++db) Oa[db] = (f32x4){0.f, 0.f, 0.f, 0.f};
        }
#pragma unroll
        for (int k4 = 0; k4 < 4; ++k4)
#pragma unroll
            for (int db = 0; db < 4; ++db) Oa[db] = __builtin_amdgcn_mfma_f32_16x16x32_bf16(Vf[bt & 1][k4][db], Pf[kh * 4 + k4], Oa[db], 0, 0, 0);
        if (kh == 1) {
#pragma unroll
            for (int db = 0; db < 4; ++db) {
                u32x2 w; w.x = cvt_pk_bf16(Oa[db][0], Oa[db][1]); w.y = cvt_pk_bf16(Oa[db][2], Oa[db][3]);
                *(u32x2*)(p->XO + (size_t)(q0 + fr) * DM + h * 256 + dh * 64 + db * 16 + fq * 4) = w;
            }
        }
        __builtin_amdgcn_sched_barrier(0);
    }
}
__device__ __forceinline__ void xattn_prompt_block(PP p, unsigned char* smem, int item) {
    const int tid = opaque_tid(), wid = tid >> 6, lane = tid & 63, fr = lane & 15, fq = lane >> 4;
    const int h = item & 3, q0 = (item >> 2) * 128 + wid * 16;
    bf16_t* L = (bf16_t*)smem;
    bf16x8 Qf[8];
#pragma unroll
    for (int ks = 0; ks < 8; ++ks) Qf[ks] = *(const bf16x8*)(p->XQ + (size_t)(q0 + fr) * DM + h * 256 + ks * 32 + fq * 8);
    f32x4 S[16];
#pragma unroll
    for (int kb = 0; kb < 16; ++kb) S[kb] = (f32x4){0.f, 0.f, 0.f, 0.f};
    u32x4 stg[4];
    const bf16_t* ksrc = p->MK + (size_t)(tid >> 5) * DM + h * 256 + (tid & 31) * 8;
    bf16_t* kdst = L + (tid >> 5) * 264 + (tid & 31) * 8;
#pragma unroll
    for (int j = 0; j < 4; ++j) stg[j] = *(const u32x4*)(ksrc + (size_t)(16 * j) * DM);
    const int krow = (fr >> 2) * 8 + (fr & 3);
#pragma unroll 1
    for (int ck = 0; ck < 4; ++ck) {
        __syncthreads();
#pragma unroll
        for (int j = 0; j < 4; ++j) *(u32x4*)(kdst + (16 * j) * 264) = stg[j];
        __syncthreads();
        if (ck < 3) {
#pragma unroll
            for (int j = 0; j < 4; ++j) stg[j] = *(const u32x4*)(ksrc + (size_t)((ck + 1) * 64 + 16 * j) * DM);
        }
#pragma unroll
        for (int b = 0; b < 4; ++b) {
            const bf16_t* kp = L + ((b >> 1) * 32 + (b & 1) * 4 + krow) * 264 + fq * 8;
            f32x4 acc = (f32x4){0.f, 0.f, 0.f, 0.f};
#pragma unroll
            for (int ks = 0; ks < 8; ++ks) acc = __builtin_amdgcn_mfma_f32_16x16x32_bf16(*(const bf16x8*)(kp + ks * 32), Qf[ks], acc, 0, 0, 0);
#pragma unroll
            for (int c4 = 0; c4 < 4; ++c4) if (c4 == ck) S[c4 * 4 + b] = acc;
        }
    }
    float mx = -1e30f;
#pragma unroll
    for (int kb = 0; kb < 16; ++kb)
#pragma unroll
        for (int j = 0; j < 4; ++j) mx = fmaxf(mx, S[kb][j]);
    mx = fmaxf(mx, __shfl_xor(mx, 16)); mx = fmaxf(mx, __shfl_xor(mx, 32));
    float l = 0.f;
#pragma unroll
    for (int kb = 0; kb < 16; ++kb)
#pragma unroll
        for (int j = 0; j < 4; ++j) { S[kb][j] = __expf(S[kb][j] - mx); l += S[kb][j]; }
    l += __shfl_xor(l, 16); l += __shfl_xor(l, 32);
    const float inv = 1.0f / l;
    bf16x8 Pf[8];
#pragma unroll
    for (int kk = 0; kk < 8; ++kk) {
        u32x4 pw; pw.x = cvt_pk_bf16(S[2 * kk][0] * inv, S[2 * kk][1] * inv); pw.y = cvt_pk_bf16(S[2 * kk][2] * inv, S[2 * kk][3] * inv);
        pw.z = cvt_pk_bf16(S[2 * kk + 1][0] * inv, S[2 * kk + 1][1] * inv); pw.w = cvt_pk_bf16(S[2 * kk + 1][2] * inv, S[2 * kk + 1][3] * inv);
        Pf[kk] = __builtin_bit_cast(bf16x8, pw);
    }
    f32x4 Oa[16];
#pragma unroll
    for (int db = 0; db < 16; ++db) Oa[db] = (f32x4){0.f, 0.f, 0.f, 0.f};
    const bf16_t* vsrc = p->MVt + (size_t)(h * 256 + (tid >> 3)) * 256 + (tid & 7) * 8;
    bf16_t* vdst = L + (tid >> 3) * 72 + (tid & 7) * 8;
#pragma unroll
    for (int j = 0; j < 4; ++j) stg[j] = *(const u32x4*)(vsrc + (size_t)(64 * j) * 256);
#pragma unroll 1
    for (int ck = 0; ck < 4; ++ck) {
        __syncthreads();
#pragma unroll
        for (int j = 0; j < 4; ++j) *(u32x4*)(vdst + (64 * j) * 72) = stg[j];
        __syncthreads();
        if (ck < 3) {
#pragma unroll
            for (int j = 0; j < 4; ++j) stg[j] = *(const u32x4*)(vsrc + (size_t)(64 * j) * 256 + (ck + 1) * 64);
        }
        bf16x8 P0 = Pf[0], P1 = Pf[1];
#pragma unroll
        for (int c4 = 1; c4 < 4; ++c4) if (c4 == ck) { P0 = Pf[2 * c4]; P1 = Pf[2 * c4 + 1]; }
#pragma unroll
        for (int db = 0; db < 16; ++db) {
            const bf16_t* vp = L + (db * 16 + fr) * 72 + fq * 8;
            Oa[db] = __builtin_amdgcn_mfma_f32_16x16x32_bf16(*(const bf16x8*)vp, P0, Oa[db], 0, 0, 0);
            Oa[db] = __builtin_amdgcn_mfma_f32_16x16x32_bf16(*(const bf16x8*)(vp + 32), P1, Oa[db], 0, 0, 0);
        }
    }
#pragma unroll
    for (int db = 0; db < 16; ++db) {
        u32x2 w; w.x = cvt_pk_bf16(Oa[db][0], Oa[db][1]); w.y = cvt_pk_bf16(Oa[db][2], Oa[db][3]);
        *(u32x2*)(p->XO + (size_t)(q0 + fr) * DM + h * 256 + db * 16 + fq * 4) = w;
    }
    __syncthreads();
}
__device__ __forceinline__ bf16x8 cvt8(const f32x4 a, const f32x4 b) { u32x4 w; w.x = cvt_pk_bf16(a[0], a[1]); w.y = cvt_pk_bf16(a[2], a[3]); w.z = cvt_pk_bf16(b[0], b[1]); w.w = cvt_pk_bf16(b[2], b[3]); return __builtin_bit_cast(bf16x8, w); }

__device__ __forceinline__ void xattn_sample(PP p, unsigned char* smem) {
    const int tid = opaque_tid(), wid = tid >> 6, lane = tid & 63, fr = lane & 15, fq = lane >> 4;
    float* sc = (float*)smem;
    float* red = (float*)(smem + 8192);
    for (int item = blockIdx.x; item < 512; item += gridDim.x) {
        const int b = item >> 2, h = item & 3;
        {
            bf16x8 Qf[8];
#pragma unroll
            for (int ks = 0; ks < 8; ++ks) Qf[ks] = *(const bf16x8*)(p->XQ + (size_t)(MP + b * 8 + (fr & 7)) * DM + h * 256 + ks * 32 + fq * 8);
            f32x4 Kr[2][16];
#pragma unroll
            for (int kb = 0; kb < 2; ++kb) {
                const float* kp = p->cache_mem_k + (((size_t)b * 256 + wid * 32 + kb * 16 + fr) * 4 + h) * 256 + fq * 8;
#pragma unroll
                for (int ks = 0; ks < 8; ++ks) { Kr[kb][2 * ks] = *(const f32x4*)(kp + ks * 32); Kr[kb][2 * ks + 1] = *(const f32x4*)(kp + ks * 32 + 4); }
            }
            __builtin_amdgcn_sched_barrier(0);
#pragma unroll
            for (int kb = 0; kb < 2; ++kb) {
                f32x4 S = (f32x4){0.f, 0.f, 0.f, 0.f};
#pragma unroll
                for (int ks = 0; ks < 8; ++ks) S = __builtin_amdgcn_mfma_f32_16x16x32_bf16(cvt8(Kr[kb][2 * ks], Kr[kb][2 * ks + 1]), Qf[ks], S, 0, 0, 0);
                if (fr < 8) *(f32x4*)(sc + fr * 256 + wid * 32 + kb * 16 + fq * 4) = S;
            }
        }
        __syncthreads();
        {
            f32x4 v = *(const f32x4*)(sc + wid * 256 + lane * 4);
            float mx = fmaxf(fmaxf(v[0], v[1]), fmaxf(v[2], v[3]));
#pragma unroll
            for (int o = 1; o < 64; o <<= 1) mx = fmaxf(mx, __shfl_xor(mx, o));
            v[0] = __expf(v[0] - mx); v[1] = __expf(v[1] - mx); v[2] = __expf(v[2] - mx); v[3] = __expf(v[3] - mx);
            float l = v[0] + v[1] + v[2] + v[3];
#pragma unroll
            for (int o = 1; o < 64; o <<= 1) l += __shfl_xor(l, o);
            const float inv = 1.0f / l;
            *(f32x4*)(sc + wid * 256 + lane * 4) = v * inv;
        }
        __syncthreads();
        {
            f32x4 acc[8];
#pragma unroll
            for (int q = 0; q < 8; ++q) acc[q] = (f32x4){0.f, 0.f, 0.f, 0.f};
            const float* vp = p->cache_mem_v + (((size_t)b * 256 + wid * 32) * 4 + h) * 256 + lane * 4;
#pragma unroll 8
            for (int kk = 0; kk < 32; ++kk) {
                const f32x4 vv = *(const f32x4*)(vp + (size_t)kk * 1024);
#pragma unroll
                for (int q = 0; q < 8; ++q) { const float pq = sc[q * 256 + wid * 32 + kk]; acc[q] += vv * pq; }
            }
#pragma unroll
            for (int q = 0; q < 8; ++q) *(f32x4*)(red + ((size_t)wid * 8 + q) * 256 + lane * 4) = acc[q];
        }
        __syncthreads();
        {
            const int q = tid >> 6, d = (tid & 63) * 4;
            f32x4 s = (f32x4){0.f, 0.f, 0.f, 0.f};
#pragma unroll
            for (int w = 0; w < 8; ++w) s += *(const f32x4*)(red + ((size_t)w * 8 + q) * 256 + d);
            u32x2 o; o.x = cvt_pk_bf16(s[0], s[1]); o.y = cvt_pk_bf16(s[2], s[3]);
            *(u32x2*)(p->XO + (size_t)(MP + b * 8 + q) * DM + h * 256 + d) = o;
        }
        __syncthreads();
    }
}

__device__ __forceinline__ void final_norm(PP p) {
    const int tid = opaque_tid(), wid = tid >> 6, lane = tid & 63;
    f32x4 gv[4];
#pragma unroll
    for (int i = 0; i < 4; ++i) gv[i] = *(const f32x4*)(p->g_final + i * 256 + lane * 4);
    for (int r = blockIdx.x * 8 + wid; r < MT; r += gridDim.x * 8) {
        const float rs = rstd_of(p->rowss[4 * MT + r]);
#pragma unroll
        for (int i = 0; i < 4; ++i) {
            const f32x4 v = *(const f32x4*)(p->X + (size_t)r * DM + i * 256 + lane * 4);
            *(f32x4*)(p->out + OFF_Y + (size_t)r * DM + i * 256 + lane * 4) = v * rs * gv[i];
        }
    }
}


#ifndef DBG_STOP
#define DBG_STOP -1
#endif
#if DBG_STOP >= 0
__device__ __forceinline__ void dump_bf16(const bf16_t* buf, int rows, int len, float*& dst) {
    const int tid = opaque_tid(), wid = tid >> 6, lane = tid & 63;
    for (int r = blockIdx.x * 8 + wid; r < rows; r += gridDim.x * 8) {
        float s = 0.f; for (int i = lane; i < len; i += 64) s += __uint_as_float(((unsigned)buf[(size_t)r * len + i]) << 16);
        for (int o = 1; o < 64; o <<= 1) s += __shfl_xor(s, o);
        if (lane == 0) dst[r] = s;
    }
    dst += rows;
}
__device__ __forceinline__ void dump_f32(const float* buf, int rows, int len, float*& dst) {
    const int tid = opaque_tid(), wid = tid >> 6, lane = tid & 63;
    for (int r = blockIdx.x * 8 + wid; r < rows; r += gridDim.x * 8) {
        float s = 0.f; for (int i = lane; i < len; i += 64) s += buf[(size_t)r * len + i];
        for (int o = 1; o < 64; o <<= 1) s += __shfl_xor(s, o);
        if (lane == 0) dst[r] = s;
    }
    dst += rows;
}
__device__ __forceinline__ void zero_f32(float* buf, size_t n) { for (size_t i = (size_t)blockIdx.x * 512 + opaque_tid(); i < n; i += (size_t)gridDim.x * 512) buf[i] = 0.f; }
__device__ __forceinline__ void dbg_dump(PP p, int k) {
    float* out = p->out;
    zero_f32(out + OFF_Y, (size_t)MT * DM);
    if (k < 1) { zero_f32(out + OFF_MKP, 2 * 262144); }
    if (k < 3) { zero_f32(out + OFF_WKP, 2 * 16384); for (int b = blockIdx.x; b < 128; b += gridDim.x) for (int i = opaque_tid(); i < 1024; i += 512) { out[OFF_WKS + ((size_t)b * 128 + 120) * 128 + i] = 0.f; out[OFF_WVS + ((size_t)b * 128 + 120) * 128 + i] = 0.f; } }
    if (k < 5) { zero_f32(out + OFF_SRP, 4096); }
    if (k < 6) { zero_f32(out + OFF_SRS, 2 * 262144); }
    asm volatile("s_waitcnt vmcnt(0)" ::: "memory"); __syncthreads();
}
__device__ __forceinline__ void dbg_dump2(PP p, int k) {
    float* dst = p->out + OFF_Y;
    dump_bf16(p->XB, MT, 1024, dst);
    dump_bf16(p->MEMB, 256, 1024, dst);
    dump_bf16(p->Wt1, 5632, 1024, dst); dump_bf16(p->Wt2, 1024, 2816, dst); dump_bf16(p->Wt3, 3328, 1024, dst); dump_bf16(p->Wt4, 1024, 512, dst); dump_bf16(p->Wt5, 2048, 512, dst);
    dump_bf16(p->Wt6, 1024, 1024, dst); dump_bf16(p->Wt7, 1024, 1024, dst); dump_bf16(p->Wtkv, 2048, 1024, dst); dump_bf16(p->Wt8, 1024, 1024, dst); dump_bf16(p->Wt9, 5632, 1024, dst); dump_bf16(p->Wt10, 1024, 2816, dst);
    dump_f32(p->rope, 16392, 64, dst); dump_f32(p->ssmtab, 2304, 32, dst);
    if (k == 1 || k == 2) dump_bf16(p->ACT, MT, DFF, dst);
    if (k >= 2) { dump_f32(p->X, MT, 1024, dst); dump_f32(p->rowss + MT, 4 * MT / 32, 32, dst); }
    if (k >= 3 && k <= 6) { dump_bf16(p->Q, MT, 512, dst); dump_bf16(p->SG, MT, 2048, dst); dump_bf16(p->Kb, MP, 128, dst); }
    if (k >= 3 && k <= 5) { dump_f32(p->U, MT, 512, dst); }
    if (k >= 4) { dump_bf16(p->O, MT, 512, dst); dump_f32(p->Schunk, 256, 4096, dst); dump_bf16(p->MK, 256, 1024, dst); dump_bf16(p->MVt, 1024, 256, dst); }
    if (k >= 5) { dump_f32(p->TMP, MT, 1024, dst); dump_f32(p->Carry, 256, 4096, dst); }
    if (k >= 6) { dump_bf16(p->Z, MT, 512, dst); }
    if (k >= 7) { dump_bf16(p->MERGED, MT, 1024, dst); }
    if (k >= 9 && k <= 11) { dump_bf16(p->XQ, MT, 1024, dst); }
    if (k == 10 || k == 11) { dump_bf16(p->XO, MT, 1024, dst); }
    if (k == 12 || k == 13) dump_bf16(p->ACT, MT, DFF, dst);
}
#define DBG_CHECK(k) do { if (DBG_STOP == (k)) { dbg_dump(get_pp(), (k)); GSYNC(); dbg_dump2(get_pp(), (k)); return; } } while (0)
#else
#define DBG_CHECK(k) do { } while (0)
#endif

__global__ void __launch_bounds__(512, 2) fwd_megakernel(Params kernarg_params) {
    extern __shared__ __attribute__((aligned(16))) unsigned char smem[];
    LAS unsigned char* lds = (LAS unsigned char*)smem;
    cg::grid_group grid = cg::this_grid();
    const int G = gridDim.x, c = blockIdx.x;
    { unsigned* bar0 = get_pp()->bar; if (blockIdx.x == 0) for (int i = threadIdx.x; i < XCD_BAR_WORDS; i += 512) bar0[i] = 0u; }
    { PP p = get_pp(); phase_prep(p, smem); }
    asm volatile("s_waitcnt vmcnt(0) lgkmcnt(0)" ::: "memory");
    grid.sync();
    __builtin_amdgcn_fence(__ATOMIC_ACQUIRE, "agent");
    asm volatile("s_waitcnt vmcnt(0)" ::: "memory");
    { unsigned* bar0 = get_pp()->bar; if (threadIdx.x == 0) { volatile LAS unsigned* st = (volatile LAS unsigned*)(lds + 131072); st[0] = 0u; st[1] = 0u; (void)xb_add(&bar0[XB_XCNT(xb_xcc_id())], 1u); } }
    __syncthreads();
    DBG_CHECK(0);
    {
        PP p = get_pp();
        pg8::Gemm g{p->XB, p->Wt1, MT, 5632, 1024}; pg8::StaticOrder S; S.init(MT, 5632, G, c); EpiSwiglu E{p->ACT, nullptr};
        pg8::gemm_phase(lds, g, S, E);
        if (G < 64) { const int tid = opaque_tid(); conv_weight_set(p, 1, c * 8 + (tid >> 6), G * 8, tid & 63); }
        else if (c >= G - 40 && c < G - 8) { const int tid = opaque_tid(); conv_weight_set(p, 1, (c - (G - 40)) * 8 + (tid >> 6), 32 * 8, tid & 63); }
        if (G < 8) { pg8::Gemm g2{p->MEMB, p->Wtkv, 256, 2048, 1024}; pg8::StaticOrder S2; S2.init(256, 2048, G, c); EpiMemKV E2{p->out, p->rowss + 5 * MT}; pg8::gemm_phase(lds, g2, S2, E2); }
        else if (c >= G - 8) { pg8::Gemm g2{p->MEMB, p->Wtkv, 256, 2048, 1024}; pg8::StaticOrder S2; S2.init(256, 2048, 8, c - (G - 8)); EpiMemKV E2{p->out, p->rowss + 5 * MT}; pg8::gemm_phase(lds, g2, S2, E2); }
    }
    GSYNC();
    DBG_CHECK(1);
    {
        PP p = get_pp();
        pg8::Gemm g{p->ACT, p->Wt2, MP, 1024, 2816}; pg8::StaticOrder S; S.init(MP, 1024, G, c); EpiResid E{p->x_prompt, p->x_sample, p->X, p->XB, p->rowss + MT, 0.5f};
        pg8::gemm_phase(lds, g, S, E);
        { SmallEpi se{}; se.src = p->x_sample; se.X = p->X; se.XB = p->XB; se.rowss_next = p->rowss + MT; se.scale = 0.5f; small_gemm_sample<0>(smem, p->ACT, p->Wt2, 2816, se); }
        prep_ctx(p, c, G);
    }
    GSYNC();
    DBG_CHECK(2);
    {
        PP p = get_pp();
        pg8::Gemm g{p->XB, p->Wt3, MT, 3328, 1024}; pg8::StaticOrder S; S.init(MT, 3328, G, c); EpiWin E{p};
        pg8::gemm_phase(lds, g, S, E);
        if (G <= 148) { const int tid = opaque_tid(); conv_weight_set(p, 2, c * 8 + (tid >> 6), G * 8, tid & 63); prep_tables(p, c, G); }
        else if (c >= 116) { const int tid = opaque_tid(); conv_weight_set(p, 2, (c - 116) * 8 + (tid >> 6), (G - 116) * 8, tid & 63); prep_tables(p, c - 116, G - 116); }
    }
    GSYNC();
    DBG_CHECK(3);
    {
        PP p = get_pp();
        for (int item = c; item < 256; item += G) swa_prompt_block(p, smem, item);
        for (int item = c; item < 256; item += G) swa_sample_block(p, smem, item);
        __syncthreads();
        ssm_pass1(p, smem);
        memkv_convert(p);
    }
    GSYNC();
    DBG_CHECK(4);
    {
        PP p = get_pp();
        pg8::Gemm g{p->O, p->Wt4, MP, 1024, 512}; pg8::StaticOrder S; S.init(MP, 1024, G, c); EpiAttnUp E{p->TMP, p->SG};
        pg8::gemm_phase(lds, g, S, E);
        { SmallEpi se{}; se.TMP = p->TMP; se.SG = p->SG; small_gemm_sample<2>(smem, p->O, p->Wt4, 512, se); }
        ssm_pass3(p, smem, c, G);
    }
    GSYNC();
    DBG_CHECK(6);
    {
        PP p = get_pp();
        pg8::Gemm g{p->Z, p->Wt5, MP, 2048, 512}; pg8::StaticOrder S; S.init(MP, 2048, G, c); EpiSsmGlu E{p->TMP, p->SG, p->MERGED};
        pg8::gemm_phase(lds, g, S, E);
        { SmallEpi se{}; se.TMP = p->TMP; se.SG = p->SG; se.MERGED = p->MERGED; se.ntn = 32; small_gemm_sample<3>(smem, p->Z, p->Wt5, 512, se); }
    }
    GSYNC();
    DBG_CHECK(7);
    {
        PP p = get_pp();
        pg8::Gemm g{p->MERGED, p->Wt6, MP, 1024, 1024}; pg8::StaticOrder S; S.init(MP, 1024, G, c); EpiResid E{p->X, p->X + (size_t)MP * DM, p->X, p->XB, p->rowss + 2 * MT, 1.0f};
        pg8::gemm_phase(lds, g, S, E);
        { SmallEpi se{}; se.src = p->X + (size_t)MP * DM; se.X = p->X; se.XB = p->XB; se.rowss_next = p->rowss + 2 * MT; se.scale = 1.0f; small_gemm_sample<0>(smem, p->MERGED, p->Wt6, 1024, se); }
    }
    GSYNC();
    DBG_CHECK(8);
    {
        PP p = get_pp();
        pg8::Gemm g{p->XB, p->Wt7, MP, 1024, 1024}; pg8::StaticOrder S; S.init(MP, 1024, G, c); EpiXq E{p->XQ, p->rowss + 2 * MT};
        pg8::gemm_phase(lds, g, S, E);
        { SmallEpi se{}; se.rowss = p->rowss + 2 * MT; se.XQ = p->XQ; small_gemm_sample<1>(smem, p->XB, p->Wt7, 1024, se); }
    }
    GSYNC();
    DBG_CHECK(9);
    {
        PP p = get_pp();
#if defined(DBG_NO_XS)
        for (size_t i = (size_t)blockIdx.x * 512 + opaque_tid(); i < (size_t)1024 * 1024; i += (size_t)gridDim.x * 512) p->XO[(size_t)MP * DM + i] = 0;
#else
        xattn_sample(p, smem);
#endif
        for (int item = c; item < 512; item += G) xattn_prompt_block(p, smem, item);
    }
    GSYNC();
    DBG_CHECK(10);
    {
        PP p = get_pp();
        pg8::Gemm g{p->XO, p->Wt8, MP, 1024, 1024}; pg8::StaticOrder S; S.init(MP, 1024, G, c); EpiResid E{p->X, p->X + (size_t)MP * DM, p->X, p->XB, p->rowss + 3 * MT, 1.0f};
        pg8::gemm_phase(lds, g, S, E);
        { SmallEpi se{}; se.src = p->X + (size_t)MP * DM; se.X = p->X; se.XB = p->XB; se.rowss_next = p->rowss + 3 * MT; se.scale = 1.0f; small_gemm_sample<0>(smem, p->XO, p->Wt8, 1024, se); }
    }
    GSYNC();
    DBG_CHECK(11);
    {
        PP p = get_pp();
        pg8::Gemm g{p->XB, p->Wt9, MT, 5632, 1024}; pg8::StaticOrder S; S.init(MT, 5632, G, c); EpiSwiglu E{p->ACT, p->rowss + 3 * MT};
        pg8::gemm_phase(lds, g, S, E);
    }
    GSYNC();
    DBG_CHECK(12);
    {
        PP p = get_pp();
        pg8::Gemm g{p->ACT, p->Wt10, MP, 1024, 2816}; pg8::StaticOrder S; S.init(MP, 1024, G, c); EpiResid E{p->X, p->X + (size_t)MP * DM, p->X, nullptr, p->rowss + 4 * MT, 0.5f};
        pg8::gemm_phase(lds, g, S, E);
        { SmallEpi se{}; se.src = p->X + (size_t)MP * DM; se.X = p->X; se.XB = nullptr; se.rowss_next = p->rowss + 4 * MT; se.scale = 0.5f; small_gemm_sample<0>(smem, p->ACT, p->Wt10, 2816, se); }
    }
    GSYNC();
    DBG_CHECK(13);
    { PP p = get_pp(); final_norm(p); }
}

extern "C" void kernel_launch(void* const* d_in, const int* in_sizes, int n_in, void* d_out, int out_size, void* d_ws, size_t ws_size, hipStream_t stream) {
    static int grid_blocks = 0;
    if (!grid_blocks) {
        int dev = 0, cus = 0, per_cu = 0;
        hipGetDevice(&dev);
        hipDeviceGetAttribute(&cus, hipDeviceAttributeMultiprocessorCount, dev);
        hipFuncSetAttribute((const void*)fwd_megakernel, hipFuncAttributeMaxDynamicSharedMemorySize, LDS_BYTES);
        hipOccupancyMaxActiveBlocksPerMultiprocessor(&per_cu, (const void*)fwd_megakernel, 512, LDS_BYTES);
        if (per_cu < 1) per_cu = 1;
        grid_blocks = cus * per_cu;
    }
    Params p; memset(&p, 0, sizeof(p));
    const float** ins = (const float**)&p;
    for (int i = 0; i < 36; ++i) ins[i] = (const float*)d_in[i];
    p.out = (float*)d_out;
    unsigned char* w = (unsigned char*)d_ws; size_t off = 0;
    auto take = [&](size_t bytes) { unsigned char* r = w + off; off += (bytes + 255) & ~(size_t)255; return r; };
    p.Wt1 = (bf16_t*)take((size_t)5632 * 1024 * 2); p.Wt2 = (bf16_t*)take((size_t)1024 * 2816 * 2); p.Wt3 = (bf16_t*)take((size_t)3328 * 1024 * 2);
    p.Wt4 = (bf16_t*)take((size_t)1024 * 512 * 2); p.Wt5 = (bf16_t*)take((size_t)2048 * 512 * 2); p.Wt6 = (bf16_t*)take((size_t)1024 * 1024 * 2);
    p.Wt7 = (bf16_t*)take((size_t)1024 * 1024 * 2); p.Wtkv = (bf16_t*)take((size_t)2048 * 1024 * 2); p.Wt8 = (bf16_t*)take((size_t)1024 * 1024 * 2);
    p.Wt9 = (bf16_t*)take((size_t)5632 * 1024 * 2); p.Wt10 = (bf16_t*)take((size_t)1024 * 2816 * 2);
    p.XB = (bf16_t*)take((size_t)MT * 1024 * 2);
    {
        unsigned char* ra = take((size_t)MT * DFF * 2);
        p.ACT = (bf16_t*)ra; p.SG = (bf16_t*)ra; p.Q = (bf16_t*)(ra + (size_t)MT * 2048 * 2);
        p.XQ = (bf16_t*)ra; p.XO = (bf16_t*)(ra + (size_t)MT * 1024 * 2);
    }
    p.Kb = (bf16_t*)take((size_t)KROWS * 128 * 2); p.Vt = (bf16_t*)take((size_t)128 * KROWS * 2);
    p.O = (bf16_t*)take((size_t)MT * 512 * 2); p.Z = (bf16_t*)take((size_t)MT * 512 * 2);
    p.MEMB = (bf16_t*)take((size_t)256 * 1024 * 2); p.MK = (bf16_t*)take((size_t)256 * 1024 * 2); p.MVt = (bf16_t*)take((size_t)1024 * 256 * 2);
    p.X = (float*)take((size_t)MT * 1024 * 4); p.TMP = (float*)take((size_t)MT * 1024 * 4);
    p.U = (float*)take((size_t)MT * 512 * 4); p.MERGED = (bf16_t*)p.U;
    p.rowss = (float*)take((size_t)(5 * MT + 256) * 4); p.rope = (float*)take((size_t)16392 * 64 * 4); p.ssmtab = (float*)take((size_t)(8192 + 2048 * 32) * 4);
    p.Schunk = (float*)take((size_t)256 * 2048 * 2 * 4); p.Carry = (float*)take((size_t)256 * 2048 * 2 * 4);
    p.bar = (unsigned*)take(XCD_BAR_WORDS * 4);
    if (off > ws_size) { fprintf(stderr, "kernel_launch: workspace too small (%zu > %zu)\n", off, ws_size); return; }
    void* args[] = {&p};
    hipError_t e = hipLaunchCooperativeKernel((const void*)fwd_megakernel, dim3(grid_blocks), dim3(512), args, LDS_BYTES, stream);
    if (e != hipSuccess) fprintf(stderr, "cooperative launch failed: %s (grid %d)\n", hipGetErrorString(e), grid_blocks);
}
```

```cpp
#include <hip/hip_runtime.h>
#include <hip/hip_cooperative_groups.h>
#include <cstdio>
#include <cstring>
namespace cg = cooperative_groups;

#define LAS __attribute__((address_space(3)))
typedef unsigned short bf16_t;
typedef short bf16x8 __attribute__((ext_vector_type(8)));
typedef float f32x4 __attribute__((ext_vector_type(4)));
typedef unsigned u32x4 __attribute__((ext_vector_type(4)));
typedef unsigned u32x2 __attribute__((ext_vector_type(2)));
typedef float f32x2 __attribute__((ext_vector_type(2)));

constexpr int MT = 17408, MP = 16384, DM = 1024, DFF = 2816;
constexpr int SBS = 192;
constexpr int KROWS = 16384 + 128 * SBS + 64;
constexpr int LDS_BYTES = 131072 + 16;

constexpr size_t OFF_Y = 0, OFF_WKP = 17825792, OFF_WVP = 17842176, OFF_SRP = 17858560, OFF_SIP = 17860608,
                 OFF_MKP = 17862656, OFF_MVP = 18124800, OFF_WKS = 18386944, OFF_WVS = 20484096, OFF_SRS = 22581248, OFF_SIS = 22843392;

struct Params {
    const float *x_prompt, *x_sample, *cache_win_k, *cache_win_v, *state_re, *state_im, *cache_mem_k, *cache_mem_v, *mem_prompt;
    const float *g_ffn1, *w_ffn1_in, *w_ffn1_out, *g_mix, *w_in, *sinks, *a_re, *a_im, *log_dt, *b_re, *b_im, *c_re, *c_im, *ssm_d;
    const float *w_attn_up, *w_ssm_glu, *w_out, *g_xattn, *g_mem, *w_xq, *w_xk, *w_xv, *w_xo, *g_ffn2, *w_ffn2_in, *w_ffn2_out, *g_final;
    float* out;
    bf16_t *Wt1, *Wt2, *Wt3, *Wt4, *Wt5, *Wt6, *Wt7, *Wtkv, *Wt8, *Wt9, *Wt10;
    bf16_t *XB, *ACT, *Q, *Kb, *Vt, *SG, *O, *Z, *MERGED, *XQ, *XO, *MEMB, *MK, *MVt;
    float *X, *U, *TMP, *rowss, *rope, *ssmtab, *Schunk, *Carry;
    unsigned* bar;
};

typedef const __attribute__((address_space(4))) Params* PP;
__device__ __forceinline__ PP get_pp() { PP p = (PP)__builtin_amdgcn_kernarg_segment_ptr(); asm volatile("" : "+s"(p)); return p; }
typedef __bf16 bf16v2 __attribute__((ext_vector_type(2)));
typedef float f32v2 __attribute__((ext_vector_type(2)));
__device__ __forceinline__ unsigned cvt_pk_bf16(float lo, float hi) { const f32v2 v = {lo, hi}; const bf16v2 b = __builtin_convertvector(v, bf16v2); return __builtin_bit_cast(unsigned, b); }
__device__ __forceinline__ float sigm(float x) { return __builtin_amdgcn_rcpf(1.0f + __expf(-x)); }
__device__ __forceinline__ float rstd_of(float ss) { return rsqrtf(ss * (1.0f / 1024.0f) + 1e-6f); }
__device__ __forceinline__ int opaque_tid() { int t = threadIdx.x; asm volatile("" : "+v"(t)); return t; }
#define XB_TMO      128
#define XB_XCNT(j)  (256  + 64 * (j))
#define XB_XSUB(j)  (1280 + 64 * (j))
#define XB_XGEN(j)  (2304 + 64 * (j))
#define XB_TOP      3328
#define XB_TOPGEN   3392
#define XCD_BAR_WORDS 3456
#define XB_SPIN_CAP (1u << 18)
__device__ __forceinline__ unsigned xb_ld(unsigned* p)              { return __hip_atomic_load(p, __ATOMIC_RELAXED, __HIP_MEMORY_SCOPE_AGENT); }
__device__ __forceinline__ unsigned xb_add(unsigned* p, unsigned v) { return __hip_atomic_fetch_add(p, v, __ATOMIC_RELAXED, __HIP_MEMORY_SCOPE_AGENT); }
__device__ __forceinline__ unsigned xb_xcc_id() { return (unsigned)__builtin_amdgcn_s_getreg((3 << 11) | 20) & 0xFu; }
#define XB_SPIN(cond, bar) do { unsigned _sp = 0; while (cond) { __builtin_amdgcn_s_sleep(1); \
    if ((++_sp & 255u) == 0u) { if (xb_ld(&(bar)[XB_TMO])) break; if (_sp > XB_SPIN_CAP) { atomicAdd(&(bar)[XB_TMO], 1u); break; } } } } while (0)
__device__ __forceinline__ void xcd_barrier_complete(unsigned* bar, unsigned x, unsigned& nloc, unsigned& nx) {
    const unsigned G = gridDim.x * gridDim.y * gridDim.z;
    unsigned sum, cnt, mine, sp = 0u;
    for (;;) {
        sum = 0u; cnt = 0u; mine = 0u;
#pragma unroll
        for (unsigned j = 0; j < 16; ++j) { const unsigned c = xb_ld(&bar[XB_XCNT(j)]); sum += c; cnt += (c > 0u) ? 1u : 0u; mine = (j == x) ? c : mine; }
        if (sum == G) break;
        __builtin_amdgcn_s_sleep(1);
        if ((++sp & 255u) == 0u) { if (xb_ld(&bar[XB_TMO])) break; if (sp > XB_SPIN_CAP) { atomicAdd(&bar[XB_TMO], 1u); break; } }
    }
    nloc = mine > 0u ? mine : 1u; nx = cnt > 0u ? cnt : 1u;
}
__device__ __forceinline__ void xcd_barrier(unsigned* bar, volatile LAS unsigned* st) {
    asm volatile("s_waitcnt vmcnt(0)" ::: "memory");
    __syncthreads();
    if (threadIdx.x == 0) {
        const unsigned x = xb_xcc_id();
        __builtin_amdgcn_s_waitcnt(0);
        unsigned nloc = st[0], nx = st[1];
        if (nloc == 0u) { xcd_barrier_complete(bar, x, nloc, nx); st[0] = nloc; st[1] = nx; }
        const unsigned old = xb_add(&bar[XB_XSUB(x)], 1u);
        const unsigned gen = old / nloc;
        if (old + 1u == (gen + 1u) * nloc) {
            __builtin_amdgcn_fence(__ATOMIC_RELEASE, "agent");
            asm volatile("s_waitcnt vmcnt(0)" ::: "memory");
            const unsigned og = xb_add(&bar[XB_TOP], 1u);
            const unsigned tg = og / nx;
            if (og + 1u == (tg + 1u) * nx) xb_add(&bar[XB_TOPGEN], 1u);
            else XB_SPIN(xb_ld(&bar[XB_TOPGEN]) == tg, bar);
            __builtin_amdgcn_fence(__ATOMIC_ACQUIRE, "agent");
            xb_add(&bar[XB_XGEN(x)], 1u);
            asm volatile("s_waitcnt vmcnt(0)" ::: "memory");
        } else {
            XB_SPIN(xb_ld(&bar[XB_XGEN(x)]) == gen, bar);
            __builtin_amdgcn_fence(__ATOMIC_ACQUIRE, "agent");
            asm volatile("s_waitcnt vmcnt(0)" ::: "memory");
        }
    }
    __syncthreads();
}
#define GSYNC() xcd_barrier(get_pp()->bar, (volatile LAS unsigned*)(lds + 131072))
__device__ __forceinline__ void wave_lds_sync() { asm volatile("s_waitcnt lgkmcnt(0)" ::: "memory"); __builtin_amdgcn_wave_barrier(); }

namespace pg8 {
constexpr int BM = 256, BK = 64, HALF = 128, HTB = HALF * BK * 2, NXCD = 8, WGM = 8;
__device__ __forceinline__ int lds_byte(int r, int c) { const int st = (r >> 4) * 2 + (c >> 5), rr = r & 15, cc = c & 31, ob = rr * 64 + cc * 2; return st * 1024 + (ob ^ (((ob >> 9) & 1) << 5)); }
__device__ __forceinline__ void stage_rc(int b, int& R, int& C) { const int st = b / 1024, sb = b % 1024, swz = sb ^ (((sb >> 9) & 1) << 5); R = (st >> 1) * 16 + swz / 64; C = (st & 1) * 32 + (swz % 64) / 2; }
struct Unit { int pm, pn; };
struct Gemm { const bf16_t* A; const bf16_t* Bt; int M, N, K; };
struct StaticOrder {
    int nM, nN, nwg, G, c;
    __device__ void init(int M, int N, int G_, int c_) { nM = M / BM; nN = N / BM; nwg = nM * nN; G = G_; c = c_; }
    __device__ bool next(int i, Unit& u) const {
        const long L = (long)i * G + c; if (L >= nwg) return false;
        int wgid = (int)L; { const int q = nwg / NXCD, r = nwg % NXCD, xcd = wgid % NXCD, off = wgid / NXCD; wgid = (xcd < r ? xcd * (q + 1) : r * (q + 1) + (xcd - r) * q) + off; }
        const int nig = WGM * nN, gid = wgid / nig, fm = gid * WGM, gsz = (nM - fm) < WGM ? (nM - fm) : WGM;
        u.pm = fm + ((wgid % nig) % gsz); u.pn = (wgid % nig) / gsz; return true;
    }
};

template <class Epi, class Sched>
__device__ __forceinline__ void gemm_phase(LAS unsigned char* lds, const Gemm g, const Sched& S, const Epi& E) {
    const int tid = opaque_tid(), wid = __builtin_amdgcn_readfirstlane(tid >> 6), lane = tid & 63, wr = wid >> 2, wc = wid & 3, fr = lane & 15, fq = lane >> 4;
    const int K = g.K, nt = K / BK;
    unsigned voffA[2];
#pragma unroll
    for (int i = 0; i < 2; ++i) { int R, C; stage_rc(tid * 16 + i * 8192, R, C); voffA[i] = (unsigned)(R * K + C) * 2u; }
    const size_t kstep = (size_t)(BK * 2);
    const size_t hstep = (size_t)HALF * K * 2;
    const size_t tstep = 2 * hstep;
    const unsigned ldsw = (unsigned)wid * 1024u;
    const int aoff = lds_byte(wr * 64 + fr, fq * 8), boff = lds_byte(wc * 32 + fr, fq * 8);
#define PG8_SA(b, h) (((b) * 2 + (h)) * HTB)
#define PG8_SB(b, h) ((4 + (b) * 2 + (h)) * HTB)
#define PG8_STAGE(bufoff, gbase) do { _Pragma("unroll") for (int _i = 0; _i < 2; ++_i) \
        __builtin_amdgcn_global_load_lds((const unsigned*)((const char*)(gbase) + voffA[_i]), (LAS unsigned*)(lds + (bufoff) + ldsw + _i * 8192), 16, 0, 0); } while (0)
#define PG8_LDA(dst, b, h) do { _Pragma("unroll") for (int m = 0; m < 4; ++m) _Pragma("unroll") for (int k = 0; k < 2; ++k) dst[m][k] = *(const LAS bf16x8*)(lds + PG8_SA(b, h) + aoff + m * 2048 + k * 1024); } while (0)
#define PG8_LDB(dst, b, h) do { _Pragma("unroll") for (int n = 0; n < 2; ++n) _Pragma("unroll") for (int k = 0; k < 2; ++k) dst[n][k] = *(const LAS bf16x8*)(lds + PG8_SB(b, h) + boff + n * 2048 + k * 1024); } while (0)
#define PG8_MMA(ai, bj, At, Bt) do { __builtin_amdgcn_s_setprio(1); _Pragma("unroll") for (int m = 0; m < 4; ++m) _Pragma("unroll") for (int n = 0; n < 2; ++n) _Pragma("unroll") for (int k = 0; k < 2; ++k) \
        acc[ai][bj][m][n] = __builtin_amdgcn_mfma_f32_16x16x32_bf16(Bt[n][k], At[m][k], acc[ai][bj][m][n], 0, 0, 0); __builtin_amdgcn_s_setprio(0); } while (0)
#define PG8_WAIT_V(n) asm volatile("s_waitcnt vmcnt(" #n ")" ::: "memory")
#define PG8_WAIT_L(n) asm volatile("s_waitcnt lgkmcnt(" #n ")" ::: "memory")
#define PG8_BAR __builtin_amdgcn_s_barrier()
#define PG8_SCHED __builtin_amdgcn_sched_barrier(0)
    Unit cur, nxt; int ui = 0;
    if (!S.next(0, cur)) return;
    f32x4 acc[2][2][4][2];
#pragma unroll
    for (int a = 0; a < 2; ++a)
#pragma unroll
        for (int b = 0; b < 2; ++b)
#pragma unroll
            for (int m = 0; m < 4; ++m)
#pragma unroll
                for (int n = 0; n < 2; ++n) acc[a][b][m][n] = (f32x4){0.f, 0.f, 0.f, 0.f};
    bf16x8 At[4][2], B0[2][2], B1[2][2];
    const char* cA = (const char*)g.A + (size_t)cur.pm * tstep; const char* cB = (const char*)g.Bt + (size_t)cur.pn * tstep;
    PG8_STAGE(PG8_SB(0, 0), cB); PG8_STAGE(PG8_SA(0, 0), cA); PG8_STAGE(PG8_SB(0, 1), cB + hstep); PG8_STAGE(PG8_SA(0, 1), cA + hstep);
    if (wr == 1) PG8_BAR;
    PG8_WAIT_V(4); PG8_BAR;
    PG8_STAGE(PG8_SB(1, 0), cB + kstep); PG8_STAGE(PG8_SA(1, 0), cA + kstep); PG8_STAGE(PG8_SB(1, 1), cB + hstep + kstep);
    PG8_WAIT_V(6); PG8_BAR;
    for (;;) {
        const bool has_next = S.next(ui + 1, nxt);
        const char* nA = has_next ? (const char*)g.A + (size_t)nxt.pm * tstep : cA; const char* nB = has_next ? (const char*)g.Bt + (size_t)nxt.pn * tstep : cB;
        for (int t = 0; t < nt; t += 2) {
            const bool last = (t == nt - 2);
            const char* a1 = cA + (size_t)(t + 1) * kstep;
            const char* a2 = last ? nA : cA + (size_t)(t + 2) * kstep; const char* b2 = last ? nB : cB + (size_t)(t + 2) * kstep;
            const char* a3 = a2 + kstep; const char* b3 = b2 + kstep;
            PG8_LDB(B0, 0, 0); PG8_SCHED; PG8_LDA(At, 0, 0); PG8_STAGE(PG8_SA(1, 1), a1 + hstep);
            PG8_WAIT_L(8); PG8_BAR; PG8_WAIT_L(0); PG8_MMA(0, 0, At, B0); PG8_BAR; PG8_SCHED;
            PG8_LDB(B1, 0, 1); PG8_STAGE(PG8_SB(0, 0), b2);
            PG8_BAR; PG8_WAIT_L(0); PG8_MMA(0, 1, At, B1); PG8_BAR;
            PG8_LDA(At, 0, 1); PG8_STAGE(PG8_SA(0, 0), a2);
            PG8_BAR; PG8_WAIT_L(0); PG8_MMA(1, 0, At, B0); PG8_BAR; PG8_SCHED;
            PG8_STAGE(PG8_SB(0, 1), b2 + hstep);
            PG8_WAIT_V(6); PG8_BAR; PG8_MMA(1, 1, At, B1); PG8_BAR;
            PG8_LDB(B0, 1, 0); PG8_SCHED; PG8_LDA(At, 1, 0); PG8_STAGE(PG8_SA(0, 1), a2 + hstep);
            PG8_WAIT_L(8); PG8_BAR; PG8_WAIT_L(0); PG8_MMA(0, 0, At, B0); PG8_BAR; PG8_SCHED;
            PG8_LDB(B1, 1, 1); PG8_STAGE(PG8_SB(1, 0), b3);
            PG8_BAR; PG8_WAIT_L(0); PG8_MMA(0, 1, At, B1); PG8_BAR;
            PG8_LDA(At, 1, 1); PG8_STAGE(PG8_SA(1, 0), a3);
            PG8_BAR; PG8_WAIT_L(0); PG8_MMA(1, 0, At, B0); PG8_BAR; PG8_SCHED;
            PG8_STAGE(PG8_SB(1, 1), b3 + hstep);
            PG8_WAIT_V(6); PG8_BAR; PG8_MMA(1, 1, At, B1); PG8_BAR;
        }
        E(acc, cur, wr, wc, fr, fq);
        if (!has_next) break;
#pragma unroll
        for (int a = 0; a < 2; ++a)
#pragma unroll
            for (int b = 0; b < 2; ++b)
#pragma unroll
                for (int m = 0; m < 4; ++m)
#pragma unroll
                    for (int n = 0; n < 2; ++n) acc[a][b][m][n] = (f32x4){0.f, 0.f, 0.f, 0.f};
        cur = nxt; cA = nA; cB = nB; ++ui;
    }
    PG8_WAIT_V(0);
    if (wr == 0) PG8_BAR;
    PG8_BAR;
#undef PG8_SA
#undef PG8_SB
#undef PG8_STAGE
#undef PG8_LDA
#undef PG8_LDB
#undef PG8_MMA
#undef PG8_WAIT_V
#undef PG8_WAIT_L
#undef PG8_BAR
#undef PG8_SCHED
}
}
using pg8::Unit;
typedef f32x4 AccT[2][2][4][2];

struct EpiSwiglu {
    bf16_t* ACT; const float* rowss;
    __device__ __forceinline__ void operator()(const AccT& acc, const Unit& u, int wr, int wc, int fr, int fq) const {
        const int row0 = u.pm * 256 + wr * 64 + fr;
#pragma unroll
        for (int ai = 0; ai < 2; ++ai)
#pragma unroll
            for (int m = 0; m < 4; ++m) {
                const int r = row0 + ai * 128 + m * 16; const float rs = rowss ? rstd_of(rowss[r]) : 1.0f;
#pragma unroll
                for (int bj = 0; bj < 2; ++bj) {
                    const int col = (u.pn * 8 + bj * 4 + wc) * 16 + fq * 4;
                    float o[4];
#pragma unroll
                    for (int j = 0; j < 4; ++j) { const float a = acc[ai][bj][m][0][j] * rs, b = acc[ai][bj][m][1][j] * rs; o[j] = a * sigm(a) * b; }
                    u32x2 w; w.x = cvt_pk_bf16(o[0], o[1]); w.y = cvt_pk_bf16(o[2], o[3]);
                    *(u32x2*)(ACT + (size_t)r * DFF + col) = w;
                }
            }
    }
};
struct EpiResid {
    const float* src0; const float* src1; float* X; bf16_t* XB; float* rowss_next; float scale;
    __device__ __forceinline__ void operator()(const AccT& acc, const Unit& u, int wr, int wc, int fr, int fq) const {
        const int row0 = u.pm * 256 + wr * 64 + fr; const int col0 = u.pn * 256 + wc * 32 + fq * 4;
#pragma unroll
        for (int ai = 0; ai < 2; ++ai)
#pragma unroll
            for (int m = 0; m < 4; ++m) {
                const int r = row0 + ai * 128 + m * 16;
                const float* xs = (r < MP) ? src0 + (size_t)r * DM : src1 + (size_t)(r - MP) * DM;
                float ss = 0.f;
#pragma unroll
                for (int bj = 0; bj < 2; ++bj)
#pragma unroll
                    for (int n = 0; n < 2; ++n) {
                        const int col = col0 + bj * 128 + n * 16;
                        const f32x4 xo = *(const f32x4*)(xs + col);
                        const f32x4 v = xo + acc[ai][bj][m][n] * scale;
                        *(f32x4*)(X + (size_t)r * DM + col) = v;
                        ss += v[0] * v[0] + v[1] * v[1] + v[2] * v[2] + v[3] * v[3];
                        if (XB) { u32x2 w; w.x = cvt_pk_bf16(v[0], v[1]); w.y = cvt_pk_bf16(v[2], v[3]); *(u32x2*)(XB + (size_t)r * DM + col) = w; }
                    }
                ss += __shfl_xor(ss, 16); ss += __shfl_xor(ss, 32);
                if (fq == 0) __hip_atomic_fetch_add(rowss_next + r, ss, __ATOMIC_RELAXED, __HIP_MEMORY_SCOPE_AGENT);
            }
    }
};
struct EpiWin {
    PP P;
    __device__ __forceinline__ void operator()(const AccT& acc, const Unit& u, int wr, int wc, int fr, int fq) const {
        PP p = P; const float* rowss = p->rowss + MT;
        const int row0 = u.pm * 256 + wr * 64 + fr; const int pn = u.pn;
#pragma unroll
        for (int ai = 0; ai < 2; ++ai)
#pragma unroll
            for (int m = 0; m < 4; ++m) {
                const int r = row0 + ai * 128 + m * 16; const float rs = rstd_of(rowss[r]);
                const bool samp = r >= MP; const int rb = (r - MP) >> 3, rt = (r - MP) & 7;
                const int pos = samp ? MP + rt : r;
                const int krow = samp ? MP + rb * SBS + 128 + rt : r;
#pragma unroll
                for (int bj = 0; bj < 2; ++bj) {
                    if (pn < 2 || (pn == 2 && bj == 0)) {
                        const int grp = wc & 1, d = grp * 16 + fq * 4;
                        const f32x4 cs0 = *(const f32x4*)(p->rope + (size_t)pos * 64 + d * 2), cs1 = *(const f32x4*)(p->rope + (size_t)pos * 64 + d * 2 + 4);
                        const float cc[4] = {cs0[0], cs0[2], cs1[0], cs1[2]}, sn[4] = {cs0[1], cs0[3], cs1[1], cs1[3]};
                        float o1[4], o2[4];
#pragma unroll
                        for (int j = 0; j < 4; ++j) { const float x1 = acc[ai][bj][m][0][j] * rs, x2 = acc[ai][bj][m][1][j] * rs; o1[j] = x1 * cc[j] - x2 * sn[j]; o2[j] = x2 * cc[j] + x1 * sn[j]; }
                        if (pn < 2) {
                            const int head = pn * 4 + bj * 2 + (wc >> 1);
                            u32x2 w1, w2; w1.x = cvt_pk_bf16(o1[0] * 0.125f, o1[1] * 0.125f); w1.y = cvt_pk_bf16(o1[2] * 0.125f, o1[3] * 0.125f);
                            w2.x = cvt_pk_bf16(o2[0] * 0.125f, o2[1] * 0.125f); w2.y = cvt_pk_bf16(o2[2] * 0.125f, o2[3] * 0.125f);
                            bf16_t* qp = p->Q + (size_t)r * 512 + head * 64 + d;
                            *(u32x2*)qp = w1; *(u32x2*)(qp + 32) = w2;
                        } else {
                            const int kvh = wc >> 1;
                            u32x2 w1, w2; w1.x = cvt_pk_bf16(o1[0], o1[1]); w1.y = cvt_pk_bf16(o1[2], o1[3]); w2.x = cvt_pk_bf16(o2[0], o2[1]); w2.y = cvt_pk_bf16(o2[2], o2[3]);
                            bf16_t* kp = p->Kb + (size_t)krow * 128 + kvh * 64 + d;
                            *(u32x2*)kp = w1; *(u32x2*)(kp + 32) = w2;
                            float* op = nullptr;
                            if (samp) op = p->out + OFF_WKS + ((size_t)rb * 128 + 120 + rt) * 128 + kvh * 64 + d;
                            else if (r >= MP - 128) op = p->out + OFF_WKP + (size_t)(r - (MP - 128)) * 128 + kvh * 64 + d;
                            if (op) { *(f32x4*)op = (f32x4){o1[0], o1[1], o1[2], o1[3]}; *(f32x4*)(op + 32) = (f32x4){o2[0], o2[1], o2[2], o2[3]}; }
                        }
                    } else if (pn == 2) {
                        const int kvh = wc >> 1;
                        float* op = nullptr;
                        if (samp) op = p->out + OFF_WVS + ((size_t)rb * 128 + 120 + rt) * 128 + kvh * 64;
                        else if (r >= MP - 128) op = p->out + OFF_WVP + (size_t)(r - (MP - 128)) * 128 + kvh * 64;
#pragma unroll
                        for (int n = 0; n < 2; ++n) {
                            const int d = (wc & 1) * 32 + n * 16 + fq * 4;
                            const f32x4 v = acc[ai][bj][m][n] * rs;
#pragma unroll
                            for (int j = 0; j < 4; ++j) p->Vt[(size_t)(kvh * 64 + d + j) * KROWS + krow] = (bf16_t)(cvt_pk_bf16(v[j], 0.f) & 0xffffu);
                            if (op) *(f32x4*)(op + d) = v;
                        }
                    } else if (pn < 5) {
#pragma unroll
                        for (int n = 0; n < 2; ++n) {
                            const int col = (pn - 3) * 256 + bj * 128 + wc * 32 + n * 16 + fq * 4;
                            *(f32x4*)(p->U + (size_t)r * 512 + col) = acc[ai][bj][m][n] * rs;
                        }
                    } else {
                        const int col = (pn - 5) * 256 + bj * 128 + wc * 32 + fq * 8;
                        const f32x4 a = acc[ai][bj][m][0] * rs, b = acc[ai][bj][m][1] * rs;
                        u32x4 w; w.x = cvt_pk_bf16(sigm(a[0]), sigm(a[1])); w.y = cvt_pk_bf16(sigm(a[2]), sigm(a[3]));
                        w.z = cvt_pk_bf16(sigm(b[0]), sigm(b[1])); w.w = cvt_pk_bf16(sigm(b[2]), sigm(b[3]));
                        *(u32x4*)(p->SG + (size_t)r * 2048 + col) = w;
                    }
                }
            }
    }
};
__device__ __forceinline__ f32x4 ld_bf16x4(const bf16_t* ptr) { const u32x2 w = *(const u32x2*)ptr; f32x4 r; r[0] = __uint_as_float(w.x << 16); r[1] = __uint_as_float(w.x & 0xffff0000u); r[2] = __uint_as_float(w.y << 16); r[3] = __uint_as_float(w.y & 0xffff0000u); return r; }
struct EpiAttnUp {
    float* TMP; const bf16_t* SG;
    __device__ __forceinline__ void operator()(const AccT& acc, const Unit& u, int wr, int wc, int fr, int fq) const {
        const int row0 = u.pm * 256 + wr * 64 + fr; const int col0 = u.pn * 256 + wc * 32 + fq * 4;
#pragma unroll
        for (int ai = 0; ai < 2; ++ai)
#pragma unroll
            for (int m = 0; m < 4; ++m) {
                const int r = row0 + ai * 128 + m * 16;
#pragma unroll
                for (int bj = 0; bj < 2; ++bj)
#pragma unroll
                    for (int n = 0; n < 2; ++n) {
                        const int col = col0 + bj * 128 + n * 16;
                        const f32x4 g = ld_bf16x4(SG + (size_t)r * 2048 + col);
                        *(f32x4*)(TMP + (size_t)r * DM + col) = g * acc[ai][bj][m][n];
                    }
            }
    }
};
struct EpiSsmGlu {
    const float* TMP; const bf16_t* SG; bf16_t* MERGED;
    __device__ __forceinline__ void operator()(const AccT& acc, const Unit& u, int wr, int wc, int fr, int fq) const {
        const int row0 = u.pm * 256 + wr * 64 + fr;
#pragma unroll
        for (int ai = 0; ai < 2; ++ai)
#pragma unroll
            for (int m = 0; m < 4; ++m) {
                const int r = row0 + ai * 128 + m * 16;
#pragma unroll
                for (int bj = 0; bj < 2; ++bj) {
                    const int col = (u.pn * 8 + bj * 4 + wc) * 16 + fq * 4;
                    const f32x4 t = *(const f32x4*)(TMP + (size_t)r * DM + col);
                    const f32x4 g = ld_bf16x4(SG + (size_t)r * 2048 + 1024 + col);
                    float o[4];
#pragma unroll
                    for (int j = 0; j < 4; ++j) { const float ga = acc[ai][bj][m][0][j], gb = acc[ai][bj][m][1][j]; o[j] = t[j] + g[j] * ga * sigm(gb); }
                    u32x2 w; w.x = cvt_pk_bf16(o[0], o[1]); w.y = cvt_pk_bf16(o[2], o[3]);
                    *(u32x2*)(MERGED + (size_t)r * DM + col) = w;
                }
            }
    }
};
struct EpiXq {
    bf16_t* XQ; const float* rowss;
    __device__ __forceinline__ void operator()(const AccT& acc, const Unit& u, int wr, int wc, int fr, int fq) const {
        const int row0 = u.pm * 256 + wr * 64 + fr;
#pragma unroll
        for (int ai = 0; ai < 2; ++ai)
#pragma unroll
            for (int m = 0; m < 4; ++m) {
                const int r = row0 + ai * 128 + m * 16; const float rs = rstd_of(rowss[r]);
#pragma unroll
                for (int bj = 0; bj < 2; ++bj) {
                    const int col = u.pn * 256 + bj * 128 + wc * 32 + fq * 8;
                    const f32x4 a = acc[ai][bj][m][0] * rs, b = acc[ai][bj][m][1] * rs;
                    u32x4 w; w.x = cvt_pk_bf16(a[0], a[1]); w.y = cvt_pk_bf16(a[2], a[3]); w.z = cvt_pk_bf16(b[0], b[1]); w.w = cvt_pk_bf16(b[2], b[3]);
                    *(u32x4*)(XQ + (size_t)r * DM + col) = w;
                }
            }
    }
};
struct EpiMemKV {
    float* out; const float* rowss;
    __device__ __forceinline__ void operator()(const AccT& acc, const Unit& u, int wr, int wc, int fr, int fq) const {
        const int row0 = wr * 64 + fr; const int col0 = (u.pn & 3) * 256 + wc * 32 + fq * 4;
        float* ob = out + (u.pn < 4 ? OFF_MKP : OFF_MVP);
#pragma unroll
        for (int ai = 0; ai < 2; ++ai)
#pragma unroll
            for (int m = 0; m < 4; ++m) {
                const int r = row0 + ai * 128 + m * 16;
#pragma unroll
                for (int bj = 0; bj < 2; ++bj)
#pragma unroll
                    for (int n = 0; n < 2; ++n) *(f32x4*)(ob + (size_t)r * DM + col0 + bj * 128 + n * 16) = acc[ai][bj][m][n];
            }
    }
};
__device__ __forceinline__ void memkv_convert(PP p) {
    const int gt = blockIdx.x * 512 + opaque_tid(), ntot = gridDim.x * 512;
    for (int i = gt; i < 256 * 1024; i += ntot) p->MK[i] = (bf16_t)(cvt_pk_bf16(p->out[OFF_MKP + i], 0.f) & 0xffffu);
    for (int i = gt; i < 256 * 1024; i += ntot) {
        const int r = i & 255, col = i >> 8;
        p->MVt[i] = (bf16_t)(cvt_pk_bf16(p->out[OFF_MVP + (size_t)r * 1024 + col], 0.f) & 0xffffu);
    }
}

struct SmallEpi { const float* src; float* X; bf16_t* XB; float* rowss_next; float scale; const float* rowss; bf16_t* XQ; float* TMP; const bf16_t* SG; bf16_t* MERGED; int ntn; };
template <int EP>
__device__ __forceinline__ void small_gemm_sample(unsigned char* smem, const bf16_t* A, const bf16_t* Bt, int K, const SmallEpi E) {
    const int tid = opaque_tid(), wid = tid >> 6, lane = tid & 63, fr = lane & 15, fq = lane >> 4;
    float* part = (float*)smem;
    const int nks = K >> 8;
    const int ntn = E.ntn ? E.ntn : 16;
    for (int t = blockIdx.x; t < 16 * ntn; t += gridDim.x) {
        const int tm = t / ntn, tn = t - tm * ntn;
        const bf16_t* ap = A + (size_t)(MP + tm * 64 + fr) * K + wid * (K >> 3) + fq * 8;
        const bf16_t* bp = Bt + (size_t)(tn * 64 + fr) * K + wid * (K >> 3) + fq * 8;
        f32x4 acc[4][4];
#pragma unroll
        for (int mi = 0; mi < 4; ++mi)
#pragma unroll
            for (int ni = 0; ni < 4; ++ni) acc[mi][ni] = (f32x4){0.f, 0.f, 0.f, 0.f};
        bf16x8 Af[2][4], Bf[2][4];
#pragma unroll
        for (int i = 0; i < 4; ++i) { Af[0][i] = *(const bf16x8*)(ap + (size_t)(i * 16) * K); Bf[0][i] = *(const bf16x8*)(bp + (size_t)(i * 16) * K); }
        for (int ks = 0; ks < nks; ks += 2) {
            if (ks + 1 < nks) {
#pragma unroll
                for (int i = 0; i < 4; ++i) { Af[1][i] = *(const bf16x8*)(ap + (size_t)(i * 16) * K + (ks + 1) * 32); Bf[1][i] = *(const bf16x8*)(bp + (size_t)(i * 16) * K + (ks + 1) * 32); }
            }
#pragma unroll
            for (int mi = 0; mi < 4; ++mi)
#pragma unroll
                for (int ni = 0; ni < 4; ++ni) acc[mi][ni] = __builtin_amdgcn_mfma_f32_16x16x32_bf16(Af[0][mi], Bf[0][ni], acc[mi][ni], 0, 0, 0);
            if (ks + 1 < nks) {
                if (ks + 2 < nks) {
#pragma unroll
                    for (int i = 0; i < 4; ++i) { Af[0][i] = *(const bf16x8*)(ap + (size_t)(i * 16) * K + (ks + 2) * 32); Bf[0][i] = *(const bf16x8*)(bp + (size_t)(i * 16) * K + (ks + 2) * 32); }
                }
#pragma unroll
                for (int mi = 0; mi < 4; ++mi)
#pragma unroll
                    for (int ni = 0; ni < 4; ++ni) acc[mi][ni] = __builtin_amdgcn_mfma_f32_16x16x32_bf16(Af[1][mi], Bf[1][ni], acc[mi][ni], 0, 0, 0);
            }
        }
        __syncthreads();
#pragma unroll
        for (int mi = 0; mi < 4; ++mi)
#pragma unroll
            for (int ni = 0; ni < 4; ++ni)
#pragma unroll
                for (int j = 0; j < 4; ++j) part[wid * 4096 + (mi * 16 + fq * 4 + j) * 64 + ni * 16 + fr] = acc[mi][ni][j];
        __syncthreads();
        const int m = tid >> 3, n8 = (tid & 7) * 8;
        f32x4 s0 = (f32x4){0.f, 0.f, 0.f, 0.f}, s1 = s0;
#pragma unroll
        for (int w = 0; w < 8; ++w) { s0 += *(const f32x4*)(part + w * 4096 + m * 64 + n8); s1 += *(const f32x4*)(part + w * 4096 + m * 64 + n8 + 4); }
        const int r = MP + tm * 64 + m, c0 = tn * 64 + n8;
        if (EP == 0) {
            const float* xs = E.src + (size_t)(r - MP) * DM + c0;
            const f32x4 v0 = *(const f32x4*)xs + s0 * E.scale, v1 = *(const f32x4*)(xs + 4) + s1 * E.scale;
            *(f32x4*)(E.X + (size_t)r * DM + c0) = v0; *(f32x4*)(E.X + (size_t)r * DM + c0 + 4) = v1;
            if (E.XB) { u32x4 w; w.x = cvt_pk_bf16(v0[0], v0[1]); w.y = cvt_pk_bf16(v0[2], v0[3]); w.z = cvt_pk_bf16(v1[0], v1[1]); w.w = cvt_pk_bf16(v1[2], v1[3]); *(u32x4*)(E.XB + (size_t)r * DM + c0) = w; }
            float ss = v0[0] * v0[0] + v0[1] * v0[1] + v0[2] * v0[2] + v0[3] * v0[3] + v1[0] * v1[0] + v1[1] * v1[1] + v1[2] * v1[2] + v1[3] * v1[3];
            ss += __shfl_xor(ss, 1); ss += __shfl_xor(ss, 2); ss += __shfl_xor(ss, 4);
            if ((tid & 7) == 0) __hip_atomic_fetch_add(E.rowss_next + r, ss, __ATOMIC_RELAXED, __HIP_MEMORY_SCOPE_AGENT);
        } else if (EP == 1) {
            const float rs = rstd_of(E.rowss[r]);
#pragma unroll
            for (int e = 0; e < 8; ++e) {
                const int cp = c0 + e, sl = cp & 31, nn = sl >> 4, ii = sl & 15; const int col = (cp & ~31) + 8 * (ii >> 2) + 4 * nn + (ii & 3);
                const float v = (e < 4 ? s0[e & 3] : s1[e & 3]) * rs;
                E.XQ[(size_t)r * DM + col] = (bf16_t)(cvt_pk_bf16(v, 0.f) & 0xffffu);
            }
        } else if (EP == 2) {
            const f32x4 g0 = ld_bf16x4(E.SG + (size_t)r * 2048 + c0), g1 = ld_bf16x4(E.SG + (size_t)r * 2048 + c0 + 4);
            *(f32x4*)(E.TMP + (size_t)r * DM + c0) = g0 * s0; *(f32x4*)(E.TMP + (size_t)r * DM + c0 + 4) = g1 * s1;
        } else {
            f32x4 b0, b1;
#pragma unroll
            for (int e = 0; e < 4; ++e) { b0[e] = __shfl_down(s0[e], 2); b1[e] = __shfl_down(s1[e], 2); }
            if ((c0 & 16) == 0) {
                const int o = (c0 >> 5) * 16 + (c0 & 15);
                const f32x4 t0 = *(const f32x4*)(E.TMP + (size_t)r * DM + o), t1 = *(const f32x4*)(E.TMP + (size_t)r * DM + o + 4);
                const f32x4 g0 = ld_bf16x4(E.SG + (size_t)r * 2048 + 1024 + o), g1 = ld_bf16x4(E.SG + (size_t)r * 2048 + 1024 + o + 4);
                float m[8];
#pragma unroll
                for (int e = 0; e < 4; ++e) { m[e] = t0[e] + g0[e] * s0[e] * sigm(b0[e]); m[4 + e] = t1[e] + g1[e] * s1[e] * sigm(b1[e]); }
                u32x4 w; w.x = cvt_pk_bf16(m[0], m[1]); w.y = cvt_pk_bf16(m[2], m[3]); w.z = cvt_pk_bf16(m[4], m[5]); w.w = cvt_pk_bf16(m[6], m[7]);
                *(u32x4*)(E.MERGED + (size_t)r * DM + o) = w;
            }
        }
    }
    __syncthreads();
}

__device__ __forceinline__ int src_col(int mode, int H, int np) {
    if (mode == 3) { if (np < 640) { const int pp = np & 63, grp = pp >> 5, s = pp & 31, n = s >> 4, i = s & 15; return (np & ~63) + grp * 16 + i + n * 32; }
                     if (np < 1280) return np; mode = 1; }
    if (mode == 0) return np;
    const int s = np & 31, n = s >> 4, i = s & 15;
    if (mode == 1) return (np & ~31) + 8 * (i >> 2) + 4 * n + (i & 3);
    return n * H + (np >> 5) * 16 + i;
}
__device__ __forceinline__ void sincos_d(double ang, double& s, double& c) {
    const double x = ang * 0.63661977236758134308;
    const double q = rint(x); const double r = (ang - q * 1.57079632679489655800) - q * 6.12323399573676603587e-17;
    const double r2 = r * r;
    double sp = -7.6471637318198164759e-13; sp = sp * r2 + 1.6059043836821614599e-10; sp = sp * r2 - 2.5052108385441718775e-08; sp = sp * r2 + 2.7557319223985890653e-06;
    sp = sp * r2 - 1.9841269841269841270e-04; sp = sp * r2 + 8.3333333333333332177e-03; sp = sp * r2 - 1.6666666666666665741e-01; sp = r + r * r2 * sp;
    double cp = 4.7794773323873852974e-14; cp = cp * r2 - 1.1470745597729724714e-11; cp = cp * r2 + 2.0876756987868098979e-09; cp = cp * r2 - 2.7557319223985888e-07;
    cp = cp * r2 + 2.4801587301587301566e-05; cp = cp * r2 - 1.3888888888888889419e-03; cp = cp * r2 + 4.1666666666666664354e-02; cp = cp * r2 - 0.5; cp = 1.0 + r2 * cp;
    const int qi = ((int)(long long)q) & 3;
    s = (qi == 0) ? sp : (qi == 1) ? cp : (qi == 2) ? -sp : -cp;
    c = (qi == 0) ? cp : (qi == 1) ? -sp : (qi == 2) ? -cp : sp;
}

__device__ __forceinline__ void conv_weight(const float* src, const float* g, bf16_t* dst, int K, int ld, int Np, int mode, int H, float scale, int tile0, int wv, int nwv, int lane) {
    const int nkt = K >> 6, ntile = (Np >> 8) * nkt;
    for (int t = wv - tile0; t < ntile; t += nwv) {
        if (t < 0) continue;
        const int tn = t / nkt, tk = t - tn * nkt; const int n0 = tn * 256 + lane * 4, k0 = tk * 64;
        const float* sp = src + (size_t)k0 * ld + src_col(mode, H, n0);
        bf16_t* dp = dst + (size_t)n0 * K + k0;
#pragma unroll 1
        for (int ss = 0; ss < 4; ++ss) {
            f32x4 v[16];
#pragma unroll
            for (int e = 0; e < 16; ++e) { const float gv = g ? g[k0 + ss * 16 + e] * scale : scale; v[e] = *(const f32x4*)(sp + (size_t)(ss * 16 + e) * ld) * gv; }
#pragma unroll
            for (int q = 0; q < 4; ++q) {
                u32x4 w0, w1;
                w0.x = cvt_pk_bf16(v[0][q], v[1][q]); w0.y = cvt_pk_bf16(v[2][q], v[3][q]); w0.z = cvt_pk_bf16(v[4][q], v[5][q]); w0.w = cvt_pk_bf16(v[6][q], v[7][q]);
                w1.x = cvt_pk_bf16(v[8][q], v[9][q]); w1.y = cvt_pk_bf16(v[10][q], v[11][q]); w1.z = cvt_pk_bf16(v[12][q], v[13][q]); w1.w = cvt_pk_bf16(v[14][q], v[15][q]);
                *(u32x4*)(dp + (size_t)q * K + ss * 16) = w0; *(u32x4*)(dp + (size_t)q * K + ss * 16 + 8) = w1;
            }
        }
    }
}
__device__ __forceinline__ void conv_weight_set(PP p, int set, int wv, int nwv, int lane) {
    if (set == 0) {
        conv_weight(p->w_ffn1_in, p->g_ffn1, p->Wt1, 1024, 5632, 5632, 2, 2816, 1.f, 0, wv, nwv, lane);
        conv_weight(p->w_xk, p->g_mem, p->Wtkv, 1024, 1024, 1024, 0, 0, 1.f, 352 % nwv, wv, nwv, lane);
        conv_weight(p->w_xv, p->g_mem, p->Wtkv + 1024 * 1024, 1024, 1024, 1024, 0, 0, 1.f, 416 % nwv, wv, nwv, lane);
    } else if (set == 1) {
        conv_weight(p->w_ffn1_out, nullptr, p->Wt2, 2816, 1024, 1024, 0, 0, 1.f, 0, wv, nwv, lane);
        conv_weight(p->w_in, p->g_mix, p->Wt3, 1024, 3328, 3328, 3, 0, 1.f, 176 % nwv, wv, nwv, lane);
    } else {
        conv_weight(p->w_attn_up, nullptr, p->Wt4, 512, 1024, 1024, 0, 0, 1.f, 0, wv, nwv, lane);
        conv_weight(p->w_ssm_glu, nullptr, p->Wt5, 512, 2048, 2048, 2, 1024, 1.f, 32 % nwv, wv, nwv, lane);
        conv_weight(p->w_out, nullptr, p->Wt6, 1024, 1024, 1024, 0, 0, 1.f, 96 % nwv, wv, nwv, lane);
        conv_weight(p->w_xq, p->g_xattn, p->Wt7, 1024, 1024, 1024, 1, 0, 0.0625f, 160 % nwv, wv, nwv, lane);
        conv_weight(p->w_xo, nullptr, p->Wt8, 1024, 1024, 1024, 0, 0, 1.f, 224 % nwv, wv, nwv, lane);
        conv_weight(p->w_ffn2_in, p->g_ffn2, p->Wt9, 1024, 5632, 5632, 2, 2816, 1.f, 288 % nwv, wv, nwv, lane);
        conv_weight(p->w_ffn2_out, nullptr, p->Wt10, 2816, 1024, 1024, 0, 0, 1.f, 640 % nwv, wv, nwv, lane);
    }
}
__device__ __forceinline__ void prep_rope(PP p, int wg, int nwg) {
    const int gt = wg * 512 + opaque_tid(), ntot = nwg * 512;
    for (int i = gt; i < 16392 * 32; i += ntot) {
        const int pos = i >> 5, d = i & 31;
        const double inv = exp(-(double)d * (9.21034037197618273607 / 32.0));
        double s, c; sincos_d((double)pos * inv, s, c);
        p->rope[(size_t)i * 2] = (float)c; p->rope[(size_t)i * 2 + 1] = (float)s;
    }
}
__device__ __forceinline__ void prep_tables(PP p, int wg, int nwg) {
    const int tid = opaque_tid(), wid = tid >> 6, lane = tid & 63;
    const int gw = wg * 8 + wid, nw = nwg * 8;
    const int gt = wg * 512 + tid, ntot = nwg * 512;
    for (int gn = gt; gn < 2048; gn += ntot) {
        const int g = gn >> 6;
        const double are = p->a_re[gn], aim = p->a_im[gn], dt = exp((double)p->log_dt[g]);
        double s, c; sincos_d(aim * dt, s, c); const double mag = exp(are * dt);
        const double lbr = mag * c, lbi = mag * s;
        double s64, c64; sincos_d(aim * dt * 64.0, s64, c64); const double mag64 = exp(are * dt * 64.0);
        const double den = are * are + aim * aim, nr = lbr - 1.0, ni = lbi;
        const double kre = (nr * are + ni * aim) / den, kim = (ni * are - nr * aim) / den;
        float* tb = p->ssmtab;
        tb[gn * 2] = (float)lbr; tb[gn * 2 + 1] = (float)lbi;
        tb[4096 + gn * 2] = (float)(mag64 * c64); tb[4096 + gn * 2 + 1] = (float)(mag64 * s64);
#pragma unroll
        for (int ch = 0; ch < 16; ++ch) {
            const double br = p->b_re[gn * 16 + ch], bi = p->b_im[gn * 16 + ch];
            tb[8192 + gn * 32 + ch] = (float)(kre * br - kim * bi);
            tb[8192 + gn * 32 + 16 + ch] = (float)(kre * bi + kim * br);
        }
    }
}
__device__ __forceinline__ void prep_ctx(PP p, int wg, int nwg) {
    const int tid = opaque_tid(), wid = tid >> 6, lane = tid & 63;
    const int gw = wg * 8 + wid, nw = nwg * 8;
    const int gt = wg * 512 + tid, ntot = nwg * 512;
    for (int i4 = gt; i4 < 128 * 128 * 32; i4 += ntot) {
        const int i = i4 * 4; const int cidx = i & 127, w = (i >> 7) & 127, b = i >> 14;
        const f32x4 kv = *(const f32x4*)(p->cache_win_k + i), vv = *(const f32x4*)(p->cache_win_v + i);
        u32x2 kw; kw.x = cvt_pk_bf16(kv[0], kv[1]); kw.y = cvt_pk_bf16(kv[2], kv[3]);
        *(u32x2*)(p->Kb + (size_t)(MP + b * SBS + w) * 128 + cidx) = kw;
        if (w >= 8) { *(f32x4*)(p->out + OFF_WKS + ((size_t)b * 128 + (w - 8)) * 128 + cidx) = kv; *(f32x4*)(p->out + OFF_WVS + ((size_t)b * 128 + (w - 8)) * 128 + cidx) = vv; }
    }
    for (int it = gw; it < 128 * 2 * 16; it += nw) {
        const int cg8 = it & 15, half = (it >> 4) & 1, b = it >> 5; const int w = half * 64 + lane;
        const float* vp = p->cache_win_v + ((size_t)b * 128 + w) * 128 + cg8 * 8;
        const f32x4 v0 = *(const f32x4*)vp, v1 = *(const f32x4*)(vp + 4);
        bf16_t* dp = p->Vt + (size_t)(cg8 * 8) * KROWS + MP + b * SBS + w;
#pragma unroll
        for (int e = 0; e < 4; ++e) { dp[(size_t)e * KROWS] = (bf16_t)(cvt_pk_bf16(v0[e], 0.f) & 0xffffu); dp[(size_t)(e + 4) * KROWS] = (bf16_t)(cvt_pk_bf16(v1[e], 0.f) & 0xffffu); }
    }
}
__device__ __forceinline__ void phase_prep(PP p, unsigned char* smem) {
    const int tid = opaque_tid(), wid = tid >> 6, lane = tid & 63;
    const int gw = blockIdx.x * 8 + wid, nw = gridDim.x * 8;
    const int gt = blockIdx.x * 512 + tid, ntot = gridDim.x * 512;
    conv_weight_set(p, 0, gw, nw, lane);
    for (int r0 = gw; r0 < MT + 256; r0 += 2 * nw) {
        f32x4 v[2][4]; float ss[2];
#pragma unroll
        for (int q = 0; q < 2; ++q) {
            int r = r0 + q * nw; r = r < MT + 256 ? r : r0;
            const float* xs = (r < MP) ? p->x_prompt + (size_t)r * DM : (r < MT) ? p->x_sample + (size_t)(r - MP) * DM : p->mem_prompt + (size_t)(r - MT) * DM;
            ss[q] = 0.f;
#pragma unroll
            for (int i = 0; i < 4; ++i) { v[q][i] = *(const f32x4*)(xs + i * 256 + lane * 4); ss[q] += v[q][i][0] * v[q][i][0] + v[q][i][1] * v[q][i][1] + v[q][i][2] * v[q][i][2] + v[q][i][3] * v[q][i][3]; }
        }
#pragma unroll
        for (int o = 1; o < 64; o <<= 1) { ss[0] += __shfl_xor(ss[0], o); ss[1] += __shfl_xor(ss[1], o); }
#pragma unroll
        for (int q = 0; q < 2; ++q) {
            const int r = r0 + q * nw; if (r >= MT + 256) continue;
            bf16_t* xb = (r < MT) ? p->XB + (size_t)r * DM : p->MEMB + (size_t)(r - MT) * DM;
            const float rs = rstd_of(ss[q]);
#pragma unroll
            for (int i = 0; i < 4; ++i) { u32x2 w; w.x = cvt_pk_bf16(v[q][i][0] * rs, v[q][i][1] * rs); w.y = cvt_pk_bf16(v[q][i][2] * rs, v[q][i][3] * rs); *(u32x2*)(xb + i * 256 + lane * 4) = w; }
        }
    }
    for (int i = gt; i < 4 * MT; i += ntot) p->rowss[MT + i] = 0.f;
    prep_rope(p, blockIdx.x, gridDim.x);
}

__device__ __forceinline__ bf16x8 mk_bf16x8(u32x2 lo, u32x2 hi) { u32x4 w; w.x = lo.x; w.y = lo.y; w.z = hi.x; w.w = hi.y; return __builtin_bit_cast(bf16x8, w); }

__device__ __forceinline__ void swa_item(PP p, int item, int lane) {
    const int fr = lane & 15, fq = lane >> 4;
    int head, kvh, tq, qrow, krow_base, row_hi;
    if (item < 8192) { head = item & 7; const int p0 = (item >> 3) * 16; kvh = head >> 2; tq = fr; qrow = p0 + fr; krow_base = p0 - 128; row_hi = MP + 127; }
    else { const int it = item - 8192; const int b = it >> 2; kvh = (it >> 1) & 1; head = kvh * 4 + (it & 1) * 2 + (fr >> 3); tq = fr & 7; qrow = MP + b * 8 + tq; krow_base = MP + b * SBS; row_hi = krow_base + 135; }
    const float sink = p->sinks[head];
    const bf16_t* Kb = p->Kb + kvh * 64 + fq * 8;
    const bf16_t* Vt = p->Vt + (size_t)(kvh * 64 + fr) * KROWS;
    bf16x8 Qf[2];
#pragma unroll
    for (int ks = 0; ks < 2; ++ks) Qf[ks] = *(const bf16x8*)(p->Q + (size_t)qrow * 512 + head * 64 + ks * 32 + fq * 8);
    float mrun = sink, lrun = (fq == 0) ? 1.f : 0.f;
    f32x4 Oa[4];
#pragma unroll
    for (int db = 0; db < 4; ++db) Oa[db] = (f32x4){0.f, 0.f, 0.f, 0.f};
    const int koff = (fr >> 2) * 8 + (fr & 3);
    const int cstart = krow_base < 0 ? ((-krow_base) >> 5) : 0;
    bf16x8 Kf[2][2], Vf[4];
    auto load_chunk = [&](int cc) {
        const int rbase = krow_base + cc * 32;
#pragma unroll
        for (int kb = 0; kb < 2; ++kb) {
            int kr = rbase + koff + kb * 4; kr = kr < 0 ? 0 : (kr > row_hi ? row_hi : kr);
            const bf16_t* kp = Kb + (size_t)kr * 128;
            Kf[kb][0] = *(const bf16x8*)kp; Kf[kb][1] = *(const bf16x8*)(kp + 32);
        }
        int vt = rbase + fq * 8; vt = vt < 0 ? 0 : (vt > row_hi - 7 ? row_hi - 7 : vt);
#pragma unroll
        for (int db = 0; db < 4; ++db) Vf[db] = *(const bf16x8*)(Vt + (size_t)db * 16 * KROWS + vt);
    };
    load_chunk(cstart);
    for (int cc = cstart; cc < 5; ++cc) {
        const int c0 = cc * 32;
        f32x4 S[2];
#pragma unroll
        for (int kb = 0; kb < 2; ++kb) {
            S[kb] = __builtin_amdgcn_mfma_f32_16x16x32_bf16(Kf[kb][0], Qf[0], (f32x4){0.f, 0.f, 0.f, 0.f}, 0, 0, 0);
            S[kb] = __builtin_amdgcn_mfma_f32_16x16x32_bf16(Kf[kb][1], Qf[1], S[kb], 0, 0, 0);
        }
        bf16x8 Vc[4];
#pragma unroll
        for (int db = 0; db < 4; ++db) Vc[db] = Vf[db];
        if (cc + 1 < 5) load_chunk(cc + 1);
        bool valid[2][4]; float mx = -1e30f;
#pragma unroll
        for (int kb = 0; kb < 2; ++kb)
#pragma unroll
            for (int j = 0; j < 4; ++j) { const int c = c0 + fq * 8 + kb * 4 + j; valid[kb][j] = (c >= tq) && (c <= 128 + tq) && (krow_base + c >= 0); if (valid[kb][j]) mx = fmaxf(mx, S[kb][j]); }
        mx = fmaxf(mx, __shfl_xor(mx, 16)); mx = fmaxf(mx, __shfl_xor(mx, 32));
        const float mnew = fmaxf(mrun, mx); const float alpha = __expf(mrun - mnew); mrun = mnew;
        float ps = 0.f; float pv[2][4];
#pragma unroll
        for (int kb = 0; kb < 2; ++kb)
#pragma unroll
            for (int j = 0; j < 4; ++j) { pv[kb][j] = valid[kb][j] ? __expf(S[kb][j] - mnew) : 0.f; ps += pv[kb][j]; }
        lrun = lrun * alpha + ps;
        u32x4 pw; pw.x = cvt_pk_bf16(pv[0][0], pv[0][1]); pw.y = cvt_pk_bf16(pv[0][2], pv[0][3]); pw.z = cvt_pk_bf16(pv[1][0], pv[1][1]); pw.w = cvt_pk_bf16(pv[1][2], pv[1][3]);
        const bf16x8 Pf = __builtin_bit_cast(bf16x8, pw);
#pragma unroll
        for (int db = 0; db < 4; ++db) {
            Oa[db] = Oa[db] * alpha;
            Oa[db] = __builtin_amdgcn_mfma_f32_16x16x32_bf16(Vc[db], Pf, Oa[db], 0, 0, 0);
        }
    }
    lrun += __shfl_xor(lrun, 16); lrun += __shfl_xor(lrun, 32);
    const float inv = 1.0f / lrun;
#pragma unroll
    for (int db = 0; db < 4; ++db) {
        u32x2 w; w.x = cvt_pk_bf16(Oa[db][0] * inv, Oa[db][1] * inv); w.y = cvt_pk_bf16(Oa[db][2] * inv, Oa[db][3] * inv);
        *(u32x2*)(p->O + (size_t)qrow * 512 + head * 64 + db * 16 + fq * 4) = w;
    }
}

__device__ __forceinline__ void swa_lds_core(const bf16_t* LK, const bf16_t* LV, const bf16x8 Qf0, const bf16x8 Qf1, float sink, int tq, int lbase, int cmin, int krmax, int vtmax, int cstart,
                                             f32x4 (&Oa)[4], float& inv, int fr, int fq) {
    const int koff = (fr >> 2) * 8 + (fr & 3);
    float mrun = sink, lrun = (fq == 0) ? 1.f : 0.f;
#pragma unroll
    for (int db = 0; db < 4; ++db) Oa[db] = (f32x4){0.f, 0.f, 0.f, 0.f};
    for (int cc = cstart; cc < 5; ++cc) {
        const int c0 = cc * 32, rbase = lbase + c0;
        f32x4 S[2];
#pragma unroll
        for (int kb = 0; kb < 2; ++kb) {
            int kr = rbase + koff + kb * 4; kr = kr > krmax ? krmax : kr;
            const bf16_t* kp = LK + kr * 72 + fq * 8;
            S[kb] = __builtin_amdgcn_mfma_f32_16x16x32_bf16(*(const bf16x8*)kp, Qf0, (f32x4){0.f, 0.f, 0.f, 0.f}, 0, 0, 0);
            S[kb] = __builtin_amdgcn_mfma_f32_16x16x32_bf16(*(const bf16x8*)(kp + 32), Qf1, S[kb], 0, 0, 0);
        }
        bool valid[2][4]; float mx = -1e30f;
#pragma unroll
        for (int kb = 0; kb < 2; ++kb)
#pragma unroll
            for (int j = 0; j < 4; ++j) { const int c = c0 + fq * 8 + kb * 4 + j; valid[kb][j] = (c >= tq) && (c <= 128 + tq) && (c >= cmin); if (valid[kb][j]) mx = fmaxf(mx, S[kb][j]); }
        mx = fmaxf(mx, __shfl_xor(mx, 16)); mx = fmaxf(mx, __shfl_xor(mx, 32));
        const float mnew = fmaxf(mrun, mx); const float alpha = __expf(mrun - mnew); mrun = mnew;
        float ps = 0.f; float pv[2][4];
#pragma unroll
        for (int kb = 0; kb < 2; ++kb)
#pragma unroll
            for (int j = 0; j < 4; ++j) { pv[kb][j] = valid[kb][j] ? __expf(S[kb][j] - mnew) : 0.f; ps += pv[kb][j]; }
        lrun = lrun * alpha + ps;
        u32x4 pw; pw.x = cvt_pk_bf16(pv[0][0], pv[0][1]); pw.y = cvt_pk_bf16(pv[0][2], pv[0][3]); pw.z = cvt_pk_bf16(pv[1][0], pv[1][1]); pw.w = cvt_pk_bf16(pv[1][2], pv[1][3]);
        const bf16x8 Pf = __builtin_bit_cast(bf16x8, pw);
        int vt = rbase + fq * 8; vt = vt > vtmax ? vtmax : vt;
#pragma unroll
        for (int db = 0; db < 4; ++db) {
            Oa[db] = Oa[db] * alpha;
            Oa[db] = __builtin_amdgcn_mfma_f32_16x16x32_bf16(*(const bf16x8*)(LV + (db * 16 + fr) * 264 + vt), Pf, Oa[db], 0, 0, 0);
        }
    }
    lrun += __shfl_xor(lrun, 16); lrun += __shfl_xor(lrun, 32);
    inv = 1.0f / lrun;
}
__device__ __forceinline__ void swa_prompt_block(PP p, unsigned char* smem, int item) {
    const int tid = opaque_tid(), wid = tid >> 6, lane = tid & 63, fr = lane & 15, fq = lane >> 4;
    const int kvh = item & 1, tile = item >> 1;
    const int key0 = tile * 128 - 128;
    bf16_t* LK = (bf16_t*)smem; bf16_t* LV = (bf16_t*)(smem + 256 * 144);
    __syncthreads();
#pragma unroll
    for (int j = 0; j < 4; ++j) {
        const int pi = tid + 512 * j;
        { const int row = pi >> 3, cp = pi & 7; int gr = key0 + row; gr = gr < 0 ? 0 : gr;
          *(u32x4*)(LK + row * 72 + cp * 8) = *(const u32x4*)(p->Kb + (size_t)gr * 128 + kvh * 64 + cp * 8); }
        { const int d = pi >> 5, cp = pi & 31; int gk = key0 + cp * 8; gk = gk < 0 ? 0 : gk;
          *(u32x4*)(LV + d * 264 + cp * 8) = *(const u32x4*)(p->Vt + (size_t)(kvh * 64 + d) * KROWS + gk); }
    }
    __syncthreads();
    const int p0 = tile * 128 + wid * 16, lbase = wid * 16;
    const int cstart = (tile == 0) ? ((128 - lbase) >> 5) : 0;
    const int cmin = (key0 + lbase) < 0 ? -(key0 + lbase) : 0;
#pragma unroll 1
    for (int hh = 0; hh < 4; ++hh) {
        const int head = kvh * 4 + hh;
        const bf16_t* qp = p->Q + (size_t)(p0 + fr) * 512 + head * 64 + fq * 8;
        f32x4 Oa[4]; float inv;
        swa_lds_core(LK, LV, *(const bf16x8*)qp, *(const bf16x8*)(qp + 32), p->sinks[head], fr, lbase, cmin, 255, 248, cstart, Oa, inv, fr, fq);
#pragma unroll
        for (int db = 0; db < 4; ++db) {
            u32x2 w; w.x = cvt_pk_bf16(Oa[db][0] * inv, Oa[db][1] * inv); w.y = cvt_pk_bf16(Oa[db][2] * inv, Oa[db][3] * inv);
            *(u32x2*)(p->O + (size_t)(p0 + fr) * 512 + head * 64 + db * 16 + fq * 4) = w;
        }
    }
}
__device__ __forceinline__ void swa_sample_block(PP p, unsigned char* smem, int item) {
    const int tid = opaque_tid(), wid = tid >> 6, lane = tid & 63, fr = lane & 15, fq = lane >> 4;
    const int kvh = item & 1, b = item >> 1;
    const int row0 = MP + b * SBS;
    bf16_t* LK = (bf16_t*)smem; bf16_t* LV = (bf16_t*)(smem + 256 * 144);
    __syncthreads();
    for (int pi = tid; pi < 1088; pi += 512) {
        { const int row = pi >> 3, cp = pi & 7;
          *(u32x4*)(LK + row * 72 + cp * 8) = *(const u32x4*)(p->Kb + (size_t)(row0 + row) * 128 + kvh * 64 + cp * 8); }
        { const int d = pi / 17, cp = pi - d * 17;
          *(u32x4*)(LV + d * 264 + cp * 8) = *(const u32x4*)(p->Vt + (size_t)(kvh * 64 + d) * KROWS + row0 + cp * 8); }
    }
    __syncthreads();
    if (wid < 2) {
        const int head = kvh * 4 + wid * 2 + (fr >> 3), tq = fr & 7, qrow = MP + b * 8 + tq;
        const bf16_t* qp = p->Q + (size_t)qrow * 512 + head * 64 + fq * 8;
        f32x4 Oa[4]; float inv;
        swa_lds_core(LK, LV, *(const bf16x8*)qp, *(const bf16x8*)(qp + 32), p->sinks[head], tq, 0, 0, 135, 128, 0, Oa, inv, fr, fq);
#pragma unroll
        for (int db = 0; db < 4; ++db) {
            u32x2 w; w.x = cvt_pk_bf16(Oa[db][0] * inv, Oa[db][1] * inv); w.y = cvt_pk_bf16(Oa[db][2] * inv, Oa[db][3] * inv);
            *(u32x2*)(p->O + (size_t)qrow * 512 + head * 64 + db * 16 + fq * 4) = w;
        }
    }
}

__device__ __forceinline__ void ssm_stage_u(const float* U, int row0, int g, int ntok, float* us, int lane) {
    if (lane < ntok) {
        const float* gp = U + (size_t)(row0 + lane) * 512 + g * 16;
        const f32x4 v0 = *(const f32x4*)gp, v1 = *(const f32x4*)(gp + 4), v2 = *(const f32x4*)(gp + 8), v3 = *(const f32x4*)(gp + 12);
        float* up = us + lane * 16;
        *(f32x4*)up = v0; *(f32x4*)(up + 4) = v1; *(f32x4*)(up + 8) = v2; *(f32x4*)(up + 12) = v3;
    }
    wave_lds_sync();
}
__device__ __forceinline__ void ssm_pass1(PP p, unsigned char* smem) {
    const int tid = opaque_tid(), wid = tid >> 6, lane = tid & 63;
    float* hb = (float*)(smem + wid * 12800);
    float* us = (float*)(smem + wid * 12800 + 8704);
    const int tsub = lane >> 4, ch = lane & 15;
    for (int item = blockIdx.x * 8 + wid; item < 8192; item += gridDim.x * 8) {
        const int c = item >> 5, g = item & 31, gn = g * 64 + lane;
        ssm_stage_u(p->U, c * 64, g, 64, us, lane);
        f32x4 bX[8];
#pragma unroll
        for (int cb = 0; cb < 8; ++cb) bX[cb] = *(const f32x4*)(p->ssmtab + 8192 + (size_t)(g * 64 + cb * 8 + (ch >> 1)) * 32 + (ch & 1) * 16 + tsub * 4);
        const float lbr = p->ssmtab[gn * 2], lbi = p->ssmtab[gn * 2 + 1];
        float hr = 0.f, hi = 0.f;
        for (int t0 = 0; t0 < 64; t0 += 16) {
            const f32x4 uA = *(const f32x4*)(us + (t0 + ch) * 16 + tsub * 4);
#pragma unroll
            for (int cb = 0; cb < 8; ++cb) {
                f32x4 xv = (f32x4){0.f, 0.f, 0.f, 0.f};
#pragma unroll
                for (int q = 0; q < 4; ++q) xv = __builtin_amdgcn_mfma_f32_16x16x4f32(uA[q], bX[cb][q], xv, 0, 0, 0);
#pragma unroll
                for (int j = 0; j < 4; ++j) hb[(tsub * 4 + j) * 132 + cb * 16 + ch] = xv[j];
            }
            wave_lds_sync();
            f32x2 xq[16];
#pragma unroll
            for (int t = 0; t < 16; ++t) xq[t] = *(const f32x2*)(hb + t * 132 + lane * 2);
#pragma unroll
            for (int t = 0; t < 16; ++t) { const float nr = lbr * hr - lbi * hi + xq[t][0], ni = lbr * hi + lbi * hr + xq[t][1]; hr = nr; hi = ni; }
            wave_lds_sync();
        }
        p->Schunk[((size_t)c * 2048 + gn) * 2] = hr; p->Schunk[((size_t)c * 2048 + gn) * 2 + 1] = hi;
    }
}
__device__ __forceinline__ void ssm_pass2(PP p) {
    const int gn = blockIdx.x * 512 + opaque_tid();
    if (gn >= 2048) return;
    const float lr = p->ssmtab[4096 + gn * 2], li = p->ssmtab[4096 + gn * 2 + 1];
    float hr = 0.f, hi = 0.f;
#pragma unroll 8
    for (int c = 0; c < 256; ++c) {
        p->Carry[((size_t)c * 2048 + gn) * 2] = hr; p->Carry[((size_t)c * 2048 + gn) * 2 + 1] = hi;
        const float sr = p->Schunk[((size_t)c * 2048 + gn) * 2], si = p->Schunk[((size_t)c * 2048 + gn) * 2 + 1];
        const float nr = lr * hr - li * hi + sr, ni = lr * hi + li * hr + si; hr = nr; hi = ni;
    }
    p->out[OFF_SRP + gn] = hr; p->out[OFF_SIP + gn] = hi;
}
__device__ __forceinline__ void split8(const f32x4 a, const f32x4 b, bf16x8& hi, bf16x8& lo) {
    u32x4 wh; wh.x = cvt_pk_bf16(a[0], a[1]); wh.y = cvt_pk_bf16(a[2], a[3]); wh.z = cvt_pk_bf16(b[0], b[1]); wh.w = cvt_pk_bf16(b[2], b[3]);
    u32x4 wl;
    wl.x = cvt_pk_bf16(a[0] - __uint_as_float(wh.x << 16), a[1] - __uint_as_float(wh.x & 0xffff0000u));
    wl.y = cvt_pk_bf16(a[2] - __uint_as_float(wh.y << 16), a[3] - __uint_as_float(wh.y & 0xffff0000u));
    wl.z = cvt_pk_bf16(b[0] - __uint_as_float(wh.z << 16), b[1] - __uint_as_float(wh.z & 0xffff0000u));
    wl.w = cvt_pk_bf16(b[2] - __uint_as_float(wh.w << 16), b[3] - __uint_as_float(wh.w & 0xffff0000u));
    hi = __builtin_bit_cast(bf16x8, wh); lo = __builtin_bit_cast(bf16x8, wl);
}
__device__ __forceinline__ void ssm_pass3(PP p, unsigned char* smem, int wg, int nwg) {
    const int tid = opaque_tid(), wid = tid >> 6, lane = tid & 63;
    float* hb = (float*)(smem + wid * 12800);
    float* us = (float*)(smem + wid * 12800 + 8704);
    const int tsub = lane >> 4, ch = lane & 15;
    float cHr = 0.f, cHi = 0.f; int cj = 0, cg = -1;
    bf16x8 bX1[8], bX2[8], cBh[4], cBl[4]; float lbr = 0.f, lbi = 0.f, lr = 0.f, li = 0.f, dsk = 0.f; int cgc = -1;
    for (int item = wg * 8 + wid; item < 8192 + 4096; item += nwg * 8) {
        int g, row0, ntok, sb = 0, c = 0; float hr, hi;
        if (item < 8192) { c = item >> 5; g = item & 31; row0 = c * 64; ntok = 64; }
        else { const int it = item - 8192; sb = it >> 5; g = it & 31; row0 = MP + sb * 8; ntok = 8; }
        const int gn = g * 64 + lane;
        f32x4 su0, su1, su2, su3;
        if (lane < ntok) { const float* gp = p->U + (size_t)(row0 + lane) * 512 + g * 16; su0 = *(const f32x4*)gp; su1 = *(const f32x4*)(gp + 4); su2 = *(const f32x4*)(gp + 8); su3 = *(const f32x4*)(gp + 12); }
        if (g != cgc) {
            cgc = g;
#pragma unroll
            for (int cb = 0; cb < 8; ++cb) {
                const float* bp = p->ssmtab + 8192 + (size_t)(g * 64 + cb * 8 + (ch >> 1)) * 32 + (ch & 1) * 16 + (tsub & 1) * 8;
                bf16x8 bh, bl; split8(*(const f32x4*)bp, *(const f32x4*)(bp + 4), bh, bl);
                bX1[cb] = bh; bX2[cb] = (tsub < 2) ? bl : (bf16x8){0, 0, 0, 0, 0, 0, 0, 0};
            }
            lbr = p->ssmtab[gn * 2]; lbi = p->ssmtab[gn * 2 + 1]; lr = p->ssmtab[4096 + gn * 2]; li = p->ssmtab[4096 + gn * 2 + 1];
#pragma unroll
            for (int ks = 0; ks < 4; ++ks) {
                const f32x4 cr = *(const f32x4*)(p->c_re + (size_t)(g * 16 + ch) * 64 + ks * 16 + tsub * 4), ci = *(const f32x4*)(p->c_im + (size_t)(g * 16 + ch) * 64 + ks * 16 + tsub * 4);
                split8((f32x4){cr[0], -ci[0], cr[1], -ci[1]}, (f32x4){cr[2], -ci[2], cr[3], -ci[3]}, cBh[ks], cBl[ks]);
            }
            dsk = p->ssm_d[g * 16 + ch];
        }
        if (item < 8192) {
            const float* sp = p->Schunk + (size_t)gn * 2;
            if (g != cg || cj > c) { cHr = 0.f; cHi = 0.f; cj = 0; cg = g; }
            int j = cj;
            for (; j + 32 <= c; j += 32) {
                f32x2 sv[32];
#pragma unroll
                for (int e = 0; e < 32; ++e) sv[e] = *(const f32x2*)(sp + (size_t)(j + e) * 4096);
                __builtin_amdgcn_sched_barrier(0);
#pragma unroll
                for (int e = 0; e < 32; ++e) { const float nr = lr * cHr - li * cHi + sv[e][0], ni = lr * cHi + li * cHr + sv[e][1]; cHr = nr; cHi = ni; }
            }
            for (; j + 8 <= c; j += 8) {
                f32x2 sv[8];
#pragma unroll
                for (int e = 0; e < 8; ++e) sv[e] = *(const f32x2*)(sp + (size_t)(j + e) * 4096);
#pragma unroll
                for (int e = 0; e < 8; ++e) { const float nr = lr * cHr - li * cHi + sv[e][0], ni = lr * cHi + li * cHr + sv[e][1]; cHr = nr; cHi = ni; }
            }
            for (; j < c; ++j) { const float sr = sp[(size_t)j * 4096], si = sp[(size_t)j * 4096 + 1]; const float nr = lr * cHr - li * cHi + sr, ni = lr * cHi + li * cHr + si; cHr = nr; cHi = ni; }
            cj = c; hr = cHr; hi = cHi;
        } else { hr = p->state_re[(size_t)sb * 2048 + gn]; hi = p->state_im[(size_t)sb * 2048 + gn]; }
        if (lane < ntok) { float* up = us + lane * 16; *(f32x4*)up = su0; *(f32x4*)(up + 4) = su1; *(f32x4*)(up + 8) = su2; *(f32x4*)(up + 12) = su3; }
        wave_lds_sync();
        for (int t0 = 0; t0 < ntok; t0 += 16) {
            const int nt = (ntok - t0) < 16 ? (ntok - t0) : 16;
            {
                const float* up = us + (t0 + ch) * 16 + (tsub & 1) * 8;
                bf16x8 uh, ul; split8(*(const f32x4*)up, *(const f32x4*)(up + 4), uh, ul);
                const bf16x8 uA1 = (tsub < 2) ? uh : ul, uA2 = (tsub < 2) ? uh : (bf16x8){0, 0, 0, 0, 0, 0, 0, 0};
#pragma unroll
                for (int cb = 0; cb < 8; ++cb) {
                    f32x4 xv = __builtin_amdgcn_mfma_f32_16x16x32_bf16(uA1, bX1[cb], (f32x4){0.f, 0.f, 0.f, 0.f}, 0, 0, 0);
                    xv = __builtin_amdgcn_mfma_f32_16x16x32_bf16(uA2, bX2[cb], xv, 0, 0, 0);
#pragma unroll
                    for (int j = 0; j < 4; ++j) hb[(tsub * 4 + j) * 132 + cb * 16 + ch] = xv[j];
                }
            }
            wave_lds_sync();
            for (int tb = 0; tb < nt; tb += 4) {
                f32x2 xq[4];
#pragma unroll
                for (int tt = 0; tt < 4; ++tt) xq[tt] = *(const f32x2*)(hb + (tb + tt) * 132 + lane * 2);
#pragma unroll
                for (int tt = 0; tt < 4; ++tt) {
                    const float nr = lbr * hr - lbi * hi + xq[tt][0], ni = lbr * hi + lbi * hr + xq[tt][1]; hr = nr; hi = ni;
                    *(f32x2*)(hb + (tb + tt) * 132 + lane * 2) = (f32x2){hr, hi};
                }
            }
            wave_lds_sync();
            {
                f32x4 yv = (f32x4){0.f, 0.f, 0.f, 0.f};
#pragma unroll
                for (int ks = 0; ks < 4; ++ks) {
                    const float* hp = hb + ch * 132 + ks * 32 + tsub * 8;
                    bf16x8 hh, hl; split8(*(const f32x4*)hp, *(const f32x4*)(hp + 4), hh, hl);
                    yv = __builtin_amdgcn_mfma_f32_16x16x32_bf16(hh, cBh[ks], yv, 0, 0, 0);
                    yv = __builtin_amdgcn_mfma_f32_16x16x32_bf16(hl, cBh[ks], yv, 0, 0, 0);
                    yv = __builtin_amdgcn_mfma_f32_16x16x32_bf16(hh, cBl[ks], yv, 0, 0, 0);
                }
#pragma unroll
                for (int j = 0; j < 4; ++j) {
                    const int t = tsub * 4 + j;
                    if (t < nt) {
                        const int row = row0 + t0 + t;
                        const float uval = us[(t0 + t) * 16 + ch];
                        const float y = yv[j] + dsk * uval;
                        const float inner = 0.7978845608028654f * (y + 0.044715f * y * y * y);
                        const float e2 = __expf(2.0f * inner);
                        const float th = 1.0f - 2.0f * __builtin_amdgcn_rcpf(e2 + 1.0f);
                        const float z = 0.5f * y * (1.0f + th);
                        p->Z[(size_t)row * 512 + g * 16 + ch] = (bf16_t)(cvt_pk_bf16(z, 0.f) & 0xffffu);
                    }
                }
            }
            wave_lds_sync();
        }
        if (item >= 8192) { p->out[OFF_SRS + (size_t)sb * 2048 + gn] = hr; p->out[OFF_SIS + (size_t)sb * 2048 + gn] = hi; }
        else if ((item >> 5) == 255) { p->out[OFF_SRP + gn] = hr; p->out[OFF_SIP + gn] = hi; }
    }
}

__device__ __forceinline__ void xattn_prompt_item(PP p, int item, int lane) {
    const int fr = lane & 15, fq = lane >> 4;
    const int h = item & 3, q0 = (item >> 2) * 16;
    bf16x8 Qf[8];
#pragma unroll
    for (int ks = 0; ks < 8; ++ks) Qf[ks] = *(const bf16x8*)(p->XQ + (size_t)(q0 + fr) * DM + h * 256 + ks * 32 + fq * 8);
    const bf16_t* kbase = p->MK + (size_t)((fr >> 2) * 8 + (fr & 3)) * DM + h * 256 + fq * 8;
    f32x4 S[16];
    bf16x8 Kf[2][8];
#pragma unroll
    for (int ks = 0; ks < 8; ++ks) Kf[0][ks] = *(const bf16x8*)(kbase + ks * 32);
#pragma unroll
    for (int kb = 0; kb < 16; ++kb) {
        if (kb + 1 < 16) {
            const bf16_t* kp = kbase + (size_t)(((kb + 1) >> 1) * 32 + ((kb + 1) & 1) * 4) * DM;
#pragma unroll
            for (int ks = 0; ks < 8; ++ks) Kf[(kb + 1) & 1][ks] = *(const bf16x8*)(kp + ks * 32);
        }
        __builtin_amdgcn_sched_barrier(0);
        S[kb] = (f32x4){0.f, 0.f, 0.f, 0.f};
#pragma unroll
        for (int ks = 0; ks < 8; ++ks) S[kb] = __builtin_amdgcn_mfma_f32_16x16x32_bf16(Kf[kb & 1][ks], Qf[ks], S[kb], 0, 0, 0);
        __builtin_amdgcn_sched_barrier(0);
    }
    float mx = -1e30f;
#pragma unroll
    for (int kb = 0; kb < 16; ++kb)
#pragma unroll
        for (int j = 0; j < 4; ++j) mx = fmaxf(mx, S[kb][j]);
    mx = fmaxf(mx, __shfl_xor(mx, 16)); mx = fmaxf(mx, __shfl_xor(mx, 32));
    float l = 0.f;
#pragma unroll
    for (int kb = 0; kb < 16; ++kb)
#pragma unroll
        for (int j = 0; j < 4; ++j) { S[kb][j] = __expf(S[kb][j] - mx); l += S[kb][j]; }
    l += __shfl_xor(l, 16); l += __shfl_xor(l, 32);
    const float inv = 1.0f / l;
    bf16x8 Pf[8];
#pragma unroll
    for (int kk = 0; kk < 8; ++kk) {
        u32x4 pw; pw.x = cvt_pk_bf16(S[2 * kk][0] * inv, S[2 * kk][1] * inv); pw.y = cvt_pk_bf16(S[2 * kk][2] * inv, S[2 * kk][3] * inv);
        pw.z = cvt_pk_bf16(S[2 * kk + 1][0] * inv, S[2 * kk + 1][1] * inv); pw.w = cvt_pk_bf16(S[2 * kk + 1][2] * inv, S[2 * kk + 1][3] * inv);
        Pf[kk] = __builtin_bit_cast(bf16x8, pw);
    }
    const bf16_t* vbase = p->MVt + (size_t)(h * 256 + fr) * 256 + fq * 8;
    bf16x8 Vf[2][4][4];
#pragma unroll
    for (int k4 = 0; k4 < 4; ++k4)
#pragma unroll
        for (int db = 0; db < 4; ++db) Vf[0][k4][db] = *(const bf16x8*)(vbase + (size_t)db * 16 * 256 + k4 * 32);
    f32x4 Oa[4];
#pragma unroll
    for (int bt = 0; bt < 8; ++bt) {
        const int dh = bt >> 1, kh = bt & 1;
        if (bt + 1 < 8) {
            const int dh1 = (bt + 1) >> 1, kh1 = (bt + 1) & 1;
#pragma unroll
            for (int k4 = 0; k4 < 4; ++k4)
#pragma unroll
                for (int db = 0; db < 4; ++db) Vf[(bt + 1) & 1][k4][db] = *(const bf16x8*)(vbase + (size_t)(dh1 * 64 + db * 16) * 256 + (kh1 * 4 + k4) * 32);
        }
        __builtin_amdgcn_sched_barrier(0);
        if (kh == 0) {
#pragma unroll
            for (int db = 0; db < 4; ++db) Oa[db] = (f32x4){0.f, 0.f, 0.f, 0.f};
        }
#pragma unroll
        for (int k4 = 0; k4 < 4; ++k4)
#pragma unroll
            for (int db = 0; db < 4; ++db) Oa[db] = __builtin_amdgcn_mfma_f32_16x16x32_bf16(Vf[bt & 1][k4][db], Pf[kh * 4 + k4], Oa[db], 0, 0, 0);
        if (kh == 1) {
#pragma unroll
            for (int db = 0; db < 4; ++db) {
                u32x2 w; w.x = cvt_pk_bf16(Oa[db][0], Oa[db][1]); w.y = cvt_pk_bf16(Oa[db][2], Oa[db][3]);
                *(u32x2*)(p->XO + (size_t)(q0 + fr) * DM + h * 256 + dh * 64 + db * 16 + fq * 4) = w;
            }
        }
        __builtin_amdgcn_sched_barrier(0);
    }
}
__device__ __forceinline__ void xattn_prompt_block(PP p, unsigned char* smem, int item) {
    const int tid = opaque_tid(), wid = tid >> 6, lane = tid & 63, fr = lane & 15, fq = lane >> 4;
    const int h = item & 3, q0 = (item >> 2) * 128 + wid * 16;
    bf16_t* L = (bf16_t*)smem;
    bf16x8 Qf[8];
#pragma unroll
    for (int ks = 0; ks < 8; ++ks) Qf[ks] = *(const bf16x8*)(p->XQ + (size_t)(q0 + fr) * DM + h * 256 + ks * 32 + fq * 8);
    f32x4 S[16];
#pragma unroll
    for (int kb = 0; kb < 16; ++kb) S[kb] = (f32x4){0.f, 0.f, 0.f, 0.f};
    u32x4 stg[4];
    const bf16_t* ksrc = p->MK + (size_t)(tid >> 5) * DM + h * 256 + (tid & 31) * 8;
    bf16_t* kdst = L + (tid >> 5) * 264 + (tid & 31) * 8;
#pragma unroll
    for (int j = 0; j < 4; ++j) stg[j] = *(const u32x4*)(ksrc + (size_t)(16 * j) * DM);
    const int krow = (fr >> 2) * 8 + (fr & 3);
#pragma unroll 1
    for (int ck = 0; ck < 4; ++ck) {
        __syncthreads();
#pragma unroll
        for (int j = 0; j < 4; ++j) *(u32x4*)(kdst + (16 * j) * 264) = stg[j];
        __syncthreads();
        if (ck < 3) {
#pragma unroll
            for (int j = 0; j < 4; ++j) stg[j] = *(const u32x4*)(ksrc + (size_t)((ck + 1) * 64 + 16 * j) * DM);
        }
#pragma unroll
        for (int b = 0; b < 4; ++b) {
            const bf16_t* kp = L + ((b >> 1) * 32 + (b & 1) * 4 + krow) * 264 + fq * 8;
            f32x4 acc = (f32x4){0.f, 0.f, 0.f, 0.f};
#pragma unroll
            for (int ks = 0; ks < 8; ++ks) acc = __builtin_amdgcn_mfma_f32_16x16x32_bf16(*(const bf16x8*)(kp + ks * 32), Qf[ks], acc, 0, 0, 0);
#pragma unroll
            for (int c4 = 0; c4 < 4; ++c4) if (c4 == ck) S[c4 * 4 + b] = acc;
        }
    }
    float mx = -1e30f;
#pragma unroll
    for (int kb = 0; kb < 16; ++kb)
#pragma unroll
        for (int j = 0; j < 4; ++j) mx = fmaxf(mx, S[kb][j]);
    mx = fmaxf(mx, __shfl_xor(mx, 16)); mx = fmaxf(mx, __shfl_xor(mx, 32));
    float l = 0.f;
#pragma unroll
    for (int kb = 0; kb < 16; ++kb)
#pragma unroll
        for (int j = 0; j < 4; ++j) { S[kb][j] = __expf(S[kb][j] - mx); l += S[kb][j]; }
    l += __shfl_xor(l, 16); l += __shfl_xor(l, 32);
    const float inv = 1.0f / l;
    bf16x8 Pf[8];
#pragma unroll
    for (int kk = 0; kk < 8; ++kk) {
        u32x4 pw; pw.x = cvt_pk_bf16(S[2 * kk][0] * inv, S[2 * kk][1] * inv); pw.y = cvt_pk_bf16(S[2 * kk][2] * inv, S[2 * kk][3] * inv);
        pw.z = cvt_pk_bf16(S[2 * kk + 1][0] * inv, S[2 * kk + 1][1] * inv); pw.w = cvt_pk_bf16(S[2 * kk + 1][2] * inv, S[2 * kk + 1][3] * inv);
        Pf[kk] = __builtin_bit_cast(bf16x8, pw);
    }
    f32x4 Oa[16];
#pragma unroll
    for (int db = 0; db < 16; ++db) Oa[db] = (f32x4){0.f, 0.f, 0.f, 0.f};
    const bf16_t* vsrc = p->MVt + (size_t)(h * 256 + (tid >> 3)) * 256 + (tid & 7) * 8;
    bf16_t* vdst = L + (tid >> 3) * 72 + (tid & 7) * 8;
#pragma unroll
    for (int j = 0; j < 4; ++j) stg[j] = *(const u32x4*)(vsrc + (size_t)(64 * j) * 256);
#pragma unroll 1
    for (int ck = 0; ck < 4; ++ck) {
        __syncthreads();
#pragma unroll
        for (int j = 0; j < 4; ++j) *(u32x4*)(vdst + (64 * j) * 72) = stg[j];
        __syncthreads();
        if (ck < 3) {
#pragma unroll
            for (int j = 0; j < 4; ++j) stg[j] = *(const u32x4*)(vsrc + (size_t)(64 * j) * 256 + (ck + 1) * 64);
        }
        bf16x8 P0 = Pf[0], P1 = Pf[1];
#pragma unroll
        for (int c4 = 1; c4 < 4; ++c4) if (c4 == ck) { P0 = Pf[2 * c4]; P1 = Pf[2 * c4 + 1]; }
#pragma unroll
        for (int db = 0; db < 16; ++db) {
            const bf16_t* vp = L + (db * 16 + fr) * 72 + fq * 8;
            Oa[db] = __builtin_amdgcn_mfma_f32_16x16x32_bf16(*(const bf16x8*)vp, P0, Oa[db], 0, 0, 0);
            Oa[db] = __builtin_amdgcn_mfma_f32_16x16x32_bf16(*(const bf16x8*)(vp + 32), P1, Oa[db], 0, 0, 0);
        }
    }
#pragma unroll
    for (int db = 0; db < 16; ++db) {
        u32x2 w; w.x = cvt_pk_bf16(Oa[db][0], Oa[db][1]); w.y = cvt_pk_bf16(Oa[db][2], Oa[db][3]);
        *(u32x2*)(p->XO + (size_t)(q0 + fr) * DM + h * 256 + db * 16 + fq * 4) = w;
    }
    __syncthreads();
}
__device__ __forceinline__ bf16x8 cvt8(const f32x4 a, const f32x4 b) { u32x4 w; w.x = cvt_pk_bf16(a[0], a[1]); w.y = cvt_pk_bf16(a[2], a[3]); w.z = cvt_pk_bf16(b[0], b[1]); w.w = cvt_pk_bf16(b[2], b[3]); return __builtin_bit_cast(bf16x8, w); }

__device__ __forceinline__ void xattn_sample(PP p, unsigned char* smem) {
    const int tid = opaque_tid(), wid = tid >> 6, lane = tid & 63, fr = lane & 15, fq = lane >> 4;
    float* sc = (float*)smem;
    float* red = (float*)(smem + 8192);
    for (int item = blockIdx.x; item < 512; item += gridDim.x) {
        const int b = item >> 2, h = item & 3;
        {
            bf16x8 Qf[8];
#pragma unroll
            for (int ks = 0; ks < 8; ++ks) Qf[ks] = *(const bf16x8*)(p->XQ + (size_t)(MP + b * 8 + (fr & 7)) * DM + h * 256 + ks * 32 + fq * 8);
            f32x4 Kr[2][16];
#pragma unroll
            for (int kb = 0; kb < 2; ++kb) {
                const float* kp = p->cache_mem_k + (((size_t)b * 256 + wid * 32 + kb * 16 + fr) * 4 + h) * 256 + fq * 8;
#pragma unroll
                for (int ks = 0; ks < 8; ++ks) { Kr[kb][2 * ks] = *(const f32x4*)(kp + ks * 32); Kr[kb][2 * ks + 1] = *(const f32x4*)(kp + ks * 32 + 4); }
            }
            __builtin_amdgcn_sched_barrier(0);
#pragma unroll
            for (int kb = 0; kb < 2; ++kb) {
                f32x4 S = (f32x4){0.f, 0.f, 0.f, 0.f};
#pragma unroll
                for (int ks = 0; ks < 8; ++ks) S = __builtin_amdgcn_mfma_f32_16x16x32_bf16(cvt8(Kr[kb][2 * ks], Kr[kb][2 * ks + 1]), Qf[ks], S, 0, 0, 0);
                if (fr < 8) *(f32x4*)(sc + fr * 256 + wid * 32 + kb * 16 + fq * 4) = S;
            }
        }
        __syncthreads();
        {
            f32x4 v = *(const f32x4*)(sc + wid * 256 + lane * 4);
            float mx = fmaxf(fmaxf(v[0], v[1]), fmaxf(v[2], v[3]));
#pragma unroll
            for (int o = 1; o < 64; o <<= 1) mx = fmaxf(mx, __shfl_xor(mx, o));
            v[0] = __expf(v[0] - mx); v[1] = __expf(v[1] - mx); v[2] = __expf(v[2] - mx); v[3] = __expf(v[3] - mx);
            float l = v[0] + v[1] + v[2] + v[3];
#pragma unroll
            for (int o = 1; o < 64; o <<= 1) l += __shfl_xor(l, o);
            const float inv = 1.0f / l;
            *(f32x4*)(sc + wid * 256 + lane * 4) = v * inv;
        }
        __syncthreads();
        {
            f32x4 acc[8];
#pragma unroll
            for (int q = 0; q < 8; ++q) acc[q] = (f32x4){0.f, 0.f, 0.f, 0.f};
            const float* vp = p->cache_mem_v + (((size_t)b * 256 + wid * 32) * 4 + h) * 256 + lane * 4;
#pragma unroll 8
            for (int kk = 0; kk < 32; ++kk) {
                const f32x4 vv = *(const f32x4*)(vp + (size_t)kk * 1024);
#pragma unroll
                for (int q = 0; q < 8; ++q) { const float pq = sc[q * 256 + wid * 32 + kk]; acc[q] += vv * pq; }
            }
#pragma unroll
            for (int q = 0; q < 8; ++q) *(f32x4*)(red + ((size_t)wid * 8 + q) * 256 + lane * 4) = acc[q];
        }
        __syncthreads();
        {
            const int q = tid >> 6, d = (tid & 63) * 4;
            f32x4 s = (f32x4){0.f, 0.f, 0.f, 0.f};
#pragma unroll
            for (int w = 0; w < 8; ++w) s += *(const f32x4*)(red + ((size_t)w * 8 + q) * 256 + d);
            u32x2 o; o.x = cvt_pk_bf16(s[0], s[1]); o.y = cvt_pk_bf16(s[2], s[3]);
            *(u32x2*)(p->XO + (size_t)(MP + b * 8 + q) * DM + h * 256 + d) = o;
        }
        __syncthreads();
    }
}

__device__ __forceinline__ void final_norm(PP p) {
    const int tid = opaque_tid(), wid = tid >> 6, lane = tid & 63;
    f32x4 gv[4];
#pragma unroll
    for (int i = 0; i < 4; ++i) gv[i] = *(const f32x4*)(p->g_final + i * 256 + lane * 4);
    for (int r = blockIdx.x * 8 + wid; r < MT; r += gridDim.x * 8) {
        const float rs = rstd_of(p->rowss[4 * MT + r]);
#pragma unroll
        for (int i = 0; i < 4; ++i) {
            const f32x4 v = *(const f32x4*)(p->X + (size_t)r * DM + i * 256 + lane * 4);
            *(f32x4*)(p->out + OFF_Y + (size_t)r * DM + i * 256 + lane * 4) = v * rs * gv[i];
        }
    }
}


#ifndef DBG_STOP
#define DBG_STOP -1
#endif
#if DBG_STOP >= 0
__device__ __forceinline__ void dump_bf16(const bf16_t* buf, int rows, int len, float*& dst) {
    const int tid = opaque_tid(), wid = tid >> 6, lane = tid & 63;
    for (int r = blockIdx.x * 8 + wid; r < rows; r += gridDim.x * 8) {
        float s = 0.f; for (int i = lane; i < len; i += 64) s += __uint_as_float(((unsigned)buf[(size_t)r * len + i]) << 16);
        for (int o = 1; o < 64; o <<= 1) s += __shfl_xor(s, o);
        if (lane == 0) dst[r] = s;
    }
    dst += rows;
}
__device__ __forceinline__ void dump_f32(const float* buf, int rows, int len, float*& dst) {
    const int tid = opaque_tid(), wid = tid >> 6, lane = tid & 63;
    for (int r = blockIdx.x * 8 + wid; r < rows; r += gridDim.x * 8) {
        float s = 0.f; for (int i = lane; i < len; i += 64) s += buf[(size_t)r * len + i];
        for (int o = 1; o < 64; o <<= 1) s += __shfl_xor(s, o);
        if (lane == 0) dst[r] = s;
    }
    dst += rows;
}
__device__ __forceinline__ void zero_f32(float* buf, size_t n) { for (size_t i = (size_t)blockIdx.x * 512 + opaque_tid(); i < n; i += (size_t)gridDim.x * 512) buf[i] = 0.f; }
__device__ __forceinline__ void dbg_dump(PP p, int k) {
    float* out = p->out;
    zero_f32(out + OFF_Y, (size_t)MT * DM);
    if (k < 1) { zero_f32(out + OFF_MKP, 2 * 262144); }
    if (k < 3) { zero_f32(out + OFF_WKP, 2 * 16384); for (int b = blockIdx.x; b < 128; b += gridDim.x) for (int i = opaque_tid(); i < 1024; i += 512) { out[OFF_WKS + ((size_t)b * 128 + 120) * 128 + i] = 0.f; out[OFF_WVS + ((size_t)b * 128 + 120) * 128 + i] = 0.f; } }
    if (k < 5) { zero_f32(out + OFF_SRP, 4096); }
    if (k < 6) { zero_f32(out + OFF_SRS, 2 * 262144); }
    asm volatile("s_waitcnt vmcnt(0)" ::: "memory"); __syncthreads();
}
__device__ __forceinline__ void dbg_dump2(PP p, int k) {
    float* dst = p->out + OFF_Y;
    dump_bf16(p->XB, MT, 1024, dst);
    dump_bf16(p->MEMB, 256, 1024, dst);
    dump_bf16(p->Wt1, 5632, 1024, dst); dump_bf16(p->Wt2, 1024, 2816, dst); dump_bf16(p->Wt3, 3328, 1024, dst); dump_bf16(p->Wt4, 1024, 512, dst); dump_bf16(p->Wt5, 2048, 512, dst);
    dump_bf16(p->Wt6, 1024, 1024, dst); dump_bf16(p->Wt7, 1024, 1024, dst); dump_bf16(p->Wtkv, 2048, 1024, dst); dump_bf16(p->Wt8, 1024, 1024, dst); dump_bf16(p->Wt9, 5632, 1024, dst); dump_bf16(p->Wt10, 1024, 2816, dst);
    dump_f32(p->rope, 16392, 64, dst); dump_f32(p->ssmtab, 2304, 32, dst);
    if (k == 1 || k == 2) dump_bf16(p->ACT, MT, DFF, dst);
    if (k >= 2) { dump_f32(p->X, MT, 1024, dst); dump_f32(p->rowss + MT, 4 * MT / 32, 32, dst); }
    if (k >= 3 && k <= 6) { dump_bf16(p->Q, MT, 512, dst); dump_bf16(p->SG, MT, 2048, dst); dump_bf16(p->Kb, MP, 128, dst); }
    if (k >= 3 && k <= 5) { dump_f32(p->U, MT, 512, dst); }
    if (k >= 4) { dump_bf16(p->O, MT, 512, dst); dump_f32(p->Schunk, 256, 4096, dst); dump_bf16(p->MK, 256, 1024, dst); dump_bf16(p->MVt, 1024, 256, dst); }
    if (k >= 5) { dump_f32(p->TMP, MT, 1024, dst); dump_f32(p->Carry, 256, 4096, dst); }
    if (k >= 6) { dump_bf16(p->Z, MT, 512, dst); }
    if (k >= 7) { dump_bf16(p->MERGED, MT, 1024, dst); }
    if (k >= 9 && k <= 11) { dump_bf16(p->XQ, MT, 1024, dst); }
    if (k == 10 || k == 11) { dump_bf16(p->XO, MT, 1024, dst); }
    if (k == 12 || k == 13) dump_bf16(p->ACT, MT, DFF, dst);
}
#define DBG_CHECK(k) do { if (DBG_STOP == (k)) { dbg_dump(get_pp(), (k)); GSYNC(); dbg_dump2(get_pp(), (k)); return; } } while (0)
#else
#define DBG_CHECK(k) do { } while (0)
#endif

__global__ void __launch_bounds__(512, 2) fwd_megakernel(Params kernarg_params) {
    extern __shared__ __attribute__((aligned(16))) unsigned char smem[];
    LAS unsigned char* lds = (LAS unsigned char*)smem;
    cg::grid_group grid = cg::this_grid();
    const int G = gridDim.x, c = blockIdx.x;
    { unsigned* bar0 = get_pp()->bar; if (blockIdx.x == 0) for (int i = threadIdx.x; i < XCD_BAR_WORDS; i += 512) bar0[i] = 0u; }
    { PP p = get_pp(); phase_prep(p, smem); }
    asm volatile("s_waitcnt vmcnt(0) lgkmcnt(0)" ::: "memory");
    grid.sync();
    __builtin_amdgcn_fence(__ATOMIC_ACQUIRE, "agent");
    asm volatile("s_waitcnt vmcnt(0)" ::: "memory");
    { unsigned* bar0 = get_pp()->bar; if (threadIdx.x == 0) { volatile LAS unsigned* st = (volatile LAS unsigned*)(lds + 131072); st[0] = 0u; st[1] = 0u; (void)xb_add(&bar0[XB_XCNT(xb_xcc_id())], 1u); } }
    __syncthreads();
    DBG_CHECK(0);
    {
        PP p = get_pp();
        pg8::Gemm g{p->XB, p->Wt1, MT, 5632, 1024}; pg8::StaticOrder S; S.init(MT, 5632, G, c); EpiSwiglu E{p->ACT, nullptr};
        pg8::gemm_phase(lds, g, S, E);
        if (G < 64) { const int tid = opaque_tid(); conv_weight_set(p, 1, c * 8 + (tid >> 6), G * 8, tid & 63); }
        else if (c >= G - 40 && c < G - 8) { const int tid = opaque_tid(); conv_weight_set(p, 1, (c - (G - 40)) * 8 + (tid >> 6), 32 * 8, tid & 63); }
        if (G < 8) { pg8::Gemm g2{p->MEMB, p->Wtkv, 256, 2048, 1024}; pg8::StaticOrder S2; S2.init(256, 2048, G, c); EpiMemKV E2{p->out, p->rowss + 5 * MT}; pg8::gemm_phase(lds, g2, S2, E2); }
        else if (c >= G - 8) { pg8::Gemm g2{p->MEMB, p->Wtkv, 256, 2048, 1024}; pg8::StaticOrder S2; S2.init(256, 2048, 8, c - (G - 8)); EpiMemKV E2{p->out, p->rowss + 5 * MT}; pg8::gemm_phase(lds, g2, S2, E2); }
    }
    GSYNC();
    DBG_CHECK(1);
    {
        PP p = get_pp();
        pg8::Gemm g{p->ACT, p->Wt2, MP, 1024, 2816}; pg8::StaticOrder S; S.init(MP, 1024, G, c); EpiResid E{p->x_prompt, p->x_sample, p->X, p->XB, p->rowss + MT, 0.5f};
        pg8::gemm_phase(lds, g, S, E);
        { SmallEpi se{}; se.src = p->x_sample; se.X = p->X; se.XB = p->XB; se.rowss_next = p->rowss + MT; se.scale = 0.5f; small_gemm_sample<0>(smem, p->ACT, p->Wt2, 2816, se); }
        prep_ctx(p, c, G);
    }
    GSYNC();
    DBG_CHECK(2);
    {
        PP p = get_pp();
        pg8::Gemm g{p->XB, p->Wt3, MT, 3328, 1024}; pg8::StaticOrder S; S.init(MT, 3328, G, c); EpiWin E{p};
        pg8::gemm_phase(lds, g, S, E);
        if (G <= 148) { const int tid = opaque_tid(); conv_weight_set(p, 2, c * 8 + (tid >> 6), G * 8, tid & 63); prep_tables(p, c, G); }
        else if (c >= 116) { const int tid = opaque_tid(); conv_weight_set(p, 2, (c - 116) * 8 + (tid >> 6), (G - 116) * 8, tid & 63); prep_tables(p, c - 116, G - 116); }
    }
    GSYNC();
    DBG_CHECK(3);
    {
        PP p = get_pp();
        for (int item = c; item < 256; item += G) swa_prompt_block(p, smem, item);
        for (int item = c; item < 256; item += G) swa_sample_block(p, smem, item);
        __syncthreads();
        ssm_pass1(p, smem);
        memkv_convert(p);
    }
    GSYNC();
    DBG_CHECK(4);
    {
        PP p = get_pp();
        pg8::Gemm g{p->O, p->Wt4, MP, 1024, 512}; pg8::StaticOrder S; S.init(MP, 1024, G, c); EpiAttnUp E{p->TMP, p->SG};
        pg8::gemm_phase(lds, g, S, E);
        { SmallEpi se{}; se.TMP = p->TMP; se.SG = p->SG; small_gemm_sample<2>(smem, p->O, p->Wt4, 512, se); }
        ssm_pass3(p, smem, c, G);
    }
    GSYNC();
    DBG_CHECK(6);
    {
        PP p = get_pp();
        pg8::Gemm g{p->Z, p->Wt5, MP, 2048, 512}; pg8::StaticOrder S; S.init(MP, 2048, G, c); EpiSsmGlu E{p->TMP, p->SG, p->MERGED};
        pg8::gemm_phase(lds, g, S, E);
        { SmallEpi se{}; se.TMP = p->TMP; se.SG = p->SG; se.MERGED = p->MERGED; se.ntn = 32; small_gemm_sample<3>(smem, p->Z, p->Wt5, 512, se); }
    }
    GSYNC();
    DBG_CHECK(7);
    {
        PP p = get_pp();
        pg8::Gemm g{p->MERGED, p->Wt6, MP, 1024, 1024}; pg8::StaticOrder S; S.init(MP, 1024, G, c); EpiResid E{p->X, p->X + (size_t)MP * DM, p->X, p->XB, p->rowss + 2 * MT, 1.0f};
        pg8::gemm_phase(lds, g, S, E);
        { SmallEpi se{}; se.src = p->X + (size_t)MP * DM; se.X = p->X; se.XB = p->XB; se.rowss_next = p->rowss + 2 * MT; se.scale = 1.0f; small_gemm_sample<0>(smem, p->MERGED, p->Wt6, 1024, se); }
    }
    GSYNC();
    DBG_CHECK(8);
    {
        PP p = get_pp();
        pg8::Gemm g{p->XB, p->Wt7, MP, 1024, 1024}; pg8::StaticOrder S; S.init(MP, 1024, G, c); EpiXq E{p->XQ, p->rowss + 2 * MT};
        pg8::gemm_phase(lds, g, S, E);
        { SmallEpi se{}; se.rowss = p->rowss + 2 * MT; se.XQ = p->XQ; small_gemm_sample<1>(smem, p->XB, p->Wt7, 1024, se); }
    }
    GSYNC();
    DBG_CHECK(9);
    {
        PP p = get_pp();
#if defined(DBG_NO_XS)
        for (size_t i = (size_t)blockIdx.x * 512 + opaque_tid(); i < (size_t)1024 * 1024; i += (size_t)gridDim.x * 512) p->XO[(size_t)MP * DM + i] = 0;
#else
        xattn_sample(p, smem);
#endif
        for (int item = c; item < 512; item += G) xattn_prompt_block(p, smem, item);
    }
    GSYNC();
    DBG_CHECK(10);
    {
        PP p = get_pp();
        pg8::Gemm g{p->XO, p->Wt8, MP, 1024, 1024}; pg8::StaticOrder S; S.init(MP, 1024, G, c); EpiResid E{p->X, p->X + (size_t)MP * DM, p->X, p->XB, p->rowss + 3 * MT, 1.0f};
        pg8::gemm_phase(lds, g, S, E);
        { SmallEpi se{}; se.src = p->X + (size_t)MP * DM; se.X = p->X; se.XB = p->XB; se.rowss_next = p->rowss + 3 * MT; se.scale = 1.0f; small_gemm_sample<0>(smem, p->XO, p->Wt8, 1024, se); }
    }
    GSYNC();
    DBG_CHECK(11);
    {
        PP p = get_pp();
        pg8::Gemm g{p->XB, p->Wt9, MT, 5632, 1024}; pg8::StaticOrder S; S.init(MT, 5632, G, c); EpiSwiglu E{p->ACT, p->rowss + 3 * MT};
        pg8::gemm_phase(lds, g, S, E);
    }
    GSYNC();
    DBG_CHECK(12);
    {
        PP p = get_pp();
        pg8::Gemm g{p->ACT, p->Wt10, MP, 1024, 2816}; pg8::StaticOrder S; S.init(MP, 1024, G, c); EpiResid E{p->X, p->X + (size_t)MP * DM, p->X, nullptr, p->rowss + 4 * MT, 0.5f};
        pg8::gemm_phase(lds, g, S, E);
        { SmallEpi se{}; se.src = p->X + (size_t)MP * DM; se.X = p->X; se.XB = nullptr; se.rowss_next = p->rowss + 4 * MT; se.scale = 0.5f; small_gemm_sample<0>(smem, p->ACT, p->Wt10, 2816, se); }
    }
    GSYNC();
    DBG_CHECK(13);
    { PP p = get_pp(); final_norm(p); }
}

extern "C" void kernel_launch(void* const* d_in, const int* in_sizes, int n_in, void* d_out, int out_size, void* d_ws, size_t ws_size, hipStream_t stream) {
    static int grid_blocks = 0;
    if (!grid_blocks) {
        int dev = 0, cus = 0, per_cu = 0;
        hipGetDevice(&dev);
        hipDeviceGetAttribute(&cus, hipDeviceAttributeMultiprocessorCount, dev);
        hipFuncSetAttribute((const void*)fwd_megakernel, hipFuncAttributeMaxDynamicSharedMemorySize, LDS_BYTES);
        hipOccupancyMaxActiveBlocksPerMultiprocessor(&per_cu, (const void*)fwd_megakernel, 512, LDS_BYTES);
        if (per_cu < 1) per_cu = 1;
        grid_blocks = cus * per_cu;
    }
    Params p; memset(&p, 0, sizeof(p));
    const float** ins = (const float**)&p;
    for (int i = 0; i < 36; ++i) ins[i] = (const float*)d_in[i];
    p.out = (float*)d_out;
    unsigned char* w = (unsigned char*)d_ws; size_t off = 0;
    auto take = [&](size_t bytes) { unsigned char* r = w + off; off += (bytes + 255) & ~(size_t)255; return r; };
    p.Wt1 = (bf16_t*)take((size_t)5632 * 1024 * 2); p.Wt2 = (bf16_t*)take((size_t)1024 * 2816 * 2); p.Wt3 = (bf16_t*)take((size_t)3328 * 1024 * 2);
    p.Wt4 = (bf16_t*)take((size_t)1024 * 512 * 2); p.Wt5 = (bf16_t*)take((size_t)2048 * 512 * 2); p.Wt6 = (bf16_t*)take((size_t)1024 * 1024 * 2);
    p.Wt7 = (bf16_t*)take((size_t)1024 * 1024 * 2); p.Wtkv = (bf16_t*)take((size_t)2048 * 1024 * 2); p.Wt8 = (bf16_t*)take((size_t)1024 * 1024 * 2);
    p.Wt9 = (bf16_t*)take((size_t)5632 * 1024 * 2); p.Wt10 = (bf16_t*)take((size_t)1024 * 2816 * 2);
    p.XB = (bf16_t*)take((size_t)MT * 1024 * 2);
    {
        unsigned char* ra = take((size_t)MT * DFF * 2);
        p.ACT = (bf16_t*)ra; p.SG = (bf16_t*)ra; p.Q = (bf16_t*)(ra + (size_t)MT * 2048 * 2);
        p.XQ = (bf16_t*)ra; p.XO = (bf16_t*)(ra + (size_t)MT * 1024 * 2);
    }
    p.Kb = (bf16_t*)take((size_t)KROWS * 128 * 2); p.Vt = (bf16_t*)take((size_t)128 * KROWS * 2);
    p.O = (bf16_t*)take((size_t)MT * 512 * 2); p.Z = (bf16_t*)take((size_t)MT * 512 * 2);
    p.MEMB = (bf16_t*)take((size_t)256 * 1024 * 2); p.MK = (bf16_t*)take((size_t)256 * 1024 * 2); p.MVt = (bf16_t*)take((size_t)1024 * 256 * 2);
    p.X = (float*)take((size_t)MT * 1024 * 4); p.TMP = (float*)take((size_t)MT * 1024 * 4);
    p.U = (float*)take((size_t)MT * 512 * 4); p.MERGED = (bf16_t*)p.U;
    p.rowss = (float*)take((size_t)(5 * MT + 256) * 4); p.rope = (float*)take((size_t)16392 * 64 * 4); p.ssmtab = (float*)take((size_t)(8192 + 2048 * 32) * 4);
    p.Schunk = (float*)take((size_t)256 * 2048 * 2 * 4); p.Carry = (float*)take((size_t)256 * 2048 * 2 * 4);
    p.bar = (unsigned*)take(XCD_BAR_WORDS * 4);
    if (off > ws_size) { fprintf(stderr, "kernel_launch: workspace too small (%zu > %zu)\n", off, ws_size); return; }
    void* args[] = {&p};
    hipError_t e = hipLaunchCooperativeKernel((const void*)fwd_megakernel, dim3(grid_blocks), dim3(512), args, LDS_BYTES, stream);
    if (e != hipSuccess) fprintf(stderr, "cooperative launch failed: %s (grid %d)\n", hipGetErrorString(e), grid_blocks);
}
```

```cpp
#include <hip/hip_runtime.h>
#include <hip/hip_cooperative_groups.h>
#include <cstdio>
#include <cstring>
namespace cg = cooperative_groups;

#define LAS __attribute__((address_space(3)))
typedef unsigned short bf16_t;
typedef short bf16x8 __attribute__((ext_vector_type(8)));
typedef float f32x4 __attribute__((ext_vector_type(4)));
typedef unsigned u32x4 __attribute__((ext_vector_type(4)));
typedef unsigned u32x2 __attribute__((ext_vector_type(2)));
typedef float f32x2 __attribute__((ext_vector_type(2)));

constexpr int MT = 17408, MP = 16384, DM = 1024, DFF = 2816;
constexpr int SBS = 192;
constexpr int KROWS = 16384 + 128 * SBS + 64;
constexpr int LDS_BYTES = 131072 + 16;

constexpr size_t OFF_Y = 0, OFF_WKP = 17825792, OFF_WVP = 17842176, OFF_SRP = 17858560, OFF_SIP = 17860608,
                 OFF_MKP = 17862656, OFF_MVP = 18124800, OFF_WKS = 18386944, OFF_WVS = 20484096, OFF_SRS = 22581248, OFF_SIS = 22843392;

struct Params {
    const float *x_prompt, *x_sample, *cache_win_k, *cache_win_v, *state_re, *state_im, *cache_mem_k, *cache_mem_v, *mem_prompt;
    const float *g_ffn1, *w_ffn1_in, *w_ffn1_out, *g_mix, *w_in, *sinks, *a_re, *a_im, *log_dt, *b_re, *b_im, *c_re, *c_im, *ssm_d;
    const float *w_attn_up, *w_ssm_glu, *w_out, *g_xattn, *g_mem, *w_xq, *w_xk, *w_xv, *w_xo, *g_ffn2, *w_ffn2_in, *w_ffn2_out, *g_final;
    float* out;
    bf16_t *Wt1, *Wt2, *Wt3, *Wt4, *Wt5, *Wt6, *Wt7, *Wtkv, *Wt8, *Wt9, *Wt10;
    bf16_t *XB, *ACT, *Q, *Kb, *Vt, *SG, *O, *Z, *MERGED, *XQ, *XO, *MEMB, *MK, *MVt;
    float *X, *U, *TMP, *rowss, *rope, *ssmtab, *Schunk, *Carry;
    unsigned* bar;
};

typedef const __attribute__((address_space(4))) Params* PP;
__device__ __forceinline__ PP get_pp() { PP p = (PP)__builtin_amdgcn_kernarg_segment_ptr(); asm volatile("" : "+s"(p)); return p; }
typedef __bf16 bf16v2 __attribute__((ext_vector_type(2)));
typedef float f32v2 __attribute__((ext_vector_type(2)));
__device__ __forceinline__ unsigned cvt_pk_bf16(float lo, float hi) { const f32v2 v = {lo, hi}; const bf16v2 b = __builtin_convertvector(v, bf16v2); return __builtin_bit_cast(unsigned, b); }
__device__ __forceinline__ float sigm(float x) { return __builtin_amdgcn_rcpf(1.0f + __expf(-x)); }
__device__ __forceinline__ float rstd_of(float ss) { return rsqrtf(ss * (1.0f / 1024.0f) + 1e-6f); }
__device__ __forceinline__ int opaque_tid() { int t = threadIdx.x; asm volatile("" : "+v"(t)); return t; }
#define XB_TMO      128
#define XB_XCNT(j)  (256  + 64 * (j))
#define XB_XSUB(j)  (1280 + 64 * (j))
#define XB_XGEN(j)  (2304 + 64 * (j))
#define XB_TOP      3328
#define XB_TOPGEN   3392
#define XCD_BAR_WORDS 3456
#define XB_SPIN_CAP (1u << 18)
__device__ __forceinline__ unsigned xb_ld(unsigned* p)              { return __hip_atomic_load(p, __ATOMIC_RELAXED, __HIP_MEMORY_SCOPE_AGENT); }
__device__ __forceinline__ unsigned xb_add(unsigned* p, unsigned v) { return __hip_atomic_fetch_add(p, v, __ATOMIC_RELAXED, __HIP_MEMORY_SCOPE_AGENT); }
__device__ __forceinline__ unsigned xb_xcc_id() { return (unsigned)__builtin_amdgcn_s_getreg((3 << 11) | 20) & 0xFu; }
#define XB_SPIN(cond, bar) do { unsigned _sp = 0; while (cond) { __builtin_amdgcn_s_sleep(1); \
    if ((++_sp & 255u) == 0u) { if (xb_ld(&(bar)[XB_TMO])) break; if (_sp > XB_SPIN_CAP) { atomicAdd(&(bar)[XB_TMO], 1u); break; } } } } while (0)
__device__ __forceinline__ void xcd_barrier_complete(unsigned* bar, unsigned x, unsigned& nloc, unsigned& nx) {
    const unsigned G = gridDim.x * gridDim.y * gridDim.z;
    unsigned sum, cnt, mine, sp = 0u;
    for (;;) {
        sum = 0u; cnt = 0u; mine = 0u;
#pragma unroll
        for (unsigned j = 0; j < 16; ++j) { const unsigned c = xb_ld(&bar[XB_XCNT(j)]); sum += c; cnt += (c > 0u) ? 1u : 0u; mine = (j == x) ? c : mine; }
        if (sum == G) break;
        __builtin_amdgcn_s_sleep(1);
        if ((++sp & 255u) == 0u) { if (xb_ld(&bar[XB_TMO])) break; if (sp > XB_SPIN_CAP) { atomicAdd(&bar[XB_TMO], 1u); break; } }
    }
    nloc = mine > 0u ? mine : 1u; nx = cnt > 0u ? cnt : 1u;
}
__device__ __forceinline__ void xcd_barrier(unsigned* bar, volatile LAS unsigned* st) {
    asm volatile("s_waitcnt vmcnt(0)" ::: "memory");
    __syncthreads();
    if (threadIdx.x == 0) {
        const unsigned x = xb_xcc_id();
        __builtin_amdgcn_s_waitcnt(0);
        unsigned nloc = st[0], nx = st[1];
        if (nloc == 0u) { xcd_barrier_complete(bar, x, nloc, nx); st[0] = nloc; st[1] = nx; }
        const unsigned old = xb_add(&bar[XB_XSUB(x)], 1u);
        const unsigned gen = old / nloc;
        if (old + 1u == (gen + 1u) * nloc) {
            __builtin_amdgcn_fence(__ATOMIC_RELEASE, "agent");
            asm volatile("s_waitcnt vmcnt(0)" ::: "memory");
            const unsigned og = xb_add(&bar[XB_TOP], 1u);
            const unsigned tg = og / nx;
            if (og + 1u == (tg + 1u) * nx) xb_add(&bar[XB_TOPGEN], 1u);
            else XB_SPIN(xb_ld(&bar[XB_TOPGEN]) == tg, bar);
            __builtin_amdgcn_fence(__ATOMIC_ACQUIRE, "agent");
            xb_add(&bar[XB_XGEN(x)], 1u);
            asm volatile("s_waitcnt vmcnt(0)" ::: "memory");
        } else {
            XB_SPIN(xb_ld(&bar[XB_XGEN(x)]) == gen, bar);
            __builtin_amdgcn_fence(__ATOMIC_ACQUIRE, "agent");
            asm volatile("s_waitcnt vmcnt(0)" ::: "memory");
        }
    }
    __syncthreads();
}
#define GSYNC() xcd_barrier(get_pp()->bar, (volatile LAS unsigned*)(lds + 131072))
__device__ __forceinline__ void wave_lds_sync() { asm volatile("s_waitcnt lgkmcnt(0)" ::: "memory"); __builtin_amdgcn_wave_barrier(); }

namespace pg8 {
constexpr int BM = 256, BK = 64, HALF = 128, HTB = HALF * BK * 2, NXCD = 8, WGM = 8;
__device__ __forceinline__ int lds_byte(int r, int c) { const int st = (r >> 4) * 2 + (c >> 5), rr = r & 15, cc = c & 31, ob = rr * 64 + cc * 2; return st * 1024 + (ob ^ (((ob >> 9) & 1) << 5)); }
__device__ __forceinline__ void stage_rc(int b, int& R, int& C) { const int st = b / 1024, sb = b % 1024, swz = sb ^ (((sb >> 9) & 1) << 5); R = (st >> 1) * 16 + swz / 64; C = (st & 1) * 32 + (swz % 64) / 2; }
struct Unit { int pm, pn; };
struct Gemm { const bf16_t* A; const bf16_t* Bt; int M, N, K; };
struct StaticOrder {
    int nM, nN, nwg, G, c;
    __device__ void init(int M, int N, int G_, int c_) { nM = M / BM; nN = N / BM; nwg = nM * nN; G = G_; c = c_; }
    __device__ bool next(int i, Unit& u) const {
        const long L = (long)i * G + c; if (L >= nwg) return false;
        int wgid = (int)L; { const int q = nwg / NXCD, r = nwg % NXCD, xcd = wgid % NXCD, off = wgid / NXCD; wgid = (xcd < r ? xcd * (q + 1) : r * (q + 1) + (xcd - r) * q) + off; }
        const int nig = WGM * nN, gid = wgid / nig, fm = gid * WGM, gsz = (nM - fm) < WGM ? (nM - fm) : WGM;
        u.pm = fm + ((wgid % nig) % gsz); u.pn = (wgid % nig) / gsz; return true;
    }
};

template <class Epi, class Sched>
__device__ __forceinline__ void gemm_phase(LAS unsigned char* lds, const Gemm g, const Sched& S, const Epi& E) {
    const int tid = opaque_tid(), wid = __builtin_amdgcn_readfirstlane(tid >> 6), lane = tid & 63, wr = wid >> 2, wc = wid & 3, fr = lane & 15, fq = lane >> 4;
    const int K = g.K, nt = K / BK;
    unsigned voffA[2];
#pragma unroll
    for (int i = 0; i < 2; ++i) { int R, C; stage_rc(tid * 16 + i * 8192, R, C); voffA[i] = (unsigned)(R * K + C) * 2u; }
    const size_t kstep = (size_t)(BK * 2);
    const size_t hstep = (size_t)HALF * K * 2;
    const size_t tstep = 2 * hstep;
    const unsigned ldsw = (unsigned)wid * 1024u;
    const int aoff = lds_byte(wr * 64 + fr, fq * 8), boff = lds_byte(wc * 32 + fr, fq * 8);
#define PG8_SA(b, h) (((b) * 2 + (h)) * HTB)
#define PG8_SB(b, h) ((4 + (b) * 2 + (h)) * HTB)
#define PG8_STAGE(bufoff, gbase) do { _Pragma("unroll") for (int _i = 0; _i < 2; ++_i) \
        __builtin_amdgcn_global_load_lds((const unsigned*)((const char*)(gbase) + voffA[_i]), (LAS unsigned*)(lds + (bufoff) + ldsw + _i * 8192), 16, 0, 0); } while (0)
#define PG8_LDA(dst, b, h) do { _Pragma("unroll") for (int m = 0; m < 4; ++m) _Pragma("unroll") for (int k = 0; k < 2; ++k) dst[m][k] = *(const LAS bf16x8*)(lds + PG8_SA(b, h) + aoff + m * 2048 + k * 1024); } while (0)
#define PG8_LDB(dst, b, h) do { _Pragma("unroll") for (int n = 0; n < 2; ++n) _Pragma("unroll") for (int k = 0; k < 2; ++k) dst[n][k] = *(const LAS bf16x8*)(lds + PG8_SB(b, h) + boff + n * 2048 + k * 1024); } while (0)
#define PG8_MMA(ai, bj, At, Bt) do { __builtin_amdgcn_s_setprio(1); _Pragma("unroll") for (int m = 0; m < 4; ++m) _Pragma("unroll") for (int n = 0; n < 2; ++n) _Pragma("unroll") for (int k = 0; k < 2; ++k) \
        acc[ai][bj][m][n] = __builtin_amdgcn_mfma_f32_16x16x32_bf16(Bt[n][k], At[m][k], acc[ai][bj][m][n], 0, 0, 0); __builtin_amdgcn_s_setprio(0); } while (0)
#define PG8_WAIT_V(n) asm volatile("s_waitcnt vmcnt(" #n ")" ::: "memory")
#define PG8_WAIT_L(n) asm volatile("s_waitcnt lgkmcnt(" #n ")" ::: "memory")
#define PG8_BAR __builtin_amdgcn_s_barrier()
#define PG8_SCHED __builtin_amdgcn_sched_barrier(0)
    Unit cur, nxt; int ui = 0;
    if (!S.next(0, cur)) return;
    f32x4 acc[2][2][4][2];
#pragma unroll
    for (int a = 0; a < 2; ++a)
#pragma unroll
        for (int b = 0; b < 2; ++b)
#pragma unroll
            for (int m = 0; m < 4; ++m)
#pragma unroll
                for (int n = 0; n < 2; ++n) acc[a][b][m][n] = (f32x4){0.f, 0.f, 0.f, 0.f};
    bf16x8 At[4][2], B0[2][2], B1[2][2];
    const char* cA = (const char*)g.A + (size_t)cur.pm * tstep; const char* cB = (const char*)g.Bt + (size_t)cur.pn * tstep;
    PG8_STAGE(PG8_SB(0, 0), cB); PG8_STAGE(PG8_SA(0, 0), cA); PG8_STAGE(PG8_SB(0, 1), cB + hstep); PG8_STAGE(PG8_SA(0, 1), cA + hstep);
    if (wr == 1) PG8_BAR;
    PG8_WAIT_V(4); PG8_BAR;
    PG8_STAGE(PG8_SB(1, 0), cB + kstep); PG8_STAGE(PG8_SA(1, 0), cA + kstep); PG8_STAGE(PG8_SB(1, 1), cB + hstep + kstep);
    PG8_WAIT_V(6); PG8_BAR;
    for (;;) {
        const bool has_next = S.next(ui + 1, nxt);
        const char* nA = has_next ? (const char*)g.A + (size_t)nxt.pm * tstep : cA; const char* nB = has_next ? (const char*)g.Bt + (size_t)nxt.pn * tstep : cB;
        for (int t = 0; t < nt; t += 2) {
            const bool last = (t == nt - 2);
            const char* a1 = cA + (size_t)(t + 1) * kstep;
            const char* a2 = last ? nA : cA + (size_t)(t + 2) * kstep; const char* b2 = last ? nB : cB + (size_t)(t + 2) * kstep;
            const char* a3 = a2 + kstep; const char* b3 = b2 + kstep;
            PG8_LDB(B0, 0, 0); PG8_SCHED; PG8_LDA(At, 0, 0); PG8_STAGE(PG8_SA(1, 1), a1 + hstep);
            PG8_WAIT_L(8); PG8_BAR; PG8_WAIT_L(0); PG8_MMA(0, 0, At, B0); PG8_BAR; PG8_SCHED;
            PG8_LDB(B1, 0, 1); PG8_STAGE(PG8_SB(0, 0), b2);
            PG8_BAR; PG8_WAIT_L(0); PG8_MMA(0, 1, At, B1); PG8_BAR;
            PG8_LDA(At, 0, 1); PG8_STAGE(PG8_SA(0, 0), a2);
            PG8_BAR; PG8_WAIT_L(0); PG8_MMA(1, 0, At, B0); PG8_BAR; PG8_SCHED;
            PG8_STAGE(PG8_SB(0, 1), b2 + hstep);
            PG8_WAIT_V(6); PG8_BAR; PG8_MMA(1, 1, At, B1); PG8_BAR;
            PG8_LDB(B0, 1, 0); PG8_SCHED; PG8_LDA(At, 1, 0); PG8_STAGE(PG8_SA(0, 1), a2 + hstep);
            PG8_WAIT_L(8); PG8_BAR; PG8_WAIT_L(0); PG8_MMA(0, 0, At, B0); PG8_BAR; PG8_SCHED;
            PG8_LDB(B1, 1, 1); PG8_STAGE(PG8_SB(1, 0), b3);
            PG8_BAR; PG8_WAIT_L(0); PG8_MMA(0, 1, At, B1); PG8_BAR;
            PG8_LDA(At, 1, 1); PG8_STAGE(PG8_SA(1, 0), a3);
            PG8_BAR; PG8_WAIT_L(0); PG8_MMA(1, 0, At, B0); PG8_BAR; PG8_SCHED;
            PG8_STAGE(PG8_SB(1, 1), b3 + hstep);
            PG8_WAIT_V(6); PG8_BAR; PG8_MMA(1, 1, At, B1); PG8_BAR;
        }
        E(acc, cur, wr, wc, fr, fq);
        if (!has_next) break;
#pragma unroll
        for (int a = 0; a < 2; ++a)
#pragma unroll
            for (int b = 0; b < 2; ++b)
#pragma unroll
                for (int m = 0; m < 4; ++m)
#pragma unroll
                    for (int n = 0; n < 2; ++n) acc[a][b][m][n] = (f32x4){0.f, 0.f, 0.f, 0.f};
        cur = nxt; cA = nA; cB = nB; ++ui;
    }
    PG8_WAIT_V(0);
    if (wr == 0) PG8_BAR;
    PG8_BAR;
#undef PG8_SA
#undef PG8_SB
#undef PG8_STAGE
#undef PG8_LDA
#undef PG8_LDB
#undef PG8_MMA
#undef PG8_WAIT_V
#undef PG8_WAIT_L
#undef PG8_BAR
#undef PG8_SCHED
}
}
using pg8::Unit;
typedef f32x4 AccT[2][2][4][2];

struct EpiSwiglu {
    bf16_t* ACT; const float* rowss;
    __device__ __forceinline__ void operator()(const AccT& acc, const Unit& u, int wr, int wc, int fr, int fq) const {
        const int row0 = u.pm * 256 + wr * 64 + fr;
#pragma unroll
        for (int ai = 0; ai < 2; ++ai)
#pragma unroll
            for (int m = 0; m < 4; ++m) {
                const int r = row0 + ai * 128 + m * 16; const float rs = rowss ? rstd_of(rowss[r]) : 1.0f;
#pragma unroll
                for (int bj = 0; bj < 2; ++bj) {
                    const int col = (u.pn * 8 + bj * 4 + wc) * 16 + fq * 4;
                    float o[4];
#pragma unroll
                    for (int j = 0; j < 4; ++j) { const float a = acc[ai][bj][m][0][j] * rs, b = acc[ai][bj][m][1][j] * rs; o[j] = a * sigm(a) * b; }
                    u32x2 w; w.x = cvt_pk_bf16(o[0], o[1]); w.y = cvt_pk_bf16(o[2], o[3]);
                    *(u32x2*)(ACT + (size_t)r * DFF + col) = w;
                }
            }
    }
};
struct EpiResid {
    const float* src0; const float* src1; float* X; bf16_t* XB; float* rowss_next; float scale;
    __device__ __forceinline__ void operator()(const AccT& acc, const Unit& u, int wr, int wc, int fr, int fq) const {
        const int row0 = u.pm * 256 + wr * 64 + fr; const int col0 = u.pn * 256 + wc * 32 + fq * 4;
#pragma unroll
        for (int ai = 0; ai < 2; ++ai)
#pragma unroll
            for (int m = 0; m < 4; ++m) {
                const int r = row0 + ai * 128 + m * 16;
                const float* xs = (r < MP) ? src0 + (size_t)r * DM : src1 + (size_t)(r - MP) * DM;
                float ss = 0.f;
#pragma unroll
                for (int bj = 0; bj < 2; ++bj)
#pragma unroll
                    for (int n = 0; n < 2; ++n) {
                        const int col = col0 + bj * 128 + n * 16;
                        const f32x4 xo = *(const f32x4*)(xs + col);
                        const f32x4 v = xo + acc[ai][bj][m][n] * scale;
                        *(f32x4*)(X + (size_t)r * DM + col) = v;
                        ss += v[0] * v[0] + v[1] * v[1] + v[2] * v[2] + v[3] * v[3];
                        if (XB) { u32x2 w; w.x = cvt_pk_bf16(v[0], v[1]); w.y = cvt_pk_bf16(v[2], v[3]); *(u32x2*)(XB + (size_t)r * DM + col) = w; }
                    }
                ss += __shfl_xor(ss, 16); ss += __shfl_xor(ss, 32);
                if (fq == 0) __hip_atomic_fetch_add(rowss_next + r, ss, __ATOMIC_RELAXED, __HIP_MEMORY_SCOPE_AGENT);
            }
    }
};
struct EpiWin {
    PP P;
    __device__ __forceinline__ void operator()(const AccT& acc, const Unit& u, int wr, int wc, int fr, int fq) const {
        PP p = P; const float* rowss = p->rowss + MT;
        const int row0 = u.pm * 256 + wr * 64 + fr; const int pn = u.pn;
#pragma unroll
        for (int ai = 0; ai < 2; ++ai)
#pragma unroll
            for (int m = 0; m < 4; ++m) {
                const int r = row0 + ai * 128 + m * 16; const float rs = rstd_of(rowss[r]);
                const bool samp = r >= MP; const int rb = (r - MP) >> 3, rt = (r - MP) & 7;
                const int pos = samp ? MP + rt : r;
                const int krow = samp ? MP + rb * SBS + 128 + rt : r;
#pragma unroll
                for (int bj = 0; bj < 2; ++bj) {
                    if (pn < 2 || (pn == 2 && bj == 0)) {
                        const int grp = wc & 1, d = grp * 16 + fq * 4;
                        const f32x4 cs0 = *(const f32x4*)(p->rope + (size_t)pos * 64 + d * 2), cs1 = *(const f32x4*)(p->rope + (size_t)pos * 64 + d * 2 + 4);
                        const float cc[4] = {cs0[0], cs0[2], cs1[0], cs1[2]}, sn[4] = {cs0[1], cs0[3], cs1[1], cs1[3]};
                        float o1[4], o2[4];
#pragma unroll
                        for (int j = 0; j < 4; ++j) { const float x1 = acc[ai][bj][m][0][j] * rs, x2 = acc[ai][bj][m][1][j] * rs; o1[j] = x1 * cc[j] - x2 * sn[j]; o2[j] = x2 * cc[j] + x1 * sn[j]; }
                        if (pn < 2) {
                            const int head = pn * 4 + bj * 2 + (wc >> 1);
                            u32x2 w1, w2; w1.x = cvt_pk_bf16(o1[0] * 0.125f, o1[1] * 0.125f); w1.y = cvt_pk_bf16(o1[2] * 0.125f, o1[3] * 0.125f);
                            w2.x = cvt_pk_bf16(o2[0] * 0.125f, o2[1] * 0.125f); w2.y = cvt_pk_bf16(o2[2] * 0.125f, o2[3] * 0.125f);
                            bf16_t* qp = p->Q + (size_t)r * 512 + head * 64 + d;
                            *(u32x2*)qp = w1; *(u32x2*)(qp + 32) = w2;
                        } else {
                            const int kvh = wc >> 1;
                            u32x2 w1, w2; w1.x = cvt_pk_bf16(o1[0], o1[1]); w1.y = cvt_pk_bf16(o1[2], o1[3]); w2.x = cvt_pk_bf16(o2[0], o2[1]); w2.y = cvt_pk_bf16(o2[2], o2[3]);
                            bf16_t* kp = p->Kb + (size_t)krow * 128 + kvh * 64 + d;
                            *(u32x2*)kp = w1; *(u32x2*)(kp + 32) = w2;
                            float* op = nullptr;
                            if (samp) op = p->out + OFF_WKS + ((size_t)rb * 128 + 120 + rt) * 128 + kvh * 64 + d;
                            else if (r >= MP - 128) op = p->out + OFF_WKP + (size_t)(r - (MP - 128)) * 128 + kvh * 64 + d;
                            if (op) { *(f32x4*)op = (f32x4){o1[0], o1[1], o1[2], o1[3]}; *(f32x4*)(op + 32) = (f32x4){o2[0], o2[1], o2[2], o2[3]}; }
                        }
                    } else if (pn == 2) {
                        const int kvh = wc >> 1;
                        float* op = nullptr;
                        if (samp) op = p->out + OFF_WVS + ((size_t)rb * 128 + 120 + rt) * 128 + kvh * 64;
                        else if (r >= MP - 128) op = p->out + OFF_WVP + (size_t)(r - (MP - 128)) * 128 + kvh * 64;
#pragma unroll
                        for (int n = 0; n < 2; ++n) {
                            const int d = (wc & 1) * 32 + n * 16 + fq * 4;
                            const f32x4 v = acc[ai][bj][m][n] * rs;
#pragma unroll
                            for (int j = 0; j < 4; ++j) p->Vt[(size_t)(kvh * 64 + d + j) * KROWS + krow] = (bf16_t)(cvt_pk_bf16(v[j], 0.f) & 0xffffu);
                            if (op) *(f32x4*)(op + d) = v;
                        }
                    } else if (pn < 5) {
#pragma unroll
                        for (int n = 0; n < 2; ++n) {
                            const int col = (pn - 3) * 256 + bj * 128 + wc * 32 + n * 16 + fq * 4;
                            *(f32x4*)(p->U + (size_t)r * 512 + col) = acc[ai][bj][m][n] * rs;
                        }
                    } else {
                        const int col = (pn - 5) * 256 + bj * 128 + wc * 32 + fq * 8;
                        const f32x4 a = acc[ai][bj][m][0] * rs, b = acc[ai][bj][m][1] * rs;
                        u32x4 w; w.x = cvt_pk_bf16(sigm(a[0]), sigm(a[1])); w.y = cvt_pk_bf16(sigm(a[2]), sigm(a[3]));
                        w.z = cvt_pk_bf16(sigm(b[0]), sigm(b[1])); w.w = cvt_pk_bf16(sigm(b[2]), sigm(b[3]));
                        *(u32x4*)(p->SG + (size_t)r * 2048 + col) = w;
                    }
                }
            }
    }
};
__device__ __forceinline__ f32x4 ld_bf16x4(const bf16_t* ptr) { const u32x2 w = *(const u32x2*)ptr; f32x4 r; r[0] = __uint_as_float(w.x << 16); r[1] = __uint_as_float(w.x & 0xffff0000u); r[2] = __uint_as_float(w.y << 16); r[3] = __uint_as_float(w.y & 0xffff0000u); return r; }
struct EpiAttnUp {
    float* TMP; const bf16_t* SG;
    __device__ __forceinline__ void operator()(const AccT& acc, const Unit& u, int wr, int wc, int fr, int fq) const {
        const int row0 = u.pm * 256 + wr * 64 + fr; const int col0 = u.pn * 256 + wc * 32 + fq * 4;
#pragma unroll
        for (int ai = 0; ai < 2; ++ai)
#pragma unroll
            for (int m = 0; m < 4; ++m) {
                const int r = row0 + ai * 128 + m * 16;
#pragma unroll
                for (int bj = 0; bj < 2; ++bj)
#pragma unroll
                    for (int n = 0; n < 2; ++n) {
                        const int col = col0 + bj * 128 + n * 16;
                        const f32x4 g = ld_bf16x4(SG + (size_t)r * 2048 + col);
                        *(f32x4*)(TMP + (size_t)r * DM + col) = g * acc[ai][bj][m][n];
                    }
            }
    }
};
struct EpiSsmGlu {
    const float* TMP; const bf16_t* SG; bf16_t* MERGED;
    __device__ __forceinline__ void operator()(const AccT& acc, const Unit& u, int wr, int wc, int fr, int fq) const {
        const int row0 = u.pm * 256 + wr * 64 + fr;
#pragma unroll
        for (int ai = 0; ai < 2; ++ai)
#pragma unroll
            for (int m = 0; m < 4; ++m) {
                const int r = row0 + ai * 128 + m * 16;
#pragma unroll
                for (int bj = 0; bj < 2; ++bj) {
                    const int col = (u.pn * 8 + bj * 4 + wc) * 16 + fq * 4;
                    const f32x4 t = *(const f32x4*)(TMP + (size_t)r * DM + col);
                    const f32x4 g = ld_bf16x4(SG + (size_t)r * 2048 + 1024 + col);
                    float o[4];
#pragma unroll
                    for (int j = 0; j < 4; ++j) { const float ga = acc[ai][bj][m][0][j], gb = acc[ai][bj][m][1][j]; o[j] = t[j] + g[j] * ga * sigm(gb); }
                    u32x2 w; w.x = cvt_pk_bf16(o[0], o[1]); w.y = cvt_pk_bf16(o[2], o[3]);
                    *(u32x2*)(MERGED + (size_t)r * DM + col) = w;
                }
            }
    }
};
struct EpiXq {
    bf16_t* XQ; const float* rowss;
    __device__ __forceinline__ void operator()(const AccT& acc, const Unit& u, int wr, int wc, int fr, int fq) const {
        const int row0 = u.pm * 256 + wr * 64 + fr;
#pragma unroll
        for (int ai = 0; ai < 2; ++ai)
#pragma unroll
            for (int m = 0; m < 4; ++m) {
                const int r = row0 + ai * 128 + m * 16; const float rs = rstd_of(rowss[r]);
#pragma unroll
                for (int bj = 0; bj < 2; ++bj) {
                    const int col = u.pn * 256 + bj * 128 + wc * 32 + fq * 8;
                    const f32x4 a = acc[ai][bj][m][0] * rs, b = acc[ai][bj][m][1] * rs;
                    u32x4 w; w.x = cvt_pk_bf16(a[0], a[1]); w.y = cvt_pk_bf16(a[2], a[3]); w.z = cvt_pk_bf16(b[0], b[1]); w.w = cvt_pk_bf16(b[2], b[3]);
                    *(u32x4*)(XQ + (size_t)r * DM + col) = w;
                }
            }
    }
};
struct EpiMemKV {
    float* out; const float* rowss;
    __device__ __forceinline__ void operator()(const AccT& acc, const Unit& u, int wr, int wc, int fr, int fq) const {
        const int row0 = wr * 64 + fr; const int col0 = (u.pn & 3) * 256 + wc * 32 + fq * 4;
        float* ob = out + (u.pn < 4 ? OFF_MKP : OFF_MVP);
#pragma unroll
        for (int ai = 0; ai < 2; ++ai)
#pragma unroll
            for (int m = 0; m < 4; ++m) {
                const int r = row0 + ai * 128 + m * 16;
#pragma unroll
                for (int bj = 0; bj < 2; ++bj)
#pragma unroll
                    for (int n = 0; n < 2; ++n) *(f32x4*)(ob + (size_t)r * DM + col0 + bj * 128 + n * 16) = acc[ai][bj][m][n];
            }
    }
};
__device__ __forceinline__ void memkv_convert(PP p) {
    const int gt = blockIdx.x * 512 + opaque_tid(), ntot = gridDim.x * 512;
    for (int i = gt; i < 256 * 1024; i += ntot) p->MK[i] = (bf16_t)(cvt_pk_bf16(p->out[OFF_MKP + i], 0.f) & 0xffffu);
    for (int i = gt; i < 256 * 1024; i += ntot) {
        const int r = i & 255, col = i >> 8;
        p->MVt[i] = (bf16_t)(cvt_pk_bf16(p->out[OFF_MVP + (size_t)r * 1024 + col], 0.f) & 0xffffu);
    }
}

struct SmallEpi { const float* src; float* X; bf16_t* XB; float* rowss_next; float scale; const float* rowss; bf16_t* XQ; float* TMP; const bf16_t* SG; bf16_t* MERGED; int ntn; };
template <int EP>
__device__ __forceinline__ void small_gemm_sample(unsigned char* smem, const bf16_t* A, const bf16_t* Bt, int K, const SmallEpi E) {
    const int tid = opaque_tid(), wid = tid >> 6, lane = tid & 63, fr = lane & 15, fq = lane >> 4;
    float* part = (float*)smem;
    const int nks = K >> 8;
    const int ntn = E.ntn ? E.ntn : 16;
    for (int t = blockIdx.x; t < 16 * ntn; t += gridDim.x) {
        const int tm = t / ntn, tn = t - tm * ntn;
        const bf16_t* ap = A + (size_t)(MP + tm * 64 + fr) * K + wid * (K >> 3) + fq * 8;
        const bf16_t* bp = Bt + (size_t)(tn * 64 + fr) * K + wid * (K >> 3) + fq * 8;
        f32x4 acc[4][4];
#pragma unroll
        for (int mi = 0; mi < 4; ++mi)
#pragma unroll
            for (int ni = 0; ni < 4; ++ni) acc[mi][ni] = (f32x4){0.f, 0.f, 0.f, 0.f};
        bf16x8 Af[2][4], Bf[2][4];
#pragma unroll
        for (int i = 0; i < 4; ++i) { Af[0][i] = *(const bf16x8*)(ap + (size_t)(i * 16) * K); Bf[0][i] = *(const bf16x8*)(bp + (size_t)(i * 16) * K); }
        for (int ks = 0; ks < nks; ks += 2) {
            if (ks + 1 < nks) {
#pragma unroll
                for (int i = 0; i < 4; ++i) { Af[1][i] = *(const bf16x8*)(ap + (size_t)(i * 16) * K + (ks + 1) * 32); Bf[1][i] = *(const bf16x8*)(bp + (size_t)(i * 16) * K + (ks + 1) * 32); }
            }
#pragma unroll
            for (int mi = 0; mi < 4; ++mi)
#pragma unroll
                for (int ni = 0; ni < 4; ++ni) acc[mi][ni] = __builtin_amdgcn_mfma_f32_16x16x32_bf16(Af[0][mi], Bf[0][ni], acc[mi][ni], 0, 0, 0);
            if (ks + 1 < nks) {
                if (ks + 2 < nks) {
#pragma unroll
                    for (int i = 0; i < 4; ++i) { Af[0][i] = *(const bf16x8*)(ap + (size_t)(i * 16) * K + (ks + 2) * 32); Bf[0][i] = *(const bf16x8*)(bp + (size_t)(i * 16) * K + (ks + 2) * 32); }
                }
#pragma unroll
                for (int mi = 0; mi < 4; ++mi)
#pragma unroll
                    for (int ni = 0; ni < 4; ++ni) acc[mi][ni] = __builtin_amdgcn_mfma_f32_16x16x32_bf16(Af[1][mi], Bf[1][ni], acc[mi][ni], 0, 0, 0);
            }
        }
        __syncthreads();
#pragma unroll
        for (int mi = 0; mi < 4; ++mi)
#pragma unroll
            for (int ni = 0; ni < 4; ++ni)
#pragma unroll
                for (int j = 0; j < 4; ++j) part[wid * 4096 + (mi * 16 + fq * 4 + j) * 64 + ni * 16 + fr] = acc[mi][ni][j];
        __syncthreads();
        const int m = tid >> 3, n8 = (tid & 7) * 8;
        f32x4 s0 = (f32x4){0.f, 0.f, 0.f, 0.f}, s1 = s0;
#pragma unroll
        for (int w = 0; w < 8; ++w) { s0 += *(const f32x4*)(part + w * 4096 + m * 64 + n8); s1 += *(const f32x4*)(part + w * 4096 + m * 64 + n8 + 4); }
        const int r = MP + tm * 64 + m, c0 = tn * 64 + n8;
        if (EP == 0) {
            const float* xs = E.src + (size_t)(r - MP) * DM + c0;
            const f32x4 v0 = *(const f32x4*)xs + s0 * E.scale, v1 = *(const f32x4*)(xs + 4) + s1 * E.scale;
            *(f32x4*)(E.X + (size_t)r * DM + c0) = v0; *(f32x4*)(E.X + (size_t)r * DM + c0 + 4) = v1;
            if (E.XB) { u32x4 w; w.x = cvt_pk_bf16(v0[0], v0[1]); w.y = cvt_pk_bf16(v0[2], v0[3]); w.z = cvt_pk_bf16(v1[0], v1[1]); w.w = cvt_pk_bf16(v1[2], v1[3]); *(u32x4*)(E.XB + (size_t)r * DM + c0) = w; }
            float ss = v0[0] * v0[0] + v0[1] * v0[1] + v0[2] * v0[2] + v0[3] * v0[3] + v1[0] * v1[0] + v1[1] * v1[1] + v1[2] * v1[2] + v1[3] * v1[3];
            ss += __shfl_xor(ss, 1); ss += __shfl_xor(ss, 2); ss += __shfl_xor(ss, 4);
            if ((tid & 7) == 0) __hip_atomic_fetch_add(E.rowss_next + r, ss, __ATOMIC_RELAXED, __HIP_MEMORY_SCOPE_AGENT);
        } else if (EP == 1) {
            const float rs = rstd_of(E.rowss[r]);
#pragma unroll
            for (int e = 0; e < 8; ++e) {
                const int cp = c0 + e, sl = cp & 31, nn = sl >> 4, ii = sl & 15; const int col = (cp & ~31) + 8 * (ii >> 2) + 4 * nn + (ii & 3);
                const float v = (e < 4 ? s0[e & 3] : s1[e & 3]) * rs;
                E.XQ[(size_t)r * DM + col] = (bf16_t)(cvt_pk_bf16(v, 0.f) & 0xffffu);
            }
        } else if (EP == 2) {
            const f32x4 g0 = ld_bf16x4(E.SG + (size_t)r * 2048 + c0), g1 = ld_bf16x4(E.SG + (size_t)r * 2048 + c0 + 4);
            *(f32x4*)(E.TMP + (size_t)r * DM + c0) = g0 * s0; *(f32x4*)(E.TMP + (size_t)r * DM + c0 + 4) = g1 * s1;
        } else {
            f32x4 b0, b1;
#pragma unroll
            for (int e = 0; e < 4; ++e) { b0[e] = __shfl_down(s0[e], 2); b1[e] = __shfl_down(s1[e], 2); }
            if ((c0 & 16) == 0) {
                const int o = (c0 >> 5) * 16 + (c0 & 15);
                const f32x4 t0 = *(const f32x4*)(E.TMP + (size_t)r * DM + o), t1 = *(const f32x4*)(E.TMP + (size_t)r * DM + o + 4);
                const f32x4 g0 = ld_bf16x4(E.SG + (size_t)r * 2048 + 1024 + o), g1 = ld_bf16x4(E.SG + (size_t)r * 2048 + 1024 + o + 4);
                float m[8];
#pragma unroll
                for (int e = 0; e < 4; ++e) { m[e] = t0[e] + g0[e] * s0[e] * sigm(b0[e]); m[4 + e] = t1[e] + g1[e] * s1[e] * sigm(b1[e]); }
                u32x4 w; w.x = cvt_pk_bf16(m[0], m[1]); w.y = cvt_pk_bf16(m[2], m[3]); w.z = cvt_pk_bf16(m[4], m[5]); w.w = cvt_pk_bf16(m[6], m[7]);
                *(u32x4*)(E.MERGED + (size_t)r * DM + o) = w;
            }
        }
    }
    __syncthreads();
}

__device__ __forceinline__ int src_col(int mode, int H, int np) {
    if (mode == 3) { if (np < 640) { const int pp = np & 63, grp = pp >> 5, s = pp & 31, n = s >> 4, i = s & 15; return (np & ~63) + grp * 16 + i + n * 32; }
                     if (np < 1280) return np; mode = 1; }
    if (mode == 0) return np;
    const int s = np & 31, n = s >> 4, i = s & 15;
    if (mode == 1) return (np & ~31) + 8 * (i >> 2) + 4 * n + (i & 3);
    return n * H + (np >> 5) * 16 + i;
}
__device__ __forceinline__ void sincos_d(double ang, double& s, double& c) {
    const double x = ang * 0.63661977236758134308;
    const double q = rint(x); const double r = (ang - q * 1.57079632679489655800) - q * 6.12323399573676603587e-17;
    const double r2 = r * r;
    double sp = -7.6471637318198164759e-13; sp = sp * r2 + 1.6059043836821614599e-10; sp = sp * r2 - 2.5052108385441718775e-08; sp = sp * r2 + 2.7557319223985890653e-06;
    sp = sp * r2 - 1.9841269841269841270e-04; sp = sp * r2 + 8.3333333333333332177e-03; sp = sp * r2 - 1.6666666666666665741e-01; sp = r + r * r2 * sp;
    double cp = 4.7794773323873852974e-14; cp = cp * r2 - 1.1470745597729724714e-11; cp = cp * r2 + 2.0876756987868098979e-09; cp = cp * r2 - 2.7557319223985888e-07;
    cp = cp * r2 + 2.4801587301587301566e-05; cp = cp * r2 - 1.3888888888888889419e-03; cp = cp * r2 + 4.1666666666666664354e-02; cp = cp * r2 - 0.5; cp = 1.0 + r2 * cp;
    const int qi = ((int)(long long)q) & 3;
    s = (qi == 0) ? sp : (qi == 1) ? cp : (qi == 2) ? -sp : -cp;
    c = (qi == 0) ? cp : (qi == 1) ? -sp : (qi == 2) ? -cp : sp;
}

__device__ __forceinline__ void conv_weight(const float* src, const float* g, bf16_t* dst, int K, int ld, int Np, int mode, int H, float scale, int tile0, int wv, int nwv, int lane) {
    const int nkt = K >> 6, ntile = (Np >> 8) * nkt;
    for (int t = wv - tile0; t < ntile; t += nwv) {
        if (t < 0) continue;
        const int tn = t / nkt, tk = t - tn * nkt; const int n0 = tn * 256 + lane * 4, k0 = tk * 64;
        const float* sp = src + (size_t)k0 * ld + src_col(mode, H, n0);
        bf16_t* dp = dst + (size_t)n0 * K + k0;
#pragma unroll 1
        for (int ss = 0; ss < 4; ++ss) {
            f32x4 v[16];
#pragma unroll
            for (int e = 0; e < 16; ++e) { const float gv = g ? g[k0 + ss * 16 + e] * scale : scale; v[e] = *(const f32x4*)(sp + (size_t)(ss * 16 + e) * ld) * gv; }
#pragma unroll
            for (int q = 0; q < 4; ++q) {
                u32x4 w0, w1;
                w0.x = cvt_pk_bf16(v[0][q], v[1][q]); w0.y = cvt_pk_bf16(v[2][q], v[3][q]); w0.z = cvt_pk_bf16(v[4][q], v[5][q]); w0.w = cvt_pk_bf16(v[6][q], v[7][q]);
                w1.x = cvt_pk_bf16(v[8][q], v[9][q]); w1.y = cvt_pk_bf16(v[10][q], v[11][q]); w1.z = cvt_pk_bf16(v[12][q], v[13][q]); w1.w = cvt_pk_bf16(v[14][q], v[15][q]);
                *(u32x4*)(dp + (size_t)q * K + ss * 16) = w0; *(u32x4*)(dp + (size_t)q * K + ss * 16 + 8) = w1;
            }
        }
    }
}
__device__ __forceinline__ void conv_weight_set(PP p, int set, int wv, int nwv, int lane) {
    if (set == 0) {
        conv_weight(p->w_ffn1_in, p->g_ffn1, p->Wt1, 1024, 5632, 5632, 2, 2816, 1.f, 0, wv, nwv, lane);
        conv_weight(p->w_xk, p->g_mem, p->Wtkv, 1024, 1024, 1024, 0, 0, 1.f, 352 % nwv, wv, nwv, lane);
        conv_weight(p->w_xv, p->g_mem, p->Wtkv + 1024 * 1024, 1024, 1024, 1024, 0, 0, 1.f, 416 % nwv, wv, nwv, lane);
        conv_weight(p->w_ffn1_out, nullptr, p->Wt2, 2816, 1024, 1024, 0, 0, 1.f, 480 % nwv, wv, nwv, lane);
    } else if (set == 1) {
        conv_weight(p->w_in, p->g_mix, p->Wt3, 1024, 3328, 3328, 3, 0, 1.f, 0, wv, nwv, lane);
    } else {
        conv_weight(p->w_attn_up, nullptr, p->Wt4, 512, 1024, 1024, 0, 0, 1.f, 0, wv, nwv, lane);
        conv_weight(p->w_ssm_glu, nullptr, p->Wt5, 512, 2048, 2048, 2, 1024, 1.f, 32 % nwv, wv, nwv, lane);
        conv_weight(p->w_out, nullptr, p->Wt6, 1024, 1024, 1024, 0, 0, 1.f, 96 % nwv, wv, nwv, lane);
        conv_weight(p->w_xq, p->g_xattn, p->Wt7, 1024, 1024, 1024, 1, 0, 0.0625f, 160 % nwv, wv, nwv, lane);
        conv_weight(p->w_xo, nullptr, p->Wt8, 1024, 1024, 1024, 0, 0, 1.f, 224 % nwv, wv, nwv, lane);
        conv_weight(p->w_ffn2_in, p->g_ffn2, p->Wt9, 1024, 5632, 5632, 2, 2816, 1.f, 288 % nwv, wv, nwv, lane);
        conv_weight(p->w_ffn2_out, nullptr, p->Wt10, 2816, 1024, 1024, 0, 0, 1.f, 640 % nwv, wv, nwv, lane);
    }
}
__device__ __forceinline__ void prep_rope(PP p, int wg, int nwg) {
    const int gt = wg * 512 + opaque_tid(), ntot = nwg * 512;
    for (int i = gt; i < 16392 * 32; i += ntot) {
        const int pos = i >> 5, d = i & 31;
        const double inv = exp(-(double)d * (9.21034037197618273607 / 32.0));
        double s, c; sincos_d((double)pos * inv, s, c);
        p->rope[(size_t)i * 2] = (float)c; p->rope[(size_t)i * 2 + 1] = (float)s;
    }
}
__device__ __forceinline__ void prep_tables(PP p, int wg, int nwg) {
    const int tid = opaque_tid(), wid = tid >> 6, lane = tid & 63;
    const int gw = wg * 8 + wid, nw = nwg * 8;
    const int gt = wg * 512 + tid, ntot = nwg * 512;
    for (int gn = gt; gn < 2048; gn += ntot) {
        const int g = gn >> 6;
        const double are = p->a_re[gn], aim = p->a_im[gn], dt = exp((double)p->log_dt[g]);
        double s, c; sincos_d(aim * dt, s, c); const double mag = exp(are * dt);
        const double lbr = mag * c, lbi = mag * s;
        double s64, c64; sincos_d(aim * dt * 64.0, s64, c64); const double mag64 = exp(are * dt * 64.0);
        const double den = are * are + aim * aim, nr = lbr - 1.0, ni = lbi;
        const double kre = (nr * are + ni * aim) / den, kim = (ni * are - nr * aim) / den;
        float* tb = p->ssmtab;
        tb[gn * 2] = (float)lbr; tb[gn * 2 + 1] = (float)lbi;
        tb[4096 + gn * 2] = (float)(mag64 * c64); tb[4096 + gn * 2 + 1] = (float)(mag64 * s64);
#pragma unroll
        for (int ch = 0; ch < 16; ++ch) {
            const double br = p->b_re[gn * 16 + ch], bi = p->b_im[gn * 16 + ch];
            tb[8192 + gn * 32 + ch] = (float)(kre * br - kim * bi);
            tb[8192 + gn * 32 + 16 + ch] = (float)(kre * bi + kim * br);
        }
    }
}
__device__ __forceinline__ void prep_ctx(PP p, int wg, int nwg) {
    const int tid = opaque_tid(), wid = tid >> 6, lane = tid & 63;
    const int gw = wg * 8 + wid, nw = nwg * 8;
    const int gt = wg * 512 + tid, ntot = nwg * 512;
    for (int i4 = gt; i4 < 128 * 128 * 32; i4 += ntot) {
        const int i = i4 * 4; const int cidx = i & 127, w = (i >> 7) & 127, b = i >> 14;
        const f32x4 kv = *(const f32x4*)(p->cache_win_k + i), vv = *(const f32x4*)(p->cache_win_v + i);
        u32x2 kw; kw.x = cvt_pk_bf16(kv[0], kv[1]); kw.y = cvt_pk_bf16(kv[2], kv[3]);
        *(u32x2*)(p->Kb + (size_t)(MP + b * SBS + w) * 128 + cidx) = kw;
        if (w >= 8) { *(f32x4*)(p->out + OFF_WKS + ((size_t)b * 128 + (w - 8)) * 128 + cidx) = kv; *(f32x4*)(p->out + OFF_WVS + ((size_t)b * 128 + (w - 8)) * 128 + cidx) = vv; }
    }
    for (int it = gw; it < 128 * 2 * 16; it += nw) {
        const int cg8 = it & 15, half = (it >> 4) & 1, b = it >> 5; const int w = half * 64 + lane;
        const float* vp = p->cache_win_v + ((size_t)b * 128 + w) * 128 + cg8 * 8;
        const f32x4 v0 = *(const f32x4*)vp, v1 = *(const f32x4*)(vp + 4);
        bf16_t* dp = p->Vt + (size_t)(cg8 * 8) * KROWS + MP + b * SBS + w;
#pragma unroll
        for (int e = 0; e < 4; ++e) { dp[(size_t)e * KROWS] = (bf16_t)(cvt_pk_bf16(v0[e], 0.f) & 0xffffu); dp[(size_t)(e + 4) * KROWS] = (bf16_t)(cvt_pk_bf16(v1[e], 0.f) & 0xffffu); }
    }
}
__device__ __forceinline__ void phase_prep(PP p, unsigned char* smem) {
    const int tid = opaque_tid(), wid = tid >> 6, lane = tid & 63;
    const int gw = blockIdx.x * 8 + wid, nw = gridDim.x * 8;
    const int gt = blockIdx.x * 512 + tid, ntot = gridDim.x * 512;
    conv_weight_set(p, 0, gw, nw, lane);
    for (int r0 = gw; r0 < MT + 256; r0 += 2 * nw) {
        f32x4 v[2][4]; float ss[2];
#pragma unroll
        for (int q = 0; q < 2; ++q) {
            int r = r0 + q * nw; r = r < MT + 256 ? r : r0;
            const float* xs = (r < MP) ? p->x_prompt + (size_t)r * DM : (r < MT) ? p->x_sample + (size_t)(r - MP) * DM : p->mem_prompt + (size_t)(r - MT) * DM;
            ss[q] = 0.f;
#pragma unroll
            for (int i = 0; i < 4; ++i) { v[q][i] = *(const f32x4*)(xs + i * 256 + lane * 4); ss[q] += v[q][i][0] * v[q][i][0] + v[q][i][1] * v[q][i][1] + v[q][i][2] * v[q][i][2] + v[q][i][3] * v[q][i][3]; }
        }
#pragma unroll
        for (int o = 1; o < 64; o <<= 1) { ss[0] += __shfl_xor(ss[0], o); ss[1] += __shfl_xor(ss[1], o); }
#pragma unroll
        for (int q = 0; q < 2; ++q) {
            const int r = r0 + q * nw; if (r >= MT + 256) continue;
            bf16_t* xb = (r < MT) ? p->XB + (size_t)r * DM : p->MEMB + (size_t)(r - MT) * DM;
            const float rs = rstd_of(ss[q]);
#pragma unroll
            for (int i = 0; i < 4; ++i) { u32x2 w; w.x = cvt_pk_bf16(v[q][i][0] * rs, v[q][i][1] * rs); w.y = cvt_pk_bf16(v[q][i][2] * rs, v[q][i][3] * rs); *(u32x2*)(xb + i * 256 + lane * 4) = w; }
        }
    }
    for (int i = gt; i < 4 * MT; i += ntot) p->rowss[MT + i] = 0.f;
    prep_rope(p, blockIdx.x, gridDim.x);
}

__device__ __forceinline__ bf16x8 mk_bf16x8(u32x2 lo, u32x2 hi) { u32x4 w; w.x = lo.x; w.y = lo.y; w.z = hi.x; w.w = hi.y; return __builtin_bit_cast(bf16x8, w); }

__device__ __forceinline__ void swa_item(PP p, int item, int lane) {
    const int fr = lane & 15, fq = lane >> 4;
    int head, kvh, tq, qrow, krow_base, row_hi;
    if (item < 8192) { head = item & 7; const int p0 = (item >> 3) * 16; kvh = head >> 2; tq = fr; qrow = p0 + fr; krow_base = p0 - 128; row_hi = MP + 127; }
    else { const int it = item - 8192; const int b = it >> 2; kvh = (it >> 1) & 1; head = kvh * 4 + (it & 1) * 2 + (fr >> 3); tq = fr & 7; qrow = MP + b * 8 + tq; krow_base = MP + b * SBS; row_hi = krow_base + 135; }
    const float sink = p->sinks[head];
    const bf16_t* Kb = p->Kb + kvh * 64 + fq * 8;
    const bf16_t* Vt = p->Vt + (size_t)(kvh * 64 + fr) * KROWS;
    bf16x8 Qf[2];
#pragma unroll
    for (int ks = 0; ks < 2; ++ks) Qf[ks] = *(const bf16x8*)(p->Q + (size_t)qrow * 512 + head * 64 + ks * 32 + fq * 8);
    float mrun = sink, lrun = (fq == 0) ? 1.f : 0.f;
    f32x4 Oa[4];
#pragma unroll
    for (int db = 0; db < 4; ++db) Oa[db] = (f32x4){0.f, 0.f, 0.f, 0.f};
    const int koff = (fr >> 2) * 8 + (fr & 3);
    const int cstart = krow_base < 0 ? ((-krow_base) >> 5) : 0;
    bf16x8 Kf[2][2], Vf[4];
    auto load_chunk = [&](int cc) {
        const int rbase = krow_base + cc * 32;
#pragma unroll
        for (int kb = 0; kb < 2; ++kb) {
            int kr = rbase + koff + kb * 4; kr = kr < 0 ? 0 : (kr > row_hi ? row_hi : kr);
            const bf16_t* kp = Kb + (size_t)kr * 128;
            Kf[kb][0] = *(const bf16x8*)kp; Kf[kb][1] = *(const bf16x8*)(kp + 32);
        }
        int vt = rbase + fq * 8; vt = vt < 0 ? 0 : (vt > row_hi - 7 ? row_hi - 7 : vt);
#pragma unroll
        for (int db = 0; db < 4; ++db) Vf[db] = *(const bf16x8*)(Vt + (size_t)db * 16 * KROWS + vt);
    };
    load_chunk(cstart);
    for (int cc = cstart; cc < 5; ++cc) {
        const int c0 = cc * 32;
        f32x4 S[2];
#pragma unroll
        for (int kb = 0; kb < 2; ++kb) {
            S[kb] = __builtin_amdgcn_mfma_f32_16x16x32_bf16(Kf[kb][0], Qf[0], (f32x4){0.f, 0.f, 0.f, 0.f}, 0, 0, 0);
            S[kb] = __builtin_amdgcn_mfma_f32_16x16x32_bf16(Kf[kb][1], Qf[1], S[kb], 0, 0, 0);
        }
        bf16x8 Vc[4];
#pragma unroll
        for (int db = 0; db < 4; ++db) Vc[db] = Vf[db];
        if (cc + 1 < 5) load_chunk(cc + 1);
        bool valid[2][4]; float mx = -1e30f;
#pragma unroll
        for (int kb = 0; kb < 2; ++kb)
#pragma unroll
            for (int j = 0; j < 4; ++j) { const int c = c0 + fq * 8 + kb * 4 + j; valid[kb][j] = (c >= tq) && (c <= 128 + tq) && (krow_base + c >= 0); if (valid[kb][j]) mx = fmaxf(mx, S[kb][j]); }
        mx = fmaxf(mx, __shfl_xor(mx, 16)); mx = fmaxf(mx, __shfl_xor(mx, 32));
        const float mnew = fmaxf(mrun, mx); const float alpha = __expf(mrun - mnew); mrun = mnew;
        float ps = 0.f; float pv[2][4];
#pragma unroll
        for (int kb = 0; kb < 2; ++kb)
#pragma unroll
            for (int j = 0; j < 4; ++j) { pv[kb][j] = valid[kb][j] ? __expf(S[kb][j] - mnew) : 0.f; ps += pv[kb][j]; }
        lrun = lrun * alpha + ps;
        u32x4 pw; pw.x = cvt_pk_bf16(pv[0][0], pv[0][1]); pw.y = cvt_pk_bf16(pv[0][2], pv[0][3]); pw.z = cvt_pk_bf16(pv[1][0], pv[1][1]); pw.w = cvt_pk_bf16(pv[1][2], pv[1][3]);
        const bf16x8 Pf = __builtin_bit_cast(bf16x8, pw);
#pragma unroll
        for (int db = 0; db < 4; ++db) {
            Oa[db] = Oa[db] * alpha;
            Oa[db] = __builtin_amdgcn_mfma_f32_16x16x32_bf16(Vc[db], Pf, Oa[db], 0, 0, 0);
        }
    }
    lrun += __shfl_xor(lrun, 16); lrun += __shfl_xor(lrun, 32);
    const float inv = 1.0f / lrun;
#pragma unroll
    for (int db = 0; db < 4; ++db) {
        u32x2 w; w.x = cvt_pk_bf16(Oa[db][0] * inv, Oa[db][1] * inv); w.y = cvt_pk_bf16(Oa[db][2] * inv, Oa[db][3] * inv);
        *(u32x2*)(p->O + (size_t)qrow * 512 + head * 64 + db * 16 + fq * 4) = w;
    }
}

__device__ __forceinline__ void swa_lds_core(const bf16_t* LK, const bf16_t* LV, const bf16x8 Qf0, const bf16x8 Qf1, float sink, int tq, int lbase, int cmin, int krmax, int vtmax, int cstart,
                                             f32x4 (&Oa)[4], float& inv, int fr, int fq) {
    const int koff = (fr >> 2) * 8 + (fr & 3);
    float mrun = sink, lrun = (fq == 0) ? 1.f : 0.f;
#pragma unroll
    for (int db = 0; db < 4; ++db) Oa[db] = (f32x4){0.f, 0.f, 0.f, 0.f};
    for (int cc = cstart; cc < 5; ++cc) {
        const int c0 = cc * 32, rbase = lbase + c0;
        f32x4 S[2];
#pragma unroll
        for (int kb = 0; kb < 2; ++kb) {
            int kr = rbase + koff + kb * 4; kr = kr > krmax ? krmax : kr;
            const bf16_t* kp = LK + kr * 72 + fq * 8;
            S[kb] = __builtin_amdgcn_mfma_f32_16x16x32_bf16(*(const bf16x8*)kp, Qf0, (f32x4){0.f, 0.f, 0.f, 0.f}, 0, 0, 0);
            S[kb] = __builtin_amdgcn_mfma_f32_16x16x32_bf16(*(const bf16x8*)(kp + 32), Qf1, S[kb], 0, 0, 0);
        }
        bool valid[2][4]; float mx = -1e30f;
#pragma unroll
        for (int kb = 0; kb < 2; ++kb)
#pragma unroll
            for (int j = 0; j < 4; ++j) { const int c = c0 + fq * 8 + kb * 4 + j; valid[kb][j] = (c >= tq) && (c <= 128 + tq) && (c >= cmin); if (valid[kb][j]) mx = fmaxf(mx, S[kb][j]); }
        mx = fmaxf(mx, __shfl_xor(mx, 16)); mx = fmaxf(mx, __shfl_xor(mx, 32));
        const float mnew = fmaxf(mrun, mx); const float alpha = __expf(mrun - mnew); mrun = mnew;
        float ps = 0.f; float pv[2][4];
#pragma unroll
        for (int kb = 0; kb < 2; ++kb)
#pragma unroll
            for (int j = 0; j < 4; ++j) { pv[kb][j] = valid[kb][j] ? __expf(S[kb][j] - mnew) : 0.f; ps += pv[kb][j]; }
        lrun = lrun * alpha + ps;
        u32x4 pw; pw.x = cvt_pk_bf16(pv[0][0], pv[0][1]); pw.y = cvt_pk_bf16(pv[0][2], pv[0][3]); pw.z = cvt_pk_bf16(pv[1][0], pv[1][1]); pw.w = cvt_pk_bf16(pv[1][2], pv[1][3]);
        const bf16x8 Pf = __builtin_bit_cast(bf16x8, pw);
        int vt = rbase + fq * 8; vt = vt > vtmax ? vtmax : vt;
#pragma unroll
        for (int db = 0; db < 4; ++db) {
            Oa[db] = Oa[db] * alpha;
            Oa[db] = __builtin_amdgcn_mfma_f32_16x16x32_bf16(*(const bf16x8*)(LV + (db * 16 + fr) * 264 + vt), Pf, Oa[db], 0, 0, 0);
        }
    }
    lrun += __shfl_xor(lrun, 16); lrun += __shfl_xor(lrun, 32);
    inv = 1.0f / lrun;
}
__device__ __forceinline__ void swa_prompt_block(PP p, unsigned char* smem, int item) {
    const int tid = opaque_tid(), wid = tid >> 6, lane = tid & 63, fr = lane & 15, fq = lane >> 4;
    const int kvh = item & 1, tile = item >> 1;
    const int key0 = tile * 128 - 128;
    bf16_t* LK = (bf16_t*)smem; bf16_t* LV = (bf16_t*)(smem + 256 * 144);
    __syncthreads();
#pragma unroll
    for (int j = 0; j < 4; ++j) {
        const int pi = tid + 512 * j;
        { const int row = pi >> 3, cp = pi & 7; int gr = key0 + row; gr = gr < 0 ? 0 : gr;
          *(u32x4*)(LK + row * 72 + cp * 8) = *(const u32x4*)(p->Kb + (size_t)gr * 128 + kvh * 64 + cp * 8); }
        { const int d = pi >> 5, cp = pi & 31; int gk = key0 + cp * 8; gk = gk < 0 ? 0 : gk;
          *(u32x4*)(LV + d * 264 + cp * 8) = *(const u32x4*)(p->Vt + (size_t)(kvh * 64 + d) * KROWS + gk); }
    }
    __syncthreads();
    const int p0 = tile * 128 + wid * 16, lbase = wid * 16;
    const int cstart = (tile == 0) ? ((128 - lbase) >> 5) : 0;
    const int cmin = (key0 + lbase) < 0 ? -(key0 + lbase) : 0;
#pragma unroll 1
    for (int hh = 0; hh < 4; ++hh) {
        const int head = kvh * 4 + hh;
        const bf16_t* qp = p->Q + (size_t)(p0 + fr) * 512 + head * 64 + fq * 8;
        f32x4 Oa[4]; float inv;
        swa_lds_core(LK, LV, *(const bf16x8*)qp, *(const bf16x8*)(qp + 32), p->sinks[head], fr, lbase, cmin, 255, 248, cstart, Oa, inv, fr, fq);
#pragma unroll
        for (int db = 0; db < 4; ++db) {
            u32x2 w; w.x = cvt_pk_bf16(Oa[db][0] * inv, Oa[db][1] * inv); w.y = cvt_pk_bf16(Oa[db][2] * inv, Oa[db][3] * inv);
            *(u32x2*)(p->O + (size_t)(p0 + fr) * 512 + head * 64 + db * 16 + fq * 4) = w;
        }
    }
}
__device__ __forceinline__ void swa_sample_block(PP p, unsigned char* smem, int item) {
    const int tid = opaque_tid(), wid = tid >> 6, lane = tid & 63, fr = lane & 15, fq = lane >> 4;
    const int kvh = item & 1, b = item >> 1;
    const int row0 = MP + b * SBS;
    bf16_t* LK = (bf16_t*)smem; bf16_t* LV = (bf16_t*)(smem + 256 * 144);
    __syncthreads();
    for (int pi = tid; pi < 1088; pi += 512) {
        { const int row = pi >> 3, cp = pi & 7;
          *(u32x4*)(LK + row * 72 + cp * 8) = *(const u32x4*)(p->Kb + (size_t)(row0 + row) * 128 + kvh * 64 + cp * 8); }
        { const int d = pi / 17, cp = pi - d * 17;
          *(u32x4*)(LV + d * 264 + cp * 8) = *(const u32x4*)(p->Vt + (size_t)(kvh * 64 + d) * KROWS + row0 + cp * 8); }
    }
    __syncthreads();
    if (wid < 2) {
        const int head = kvh * 4 + wid * 2 + (fr >> 3), tq = fr & 7, qrow = MP + b * 8 + tq;
        const bf16_t* qp = p->Q + (size_t)qrow * 512 + head * 64 + fq * 8;
        f32x4 Oa[4]; float inv;
        swa_lds_core(LK, LV, *(const bf16x8*)qp, *(const bf16x8*)(qp + 32), p->sinks[head], tq, 0, 0, 135, 128, 0, Oa, inv, fr, fq);
#pragma unroll
        for (int db = 0; db < 4; ++db) {
            u32x2 w; w.x = cvt_pk_bf16(Oa[db][0] * inv, Oa[db][1] * inv); w.y = cvt_pk_bf16(Oa[db][2] * inv, Oa[db][3] * inv);
            *(u32x2*)(p->O + (size_t)qrow * 512 + head * 64 + db * 16 + fq * 4) = w;
        }
    }
}

__device__ __forceinline__ void ssm_stage_u(const float* U, int row0, int g, int ntok, float* us, int lane) {
    if (lane < ntok) {
        const float* gp = U + (size_t)(row0 + lane) * 512 + g * 16;
        const f32x4 v0 = *(const f32x4*)gp, v1 = *(const f32x4*)(gp + 4), v2 = *(const f32x4*)(gp + 8), v3 = *(const f32x4*)(gp + 12);
        float* up = us + lane * 16;
        *(f32x4*)up = v0; *(f32x4*)(up + 4) = v1; *(f32x4*)(up + 8) = v2; *(f32x4*)(up + 12) = v3;
    }
    wave_lds_sync();
}
__device__ __forceinline__ void ssm_pass1(PP p, unsigned char* smem) {
    const int tid = opaque_tid(), wid = tid >> 6, lane = tid & 63;
    float* hb = (float*)(smem + wid * 12800);
    float* us = (float*)(smem + wid * 12800 + 8704);
    const int tsub = lane >> 4, ch = lane & 15;
    for (int item = blockIdx.x * 8 + wid; item < 8192; item += gridDim.x * 8) {
        const int c = item >> 5, g = item & 31, gn = g * 64 + lane;
        ssm_stage_u(p->U, c * 64, g, 64, us, lane);
        f32x4 bX[8];
#pragma unroll
        for (int cb = 0; cb < 8; ++cb) bX[cb] = *(const f32x4*)(p->ssmtab + 8192 + (size_t)(g * 64 + cb * 8 + (ch >> 1)) * 32 + (ch & 1) * 16 + tsub * 4);
        const float lbr = p->ssmtab[gn * 2], lbi = p->ssmtab[gn * 2 + 1];
        float hr = 0.f, hi = 0.f;
        for (int t0 = 0; t0 < 64; t0 += 16) {
            const f32x4 uA = *(const f32x4*)(us + (t0 + ch) * 16 + tsub * 4);
#pragma unroll
            for (int cb = 0; cb < 8; ++cb) {
                f32x4 xv = (f32x4){0.f, 0.f, 0.f, 0.f};
#pragma unroll
                for (int q = 0; q < 4; ++q) xv = __builtin_amdgcn_mfma_f32_16x16x4f32(uA[q], bX[cb][q], xv, 0, 0, 0);
#pragma unroll
                for (int j = 0; j < 4; ++j) hb[(tsub * 4 + j) * 132 + cb * 16 + ch] = xv[j];
            }
            wave_lds_sync();
            f32x2 xq[16];
#pragma unroll
            for (int t = 0; t < 16; ++t) xq[t] = *(const f32x2*)(hb + t * 132 + lane * 2);
#pragma unroll
            for (int t = 0; t < 16; ++t) { const float nr = lbr * hr - lbi * hi + xq[t][0], ni = lbr * hi + lbi * hr + xq[t][1]; hr = nr; hi = ni; }
            wave_lds_sync();
        }
        p->Schunk[((size_t)c * 2048 + gn) * 2] = hr; p->Schunk[((size_t)c * 2048 + gn) * 2 + 1] = hi;
    }
}
__device__ __forceinline__ void ssm_pass2(PP p) {
    const int gn = blockIdx.x * 512 + opaque_tid();
    if (gn >= 2048) return;
    const float lr = p->ssmtab[4096 + gn * 2], li = p->ssmtab[4096 + gn * 2 + 1];
    float hr = 0.f, hi = 0.f;
#pragma unroll 8
    for (int c = 0; c < 256; ++c) {
        p->Carry[((size_t)c * 2048 + gn) * 2] = hr; p->Carry[((size_t)c * 2048 + gn) * 2 + 1] = hi;
        const float sr = p->Schunk[((size_t)c * 2048 + gn) * 2], si = p->Schunk[((size_t)c * 2048 + gn) * 2 + 1];
        const float nr = lr * hr - li * hi + sr, ni = lr * hi + li * hr + si; hr = nr; hi = ni;
    }
    p->out[OFF_SRP + gn] = hr; p->out[OFF_SIP + gn] = hi;
}
__device__ __forceinline__ void ssm_pass3(PP p, unsigned char* smem, int wg, int nwg) {
    const int tid = opaque_tid(), wid = tid >> 6, lane = tid & 63;
    float* hb = (float*)(smem + wid * 12800);
    float* us = (float*)(smem + wid * 12800 + 8704);
    const int tsub = lane >> 4, ch = lane & 15;
    float cHr = 0.f, cHi = 0.f; int cj = 0, cg = -1;
    f32x4 bX[8]; float cB[32]; float lbr = 0.f, lbi = 0.f, lr = 0.f, li = 0.f, dsk = 0.f; int cgc = -1;
    for (int item = wg * 8 + wid; item < 8192 + 4096; item += nwg * 8) {
        int g, row0, ntok, sb = 0, c = 0; float hr, hi;
        if (item < 8192) { c = item >> 5; g = item & 31; row0 = c * 64; ntok = 64; }
        else { const int it = item - 8192; sb = it >> 5; g = it & 31; row0 = MP + sb * 8; ntok = 8; }
        const int gn = g * 64 + lane;
        f32x4 su0, su1, su2, su3;
        if (lane < ntok) { const float* gp = p->U + (size_t)(row0 + lane) * 512 + g * 16; su0 = *(const f32x4*)gp; su1 = *(const f32x4*)(gp + 4); su2 = *(const f32x4*)(gp + 8); su3 = *(const f32x4*)(gp + 12); }
        if (g != cgc) {
            cgc = g;
#pragma unroll
            for (int cb = 0; cb < 8; ++cb) bX[cb] = *(const f32x4*)(p->ssmtab + 8192 + (size_t)(g * 64 + cb * 8 + (ch >> 1)) * 32 + (ch & 1) * 16 + tsub * 4);
            lbr = p->ssmtab[gn * 2]; lbi = p->ssmtab[gn * 2 + 1]; lr = p->ssmtab[4096 + gn * 2]; li = p->ssmtab[4096 + gn * 2 + 1];
#pragma unroll
            for (int i = 0; i < 4; ++i) { const f32x4 a = *(const f32x4*)(p->c_re + (size_t)(g * 16 + ch) * 64 + tsub * 16 + i * 4), b = *(const f32x4*)(p->c_im + (size_t)(g * 16 + ch) * 64 + tsub * 16 + i * 4);
#pragma unroll
                for (int j = 0; j < 4; ++j) { cB[(i * 4 + j) * 2] = a[j]; cB[(i * 4 + j) * 2 + 1] = -b[j]; } }
            dsk = p->ssm_d[g * 16 + ch];
        }
        if (item < 8192) {
            const float* sp = p->Schunk + (size_t)gn * 2;
            if (g != cg || cj > c) { cHr = 0.f; cHi = 0.f; cj = 0; cg = g; }
            int j = cj;
            for (; j + 32 <= c; j += 32) {
                f32x2 sv[32];
#pragma unroll
                for (int e = 0; e < 32; ++e) sv[e] = *(const f32x2*)(sp + (size_t)(j + e) * 4096);
                __builtin_amdgcn_sched_barrier(0);
#pragma unroll
                for (int e = 0; e < 32; ++e) { const float nr = lr * cHr - li * cHi + sv[e][0], ni = lr * cHi + li * cHr + sv[e][1]; cHr = nr; cHi = ni; }
            }
            for (; j + 8 <= c; j += 8) {
                f32x2 sv[8];
#pragma unroll
                for (int e = 0; e < 8; ++e) sv[e] = *(const f32x2*)(sp + (size_t)(j + e) * 4096);
#pragma unroll
                for (int e = 0; e < 8; ++e) { const float nr = lr * cHr - li * cHi + sv[e][0], ni = lr * cHi + li * cHr + sv[e][1]; cHr = nr; cHi = ni; }
            }
            for (; j < c; ++j) { const float sr = sp[(size_t)j * 4096], si = sp[(size_t)j * 4096 + 1]; const float nr = lr * cHr - li * cHi + sr, ni = lr * cHi + li * cHr + si; cHr = nr; cHi = ni; }
            cj = c; hr = cHr; hi = cHi;
        } else { hr = p->state_re[(size_t)sb * 2048 + gn]; hi = p->state_im[(size_t)sb * 2048 + gn]; }
        if (lane < ntok) { float* up = us + lane * 16; *(f32x4*)up = su0; *(f32x4*)(up + 4) = su1; *(f32x4*)(up + 8) = su2; *(f32x4*)(up + 12) = su3; }
        wave_lds_sync();
        for (int t0 = 0; t0 < ntok; t0 += 16) {
            const int nt = (ntok - t0) < 16 ? (ntok - t0) : 16;
            {
                const f32x4 uA = *(const f32x4*)(us + (t0 + ch) * 16 + tsub * 4);
#pragma unroll
                for (int cb = 0; cb < 8; ++cb) {
                    f32x4 xv = (f32x4){0.f, 0.f, 0.f, 0.f};
#pragma unroll
                    for (int q = 0; q < 4; ++q) xv = __builtin_amdgcn_mfma_f32_16x16x4f32(uA[q], bX[cb][q], xv, 0, 0, 0);
#pragma unroll
                    for (int j = 0; j < 4; ++j) hb[(tsub * 4 + j) * 132 + cb * 16 + ch] = xv[j];
                }
            }
            wave_lds_sync();
            for (int tb = 0; tb < nt; tb += 4) {
                f32x2 xq[4];
#pragma unroll
                for (int tt = 0; tt < 4; ++tt) xq[tt] = *(const f32x2*)(hb + (tb + tt) * 132 + lane * 2);
#pragma unroll
                for (int tt = 0; tt < 4; ++tt) {
                    const float nr = lbr * hr - lbi * hi + xq[tt][0], ni = lbr * hi + lbi * hr + xq[tt][1]; hr = nr; hi = ni;
                    *(f32x2*)(hb + (tb + tt) * 132 + lane * 2) = (f32x2){hr, hi};
                }
            }
            wave_lds_sync();
            {
                f32x4 hA[8];
#pragma unroll
                for (int e = 0; e < 8; ++e) hA[e] = *(const f32x4*)(hb + ch * 132 + tsub * 32 + e * 4);
                f32x4 yv = (f32x4){0.f, 0.f, 0.f, 0.f};
#pragma unroll
                for (int e = 0; e < 8; ++e)
#pragma unroll
                    for (int q = 0; q < 4; ++q) yv = __builtin_amdgcn_mfma_f32_16x16x4f32(hA[e][q], cB[e * 4 + q], yv, 0, 0, 0);
#pragma unroll
                for (int j = 0; j < 4; ++j) {
                    const int t = tsub * 4 + j;
                    if (t < nt) {
                        const int row = row0 + t0 + t;
                        const float uval = us[(t0 + t) * 16 + ch];
                        const float y = yv[j] + dsk * uval;
                        const float inner = 0.7978845608028654f * (y + 0.044715f * y * y * y);
                        const float e2 = __expf(2.0f * inner);
                        const float th = 1.0f - 2.0f * __builtin_amdgcn_rcpf(e2 + 1.0f);
                        const float z = 0.5f * y * (1.0f + th);
                        p->Z[(size_t)row * 512 + g * 16 + ch] = (bf16_t)(cvt_pk_bf16(z, 0.f) & 0xffffu);
                    }
                }
            }
            wave_lds_sync();
        }
        if (item >= 8192) { p->out[OFF_SRS + (size_t)sb * 2048 + gn] = hr; p->out[OFF_SIS + (size_t)sb * 2048 + gn] = hi; }
        else if ((item >> 5) == 255) { p->out[OFF_SRP + gn] = hr; p->out[OFF_SIP + gn] = hi; }
    }
}

__device__ __forceinline__ void xattn_prompt_item(PP p, int item, int lane) {
    const int fr = lane & 15, fq = lane >> 4;
    const int h = item & 3, q0 = (item >> 2) * 16;
    bf16x8 Qf[8];
#pragma unroll
    for (int ks = 0; ks < 8; ++ks) Qf[ks] = *(const bf16x8*)(p->XQ + (size_t)(q0 + fr) * DM + h * 256 + ks * 32 + fq * 8);
    const bf16_t* kbase = p->MK + (size_t)((fr >> 2) * 8 + (fr & 3)) * DM + h * 256 + fq * 8;
    f32x4 S[16];
    bf16x8 Kf[2][8];
#pragma unroll
    for (int ks = 0; ks < 8; ++ks) Kf[0][ks] = *(const bf16x8*)(kbase + ks * 32);
#pragma unroll
    for (int kb = 0; kb < 16; ++kb) {
        if (kb + 1 < 16) {
            const bf16_t* kp = kbase + (size_t)(((kb + 1) >> 1) * 32 + ((kb + 1) & 1) * 4) * DM;
#pragma unroll
            for (int ks = 0; ks < 8; ++ks) Kf[(kb + 1) & 1][ks] = *(const bf16x8*)(kp + ks * 32);
        }
        __builtin_amdgcn_sched_barrier(0);
        S[kb] = (f32x4){0.f, 0.f, 0.f, 0.f};
#pragma unroll
        for (int ks = 0; ks < 8; ++ks) S[kb] = __builtin_amdgcn_mfma_f32_16x16x32_bf16(Kf[kb & 1][ks], Qf[ks], S[kb], 0, 0, 0);
        __builtin_amdgcn_sched_barrier(0);
    }
    float mx = -1e30f;
#pragma unroll
    for (int kb = 0; kb < 16; ++kb)
#pragma unroll
        for (int j = 0; j < 4; ++j) mx = fmaxf(mx, S[kb][j]);
    mx = fmaxf(mx, __shfl_xor(mx, 16)); mx = fmaxf(mx, __shfl_xor(mx, 32));
    float l = 0.f;
#pragma unroll
    for (int kb = 0; kb < 16; ++kb)
#pragma unroll
        for (int j = 0; j < 4; ++j) { S[kb][j] = __expf(S[kb][j] - mx); l += S[kb][j]; }
    l += __shfl_xor(l, 16); l += __shfl_xor(l, 32);
    const float inv = 1.0f / l;
    bf16x8 Pf[8];
#pragma unroll
    for (int kk = 0; kk < 8; ++kk) {
        u32x4 pw; pw.x = cvt_pk_bf16(S[2 * kk][0] * inv, S[2 * kk][1] * inv); pw.y = cvt_pk_bf16(S[2 * kk][2] * inv, S[2 * kk][3] * inv);
        pw.z = cvt_pk_bf16(S[2 * kk + 1][0] * inv, S[2 * kk + 1][1] * inv); pw.w = cvt_pk_bf16(S[2 * kk + 1][2] * inv, S[2 * kk + 1][3] * inv);
        Pf[kk] = __builtin_bit_cast(bf16x8, pw);
    }
    const bf16_t* vbase = p->MVt + (size_t)(h * 256 + fr) * 256 + fq * 8;
    bf16x8 Vf[2][4][4];
#pragma unroll
    for (int k4 = 0; k4 < 4; ++k4)
#pragma unroll
        for (int db = 0; db < 4; ++db) Vf[0][k4][db] = *(const bf16x8*)(vbase + (size_t)db * 16 * 256 + k4 * 32);
    f32x4 Oa[4];
#pragma unroll
    for (int bt = 0; bt < 8; ++bt) {
        const int dh = bt >> 1, kh = bt & 1;
        if (bt + 1 < 8) {
            const int dh1 = (bt + 1) >> 1, kh1 = (bt + 1) & 1;
#pragma unroll
            for (int k4 = 0; k4 < 4; ++k4)
#pragma unroll
                for (int db = 0; db < 4; ++db) Vf[(bt + 1) & 1][k4][db] = *(const bf16x8*)(vbase + (size_t)(dh1 * 64 + db * 16) * 256 + (kh1 * 4 + k4) * 32);
        }
        __builtin_amdgcn_sched_barrier(0);
        if (kh == 0) {
#pragma unroll
            for (int db = 0; db < 4; ++db) Oa[db] = (f32x4){0.f, 0.f, 0.f, 0.f};
        }
#pragma unroll
        for (int k4 = 0; k4 < 4; ++k4)
#pragma unroll
            for (int db = 0; db < 4; ++db) Oa[db] = __builtin_amdgcn_mfma_f32_16x16x32_bf16(Vf[bt & 1][k4][db], Pf[kh * 4 + k4], Oa[db], 0, 0, 0);
        if (kh == 1) {
#pragma unroll
            for (int db = 0; db < 4; ++db) {
                u32x2 w; w.x = cvt_pk_bf16(Oa[db][0], Oa[db][1]); w.y = cvt_pk_bf16(Oa[db][2], Oa[db][3]);
                *(u32x2*)(p->XO + (size_t)(q0 + fr) * DM + h * 256 + dh * 64 + db * 16 + fq * 4) = w;
            }
        }
        __builtin_amdgcn_sched_barrier(0);
    }
}
__device__ __forceinline__ void xattn_prompt_block(PP p, unsigned char* smem, int item) {
    const int tid = opaque_tid(), wid = tid >> 6, lane = tid & 63, fr = lane & 15, fq = lane >> 4;
    const int h = item & 3, q0 = (item >> 2) * 128 + wid * 16;
    bf16_t* L = (bf16_t*)smem;
    bf16x8 Qf[8];
#pragma unroll
    for (int ks = 0; ks < 8; ++ks) Qf[ks] = *(const bf16x8*)(p->XQ + (size_t)(q0 + fr) * DM + h * 256 + ks * 32 + fq * 8);
    f32x4 S[16];
#pragma unroll
    for (int kb = 0; kb < 16; ++kb) S[kb] = (f32x4){0.f, 0.f, 0.f, 0.f};
    u32x4 stg[4];
    const bf16_t* ksrc = p->MK + (size_t)(tid >> 5) * DM + h * 256 + (tid & 31) * 8;
    bf16_t* kdst = L + (tid >> 5) * 264 + (tid & 31) * 8;
#pragma unroll
    for (int j = 0; j < 4; ++j) stg[j] = *(const u32x4*)(ksrc + (size_t)(16 * j) * DM);
    const int krow = (fr >> 2) * 8 + (fr & 3);
#pragma unroll 1
    for (int ck = 0; ck < 4; ++ck) {
        __syncthreads();
#pragma unroll
        for (int j = 0; j < 4; ++j) *(u32x4*)(kdst + (16 * j) * 264) = stg[j];
        __syncthreads();
        if (ck < 3) {
#pragma unroll
            for (int j = 0; j < 4; ++j) stg[j] = *(const u32x4*)(ksrc + (size_t)((ck + 1) * 64 + 16 * j) * DM);
        }
#pragma unroll
        for (int b = 0; b < 4; ++b) {
            const bf16_t* kp = L + ((b >> 1) * 32 + (b & 1) * 4 + krow) * 264 + fq * 8;
            f32x4 acc = (f32x4){0.f, 0.f, 0.f, 0.f};
#pragma unroll
            for (int ks = 0; ks < 8; ++ks) acc = __builtin_amdgcn_mfma_f32_16x16x32_bf16(*(const bf16x8*)(kp + ks * 32), Qf[ks], acc, 0, 0, 0);
#pragma unroll
            for (int c4 = 0; c4 < 4; ++c4) if (c4 == ck) S[c4 * 4 + b] = acc;
        }
    }
    float mx = -1e30f;
#pragma unroll
    for (int kb = 0; kb < 16; ++kb)
#pragma unroll
        for (int j = 0; j < 4; ++j) mx = fmaxf(mx, S[kb][j]);
    mx = fmaxf(mx, __shfl_xor(mx, 16)); mx = fmaxf(mx, __shfl_xor(mx, 32));
    float l = 0.f;
#pragma unroll
    for (int kb = 0; kb < 16; ++kb)
#pragma unroll
        for (int j = 0; j < 4; ++j) { S[kb][j] = __expf(S[kb][j] - mx); l += S[kb][j]; }
    l += __shfl_xor(l, 16); l += __shfl_xor(l, 32);
    const float inv = 1.0f / l;
    bf16x8 Pf[8];
#pragma unroll
    for (int kk = 0; kk < 8; ++kk) {
        u32x4 pw; pw.x = cvt_pk_bf16(S[2 * kk][0] * inv, S[2 * kk][1] * inv); pw.y = cvt_pk_bf16(S[2 * kk][2] * inv, S[2 * kk][3] * inv);
        pw.z = cvt_pk_bf16(S[2 * kk + 1][0] * inv, S[2 * kk + 1][1] * inv); pw.w = cvt_pk_bf16(S[2 * kk + 1][2] * inv, S[2 * kk + 1][3] * inv);
        Pf[kk] = __builtin_bit_cast(bf16x8, pw);
    }
    f32x4 Oa[16];
#pragma unroll
    for (int db = 0; db < 16; ++db) Oa[db] = (f32x4){0.f, 0.f, 0.f, 0.f};
    const bf16_t* vsrc = p->MVt + (size_t)(h * 256 + (tid >> 3)) * 256 + (tid & 7) * 8;
    bf16_t* vdst = L + (tid >> 3) * 72 + (tid & 7) * 8;
#pragma unroll
    for (int j = 0; j < 4; ++j) stg[j] = *(const u32x4*)(vsrc + (size_t)(64 * j) * 256);
#pragma unroll 1
    for (int ck = 0; ck < 4; ++ck) {
        __syncthreads();
#pragma unroll
        for (int j = 0; j < 4; ++j) *(u32x4*)(vdst + (64 * j) * 72) = stg[j];
        __syncthreads();
        if (ck < 3) {
#pragma unroll
            for (int j = 0; j < 4; ++j) stg[j] = *(const u32x4*)(vsrc + (size_t)(64 * j) * 256 + (ck + 1) * 64);
        }
        bf16x8 P0 = Pf[0], P1 = Pf[1];
#pragma unroll
        for (int c4 = 1; c4 < 4; ++c4) if (c4 == ck) { P0 = Pf[2 * c4]; P1 = Pf[2 * c4 + 1]; }
#pragma unroll
        for (int db = 0; db < 16; ++db) {
            const bf16_t* vp = L + (db * 16 + fr) * 72 + fq * 8;
            Oa[db] = __builtin_amdgcn_mfma_f32_16x16x32_bf16(*(const bf16x8*)vp, P0, Oa[db], 0, 0, 0);
            Oa[db] = __builtin_amdgcn_mfma_f32_16x16x32_bf16(*(const bf16x8*)(vp + 32), P1, Oa[db], 0, 0, 0);
        }
    }
#pragma unroll
    for (int db = 0; db < 16; ++db) {
        u32x2 w; w.x = cvt_pk_bf16(Oa[db][0], Oa[db][1]); w.y = cvt_pk_bf16(Oa[db][2], Oa[db][3]);
        *(u32x2*)(p->XO + (size_t)(q0 + fr) * DM + h * 256 + db * 16 + fq * 4) = w;
    }
    __syncthreads();
}
__device__ __forceinline__ bf16x8 cvt8(const f32x4 a, const f32x4 b) { u32x4 w; w.x = cvt_pk_bf16(a[0], a[1]); w.y = cvt_pk_bf16(a[2], a[3]); w.z = cvt_pk_bf16(b[0], b[1]); w.w = cvt_pk_bf16(b[2], b[3]); return __builtin_bit_cast(bf16x8, w); }

__device__ __forceinline__ void xattn_sample(PP p, unsigned char* smem) {
    const int tid = opaque_tid(), wid = tid >> 6, lane = tid & 63, fr = lane & 15, fq = lane >> 4;
    float* sc = (float*)smem;
    float* red = (float*)(smem + 8192);
    for (int item = blockIdx.x; item < 512; item += gridDim.x) {
        const int b = item >> 2, h = item & 3;
        {
            bf16x8 Qf[8];
#pragma unroll
            for (int ks = 0; ks < 8; ++ks) Qf[ks] = *(const bf16x8*)(p->XQ + (size_t)(MP + b * 8 + (fr & 7)) * DM + h * 256 + ks * 32 + fq * 8);
            f32x4 Kr[2][16];
#pragma unroll
            for (int kb = 0; kb < 2; ++kb) {
                const float* kp = p->cache_mem_k + (((size_t)b * 256 + wid * 32 + kb * 16 + fr) * 4 + h) * 256 + fq * 8;
#pragma unroll
                for (int ks = 0; ks < 8; ++ks) { Kr[kb][2 * ks] = *(const f32x4*)(kp + ks * 32); Kr[kb][2 * ks + 1] = *(const f32x4*)(kp + ks * 32 + 4); }
            }
            __builtin_amdgcn_sched_barrier(0);
#pragma unroll
            for (int kb = 0; kb < 2; ++kb) {
                f32x4 S = (f32x4){0.f, 0.f, 0.f, 0.f};
#pragma unroll
                for (int ks = 0; ks < 8; ++ks) S = __builtin_amdgcn_mfma_f32_16x16x32_bf16(cvt8(Kr[kb][2 * ks], Kr[kb][2 * ks + 1]), Qf[ks], S, 0, 0, 0);
                if (fr < 8) *(f32x4*)(sc + fr * 256 + wid * 32 + kb * 16 + fq * 4) = S;
            }
        }
        __syncthreads();
        {
            f32x4 v = *(const f32x4*)(sc + wid * 256 + lane * 4);
            float mx = fmaxf(fmaxf(v[0], v[1]), fmaxf(v[2], v[3]));
#pragma unroll
            for (int o = 1; o < 64; o <<= 1) mx = fmaxf(mx, __shfl_xor(mx, o));
            v[0] = __expf(v[0] - mx); v[1] = __expf(v[1] - mx); v[2] = __expf(v[2] - mx); v[3] = __expf(v[3] - mx);
            float l = v[0] + v[1] + v[2] + v[3];
#pragma unroll
            for (int o = 1; o < 64; o <<= 1) l += __shfl_xor(l, o);
            const float inv = 1.0f / l;
            *(f32x4*)(sc + wid * 256 + lane * 4) = v * inv;
        }
        __syncthreads();
        {
            f32x4 acc[8];
#pragma unroll
            for (int q = 0; q < 8; ++q) acc[q] = (f32x4){0.f, 0.f, 0.f, 0.f};
            const float* vp = p->cache_mem_v + (((size_t)b * 256 + wid * 32) * 4 + h) * 256 + lane * 4;
#pragma unroll 8
            for (int kk = 0; kk < 32; ++kk) {
                const f32x4 vv = *(const f32x4*)(vp + (size_t)kk * 1024);
#pragma unroll
                for (int q = 0; q < 8; ++q) { const float pq = sc[q * 256 + wid * 32 + kk]; acc[q] += vv * pq; }
            }
#pragma unroll
            for (int q = 0; q < 8; ++q) *(f32x4*)(red + ((size_t)wid * 8 + q) * 256 + lane * 4) = acc[q];
        }
        __syncthreads();
        {
            const int q = tid >> 6, d = (tid & 63) * 4;
            f32x4 s = (f32x4){0.f, 0.f, 0.f, 0.f};
#pragma unroll
            for (int w = 0; w < 8; ++w) s += *(const f32x4*)(red + ((size_t)w * 8 + q) * 256 + d);
            u32x2 o; o.x = cvt_pk_bf16(s[0], s[1]); o.y = cvt_pk_bf16(s[2], s[3]);
            *(u32x2*)(p->XO + (size_t)(MP + b * 8 + q) * DM + h * 256 + d) = o;
        }
        __syncthreads();
    }
}

__device__ __forceinline__ void final_norm(PP p) {
    const int tid = opaque_tid(), wid = tid >> 6, lane = tid & 63;
    f32x4 gv[4];
#pragma unroll
    for (int i = 0; i < 4; ++i) gv[i] = *(const f32x4*)(p->g_final + i * 256 + lane * 4);
    for (int r = blockIdx.x * 8 + wid; r < MT; r += gridDim.x * 8) {
        const float rs = rstd_of(p->rowss[4 * MT + r]);
#pragma unroll
        for (int i = 0; i < 4; ++i) {
            const f32x4 v = *(const f32x4*)(p->X + (size_t)r * DM + i * 256 + lane * 4);
            *(f32x4*)(p->out + OFF_Y + (size_t)r * DM + i * 256 + lane * 4) = v * rs * gv[i];
        }
    }
}


#ifndef DBG_STOP
#define DBG_STOP -1
#endif
#if DBG_STOP >= 0
__device__ __forceinline__ void dump_bf16(const bf16_t* buf, int rows, int len, float*& dst) {
    const int tid = opaque_tid(), wid = tid >> 6, lane = tid & 63;
    for (int r = blockIdx.x * 8 + wid; r < rows; r += gridDim.x * 8) {
        float s = 0.f; for (int i = lane; i < len; i += 64) s += __uint_as_float(((unsigned)buf[(size_t)r * len + i]) << 16);
        for (int o = 1; o < 64; o <<= 1) s += __shfl_xor(s, o);
        if (lane == 0) dst[r] = s;
    }
    dst += rows;
}
__device__ __forceinline__ void dump_f32(const float* buf, int rows, int len, float*& dst) {
    const int tid = opaque_tid(), wid = tid >> 6, lane = tid & 63;
    for (int r = blockIdx.x * 8 + wid; r < rows; r += gridDim.x * 8) {
        float s = 0.f; for (int i = lane; i < len; i += 64) s += buf[(size_t)r * len + i];
        for (int o = 1; o < 64; o <<= 1) s += __shfl_xor(s, o);
        if (lane == 0) dst[r] = s;
    }
    dst += rows;
}
__device__ __forceinline__ void zero_f32(float* buf, size_t n) { for (size_t i = (size_t)blockIdx.x * 512 + opaque_tid(); i < n; i += (size_t)gridDim.x * 512) buf[i] = 0.f; }
__device__ __forceinline__ void dbg_dump(PP p, int k) {
    float* out = p->out;
    zero_f32(out + OFF_Y, (size_t)MT * DM);
    if (k < 1) { zero_f32(out + OFF_MKP, 2 * 262144); }
    if (k < 3) { zero_f32(out + OFF_WKP, 2 * 16384); for (int b = blockIdx.x; b < 128; b += gridDim.x) for (int i = opaque_tid(); i < 1024; i += 512) { out[OFF_WKS + ((size_t)b * 128 + 120) * 128 + i] = 0.f; out[OFF_WVS + ((size_t)b * 128 + 120) * 128 + i] = 0.f; } }
    if (k < 5) { zero_f32(out + OFF_SRP, 4096); }
    if (k < 6) { zero_f32(out + OFF_SRS, 2 * 262144); }
    asm volatile("s_waitcnt vmcnt(0)" ::: "memory"); __syncthreads();
}
__device__ __forceinline__ void dbg_dump2(PP p, int k) {
    float* dst = p->out + OFF_Y;
    dump_bf16(p->XB, MT, 1024, dst);
    dump_bf16(p->MEMB, 256, 1024, dst);
    dump_bf16(p->Wt1, 5632, 1024, dst); dump_bf16(p->Wt2, 1024, 2816, dst); dump_bf16(p->Wt3, 3328, 1024, dst); dump_bf16(p->Wt4, 1024, 512, dst); dump_bf16(p->Wt5, 2048, 512, dst);
    dump_bf16(p->Wt6, 1024, 1024, dst); dump_bf16(p->Wt7, 1024, 1024, dst); dump_bf16(p->Wtkv, 2048, 1024, dst); dump_bf16(p->Wt8, 1024, 1024, dst); dump_bf16(p->Wt9, 5632, 1024, dst); dump_bf16(p->Wt10, 1024, 2816, dst);
    dump_f32(p->rope, 16392, 64, dst); dump_f32(p->ssmtab, 2304, 32, dst);
    if (k == 1 || k == 2) dump_bf16(p->ACT, MT, DFF, dst);
    if (k >= 2) { dump_f32(p->X, MT, 1024, dst); dump_f32(p->rowss + MT, 4 * MT / 32, 32, dst); }
    if (k >= 3 && k <= 6) { dump_bf16(p->Q, MT, 512, dst); dump_bf16(p->SG, MT, 2048, dst); dump_bf16(p->Kb, MP, 128, dst); }
    if (k >= 3 && k <= 5) { dump_f32(p->U, MT, 512, dst); }
    if (k >= 4) { dump_bf16(p->O, MT, 512, dst); dump_f32(p->Schunk, 256, 4096, dst); dump_bf16(p->MK, 256, 1024, dst); dump_bf16(p->MVt, 1024, 256, dst); }
    if (k >= 5) { dump_f32(p->TMP, MT, 1024, dst); dump_f32(p->Carry, 256, 4096, dst); }
    if (k >= 6) { dump_bf16(p->Z, MT, 512, dst); }
    if (k >= 7) { dump_bf16(p->MERGED, MT, 1024, dst); }
    if (k >= 9 && k <= 11) { dump_bf16(p->XQ, MT, 1024, dst); }
    if (k == 10 || k == 11) { dump_bf16(p->XO, MT, 1024, dst); }
    if (k == 12 || k == 13) dump_bf16(p->ACT, MT, DFF, dst);
}
#define DBG_CHECK(k) do { if (DBG_STOP == (k)) { dbg_dump(get_pp(), (k)); GSYNC(); dbg_dump2(get_pp(), (k)); return; } } while (0)
#else
#define DBG_CHECK(k) do { } while (0)
#endif

__global__ void __launch_bounds__(512, 2) fwd_megakernel(Params kernarg_params) {
    extern __shared__ __attribute__((aligned(16))) unsigned char smem[];
    LAS unsigned char* lds = (LAS unsigned char*)smem;
    cg::grid_group grid = cg::this_grid();
    const int G = gridDim.x, c = blockIdx.x;
    { unsigned* bar0 = get_pp()->bar; if (blockIdx.x == 0) for (int i = threadIdx.x; i < XCD_BAR_WORDS; i += 512) bar0[i] = 0u; }
    { PP p = get_pp(); phase_prep(p, smem); }
    asm volatile("s_waitcnt vmcnt(0) lgkmcnt(0)" ::: "memory");
    grid.sync();
    __builtin_amdgcn_fence(__ATOMIC_ACQUIRE, "agent");
    asm volatile("s_waitcnt vmcnt(0)" ::: "memory");
    { unsigned* bar0 = get_pp()->bar; if (threadIdx.x == 0) { volatile LAS unsigned* st = (volatile LAS unsigned*)(lds + 131072); st[0] = 0u; st[1] = 0u; (void)xb_add(&bar0[XB_XCNT(xb_xcc_id())], 1u); } }
    __syncthreads();
    DBG_CHECK(0);
    {
        PP p = get_pp();
        pg8::Gemm g{p->XB, p->Wt1, MT, 5632, 1024}; pg8::StaticOrder S; S.init(MT, 5632, G, c); EpiSwiglu E{p->ACT, nullptr};
        pg8::gemm_phase(lds, g, S, E);
        if (G < 64) { const int tid = opaque_tid(); conv_weight_set(p, 1, c * 8 + (tid >> 6), G * 8, tid & 63); }
        else if (c >= G - 40 && c < G - 8) { const int tid = opaque_tid(); conv_weight_set(p, 1, (c - (G - 40)) * 8 + (tid >> 6), 32 * 8, tid & 63); }
        if (G < 8) { pg8::Gemm g2{p->MEMB, p->Wtkv, 256, 2048, 1024}; pg8::StaticOrder S2; S2.init(256, 2048, G, c); EpiMemKV E2{p->out, p->rowss + 5 * MT}; pg8::gemm_phase(lds, g2, S2, E2); }
        else if (c >= G - 8) { pg8::Gemm g2{p->MEMB, p->Wtkv, 256, 2048, 1024}; pg8::StaticOrder S2; S2.init(256, 2048, 8, c - (G - 8)); EpiMemKV E2{p->out, p->rowss + 5 * MT}; pg8::gemm_phase(lds, g2, S2, E2); }
    }
    GSYNC();
    DBG_CHECK(1);
    {
        PP p = get_pp();
        pg8::Gemm g{p->ACT, p->Wt2, MP, 1024, 2816}; pg8::StaticOrder S; S.init(MP, 1024, G, c); EpiResid E{p->x_prompt, p->x_sample, p->X, p->XB, p->rowss + MT, 0.5f};
        pg8::gemm_phase(lds, g, S, E);
        { SmallEpi se{}; se.src = p->x_sample; se.X = p->X; se.XB = p->XB; se.rowss_next = p->rowss + MT; se.scale = 0.5f; small_gemm_sample<0>(smem, p->ACT, p->Wt2, 2816, se); }
        prep_ctx(p, c, G);
    }
    GSYNC();
    DBG_CHECK(2);
    {
        PP p = get_pp();
        pg8::Gemm g{p->XB, p->Wt3, MT, 3328, 1024}; pg8::StaticOrder S; S.init(MT, 3328, G, c); EpiWin E{p};
        pg8::gemm_phase(lds, g, S, E);
        if (G <= 148) { const int tid = opaque_tid(); conv_weight_set(p, 2, c * 8 + (tid >> 6), G * 8, tid & 63); prep_tables(p, c, G); }
        else if (c >= 116) { const int tid = opaque_tid(); conv_weight_set(p, 2, (c - 116) * 8 + (tid >> 6), (G - 116) * 8, tid & 63); prep_tables(p, c - 116, G - 116); }
    }
    GSYNC();
    DBG_CHECK(3);
    {
        PP p = get_pp();
        for (int item = c; item < 256; item += G) swa_prompt_block(p, smem, item);
        for (int item = c; item < 256; item += G) swa_sample_block(p, smem, item);
        __syncthreads();
        ssm_pass1(p, smem);
        memkv_convert(p);
    }
    GSYNC();
    DBG_CHECK(4);
    {
        PP p = get_pp();
        pg8::Gemm g{p->O, p->Wt4, MP, 1024, 512}; pg8::StaticOrder S; S.init(MP, 1024, G, c); EpiAttnUp E{p->TMP, p->SG};
        pg8::gemm_phase(lds, g, S, E);
        { SmallEpi se{}; se.TMP = p->TMP; se.SG = p->SG; small_gemm_sample<2>(smem, p->O, p->Wt4, 512, se); }
        ssm_pass3(p, smem, c, G);
    }
    GSYNC();
    DBG_CHECK(6);
    {
        PP p = get_pp();
        pg8::Gemm g{p->Z, p->Wt5, MP, 2048, 512}; pg8::StaticOrder S; S.init(MP, 2048, G, c); EpiSsmGlu E{p->TMP, p->SG, p->MERGED};
        pg8::gemm_phase(lds, g, S, E);
        { SmallEpi se{}; se.TMP = p->TMP; se.SG = p->SG; se.MERGED = p->MERGED; se.ntn = 32; small_gemm_sample<3>(smem, p->Z, p->Wt5, 512, se); }
    }
    GSYNC();
    DBG_CHECK(7);
    {
        PP p = get_pp();
        pg8::Gemm g{p->MERGED, p->Wt6, MP, 1024, 1024}; pg8::StaticOrder S; S.init(MP, 1024, G, c); EpiResid E{p->X, p->X + (size_t)MP * DM, p->X, p->XB, p->rowss + 2 * MT, 1.0f};
        pg8::gemm_phase(lds, g, S, E);
        { SmallEpi se{}; se.src = p->X + (size_t)MP * DM; se.X = p->X; se.XB = p->XB; se.rowss_next = p->rowss + 2 * MT; se.scale = 1.0f; small_gemm_sample<0>(smem, p->MERGED, p->Wt6, 1024, se); }
    }
    GSYNC();
    DBG_CHECK(8);
    {
        PP p = get_pp();
        pg8::Gemm g{p->XB, p->Wt7, MP, 1024, 1024}; pg8::StaticOrder S; S.init(MP, 1024, G, c); EpiXq E{p->XQ, p->rowss + 2 * MT};
        pg8::gemm_phase(lds, g, S, E);
        { SmallEpi se{}; se.rowss = p->rowss + 2 * MT; se.XQ = p->XQ; small_gemm_sample<1>(smem, p->XB, p->Wt7, 1024, se); }
    }
    GSYNC();
    DBG_CHECK(9);
    {
        PP p = get_pp();
#if defined(DBG_NO_XS)
        for (size_t i = (size_t)blockIdx.x * 512 + opaque_tid(); i < (size_t)1024 * 1024; i += (size_t)gridDim.x * 512) p->XO[(size_t)MP * DM + i] = 0;
#else
        xattn_sample(p, smem);
#endif
        for (int item = c; item < 512; item += G) xattn_prompt_block(p, smem, item);
    }
    GSYNC();
    DBG_CHECK(10);
    {
        PP p = get_pp();
        pg8::Gemm g{p->XO, p->Wt8, MP, 1024, 1024}; pg8::StaticOrder S; S.init(MP, 1024, G, c); EpiResid E{p->X, p->X + (size_t)MP * DM, p->X, p->XB, p->rowss + 3 * MT, 1.0f};
        pg8::gemm_phase(lds, g, S, E);
        { SmallEpi se{}; se.src = p->X + (size_t)MP * DM; se.X = p->X; se.XB = p->XB; se.rowss_next = p->rowss + 3 * MT; se.scale = 1.0f; small_gemm_sample<0>(smem, p->XO, p->Wt8, 1024, se); }
    }
    GSYNC();
    DBG_CHECK(11);
    {
        PP p = get_pp();
        pg8::Gemm g{p->XB, p->Wt9, MT, 5632, 1024}; pg8::StaticOrder S; S.init(MT, 5632, G, c); EpiSwiglu E{p->ACT, p->rowss + 3 * MT};
        pg8::gemm_phase(lds, g, S, E);
    }
    GSYNC();
    DBG_CHECK(12);
    {
        PP p = get_pp();
        pg8::Gemm g{p->ACT, p->Wt10, MP, 1024, 2816}; pg8::StaticOrder S; S.init(MP, 1024, G, c); EpiResid E{p->X, p->X + (size_t)MP * DM, p->X, nullptr, p->rowss + 4 * MT, 0.5f};
        pg8::gemm_phase(lds, g, S, E);
        { SmallEpi se{}; se.src = p->X + (size_t)MP * DM; se.X = p->X; se.XB = nullptr; se.rowss_next = p->rowss + 4 * MT; se.scale = 0.5f; small_gemm_sample<0>(smem, p->ACT, p->Wt10, 2816, se); }
    }
    GSYNC();
    DBG_CHECK(13);
    { PP p = get_pp(); final_norm(p); }
}

extern "C" void kernel_launch(void* const* d_in, const int* in_sizes, int n_in, void* d_out, int out_size, void* d_ws, size_t ws_size, hipStream_t stream) {
    static int grid_blocks = 0;
    if (!grid_blocks) {
        int dev = 0, cus = 0, per_cu = 0;
        hipGetDevice(&dev);
        hipDeviceGetAttribute(&cus, hipDeviceAttributeMultiprocessorCount, dev);
        hipFuncSetAttribute((const void*)fwd_megakernel, hipFuncAttributeMaxDynamicSharedMemorySize, LDS_BYTES);
        hipOccupancyMaxActiveBlocksPerMultiprocessor(&per_cu, (const void*)fwd_megakernel, 512, LDS_BYTES);
        if (per_cu < 1) per_cu = 1;
        grid_blocks = cus * per_cu;
    }
    Params p; memset(&p, 0, sizeof(p));
    const float** ins = (const float**)&p;
    for (int i = 0; i < 36; ++i) ins[i] = (const float*)d_in[i];
    p.out = (float*)d_out;
    unsigned char* w = (unsigned char*)d_ws; size_t off = 0;
    auto take = [&](size_t bytes) { unsigned char* r = w + off; off += (bytes + 255) & ~(size_t)255; return r; };
    p.Wt1 = (bf16_t*)take((size_t)5632 * 1024 * 2); p.Wt2 = (bf16_t*)take((size_t)1024 * 2816 * 2); p.Wt3 = (bf16_t*)take((size_t)3328 * 1024 * 2);
    p.Wt4 = (bf16_t*)take((size_t)1024 * 512 * 2); p.Wt5 = (bf16_t*)take((size_t)2048 * 512 * 2); p.Wt6 = (bf16_t*)take((size_t)1024 * 1024 * 2);
    p.Wt7 = (bf16_t*)take((size_t)1024 * 1024 * 2); p.Wtkv = (bf16_t*)take((size_t)2048 * 1024 * 2); p.Wt8 = (bf16_t*)take((size_t)1024 * 1024 * 2);
    p.Wt9 = (bf16_t*)take((size_t)5632 * 1024 * 2); p.Wt10 = (bf16_t*)take((size_t)1024 * 2816 * 2);
    p.XB = (bf16_t*)take((size_t)MT * 1024 * 2);
    {
        unsigned char* ra = take((size_t)MT * DFF * 2);
        p.ACT = (bf16_t*)ra; p.SG = (bf16_t*)ra; p.Q = (bf16_t*)(ra + (size_t)MT * 2048 * 2);
        p.XQ = (bf16_t*)ra; p.XO = (bf16_t*)(ra + (size_t)MT * 1024 * 2);
    }
    p.Kb = (bf16_t*)take((size_t)KROWS * 128 * 2); p.Vt = (bf16_t*)take((size_t)128 * KROWS * 2);
    p.O = (bf16_t*)take((size_t)MT * 512 * 2); p.Z = (bf16_t*)take((size_t)MT * 512 * 2);
    p.MEMB = (bf16_t*)take((size_t)256 * 1024 * 2); p.MK = (bf16_t*)take((size_t)256 * 1024 * 2); p.MVt = (bf16_t*)take((size_t)1024 * 256 * 2);
    p.X = (float*)take((size_t)MT * 1024 * 4); p.TMP = (float*)take((size_t)MT * 1024 * 4);
    p.U = (float*)take((size_t)MT * 512 * 4); p.MERGED = (bf16_t*)p.U;
    p.rowss = (float*)take((size_t)(5 * MT + 256) * 4); p.rope = (float*)take((size_t)16392 * 64 * 4); p.ssmtab = (float*)take((size_t)(8192 + 2048 * 32) * 4);
    p.Schunk = (float*)take((size_t)256 * 2048 * 2 * 4); p.Carry = (float*)take((size_t)256 * 2048 * 2 * 4);
    p.bar = (unsigned*)take(XCD_BAR_WORDS * 4);
    if (off > ws_size) { fprintf(stderr, "kernel_launch: workspace too small (%zu > %zu)\n", off, ws_size); return; }
    void* args[] = {&p};
    hipError_t e = hipLaunchCooperativeKernel((const void*)fwd_megakernel, dim3(grid_blocks), dim3(512), args, LDS_BYTES, stream);
    if (e != hipSuccess) fprintf(stderr, "cooperative launch failed: %s (grid %d)\n", hipGetErrorString(e), grid_blocks);
}
```

```cpp
#include <hip/hip_runtime.h>
#include <hip/hip_cooperative_groups.h>
#include <cstdio>
#include <cstring>
namespace cg = cooperative_groups;

#define LAS __attribute__((address_space(3)))
typedef unsigned short bf16_t;
typedef short bf16x8 __attribute__((ext_vector_type(8)));
typedef float f32x4 __attribute__((ext_vector_type(4)));
typedef unsigned u32x4 __attribute__((ext_vector_type(4)));
typedef unsigned u32x2 __attribute__((ext_vector_type(2)));
typedef float f32x2 __attribute__((ext_vector_type(2)));

constexpr int MT = 17408, MP = 16384, DM = 1024, DFF = 2816;
constexpr int SBS = 192;
constexpr int KROWS = 16384 + 128 * SBS + 64;
constexpr int LDS_BYTES = 131072 + 16;

constexpr size_t OFF_Y = 0, OFF_WKP = 17825792, OFF_WVP = 17842176, OFF_SRP = 17858560, OFF_SIP = 17860608,
                 OFF_MKP = 17862656, OFF_MVP = 18124800, OFF_WKS = 18386944, OFF_WVS = 20484096, OFF_SRS = 22581248, OFF_SIS = 22843392;

struct Params {
    const float *x_prompt, *x_sample, *cache_win_k, *cache_win_v, *state_re, *state_im, *cache_mem_k, *cache_mem_v, *mem_prompt;
    const float *g_ffn1, *w_ffn1_in, *w_ffn1_out, *g_mix, *w_in, *sinks, *a_re, *a_im, *log_dt, *b_re, *b_im, *c_re, *c_im, *ssm_d;
    const float *w_attn_up, *w_ssm_glu, *w_out, *g_xattn, *g_mem, *w_xq, *w_xk, *w_xv, *w_xo, *g_ffn2, *w_ffn2_in, *w_ffn2_out, *g_final;
    float* out;
    bf16_t *Wt1, *Wt2, *Wt3, *Wt4, *Wt5, *Wt6, *Wt7, *Wtkv, *Wt8, *Wt9, *Wt10;
    bf16_t *XB, *ACT, *Q, *Kb, *Vt, *SG, *O, *Z, *MERGED, *XQ, *XO, *MEMB, *MK, *MVt;
    float *X, *U, *TMP, *rowss, *rope, *ssmtab, *Schunk, *Carry;
    unsigned* bar;
};

typedef const __attribute__((address_space(4))) Params* PP;
__device__ __forceinline__ PP get_pp() { PP p = (PP)__builtin_amdgcn_kernarg_segment_ptr(); asm volatile("" : "+s"(p)); return p; }
typedef __bf16 bf16v2 __attribute__((ext_vector_type(2)));
typedef float f32v2 __attribute__((ext_vector_type(2)));
__device__ __forceinline__ unsigned cvt_pk_bf16(float lo, float hi) { const f32v2 v = {lo, hi}; const bf16v2 b = __builtin_convertvector(v, bf16v2); return __builtin_bit_cast(unsigned, b); }
__device__ __forceinline__ float sigm(float x) { return __builtin_amdgcn_rcpf(1.0f + __expf(-x)); }
__device__ __forceinline__ float rstd_of(float ss) { return rsqrtf(ss * (1.0f / 1024.0f) + 1e-6f); }
__device__ __forceinline__ int opaque_tid() { int t = threadIdx.x; asm volatile("" : "+v"(t)); return t; }
#define XB_TMO      128
#define XB_XCNT(j)  (256  + 64 * (j))
#define XB_XSUB(j)  (1280 + 64 * (j))
#define XB_XGEN(j)  (2304 + 64 * (j))
#define XB_TOP      3328
#define XB_TOPGEN   3392
#define XCD_BAR_WORDS 3456
#define XB_SPIN_CAP (1u << 18)
__device__ __forceinline__ unsigned xb_ld(unsigned* p)              { return __hip_atomic_load(p, __ATOMIC_RELAXED, __HIP_MEMORY_SCOPE_AGENT); }
__device__ __forceinline__ unsigned xb_add(unsigned* p, unsigned v) { return __hip_atomic_fetch_add(p, v, __ATOMIC_RELAXED, __HIP_MEMORY_SCOPE_AGENT); }
__device__ __forceinline__ unsigned xb_xcc_id() { return (unsigned)__builtin_amdgcn_s_getreg((3 << 11) | 20) & 0xFu; }
#define XB_SPIN(cond, bar) do { unsigned _sp = 0; while (cond) { __builtin_amdgcn_s_sleep(1); \
    if ((++_sp & 255u) == 0u) { if (xb_ld(&(bar)[XB_TMO])) break; if (_sp > XB_SPIN_CAP) { atomicAdd(&(bar)[XB_TMO], 1u); break; } } } } while (0)
__device__ __forceinline__ void xcd_barrier_complete(unsigned* bar, unsigned x, unsigned& nloc, unsigned& nx) {
    const unsigned G = gridDim.x * gridDim.y * gridDim.z;
    unsigned sum, cnt, mine, sp = 0u;
    for (;;) {
        sum = 0u; cnt = 0u; mine = 0u;
#pragma unroll
        for (unsigned j = 0; j < 16; ++j) { const unsigned c = xb_ld(&bar[XB_XCNT(j)]); sum += c; cnt += (c > 0u) ? 1u : 0u; mine = (j == x) ? c : mine; }
        if (sum == G) break;
        __builtin_amdgcn_s_sleep(1);
        if ((++sp & 255u) == 0u) { if (xb_ld(&bar[XB_TMO])) break; if (sp > XB_SPIN_CAP) { atomicAdd(&bar[XB_TMO], 1u); break; } }
    }
    nloc = mine > 0u ? mine : 1u; nx = cnt > 0u ? cnt : 1u;
}
__device__ __forceinline__ void xcd_barrier(unsigned* bar, volatile LAS unsigned* st) {
    asm volatile("s_waitcnt vmcnt(0)" ::: "memory");
    __syncthreads();
    if (threadIdx.x == 0) {
        const unsigned x = xb_xcc_id();
        __builtin_amdgcn_s_waitcnt(0);
        unsigned nloc = st[0], nx = st[1];
        if (nloc == 0u) { xcd_barrier_complete(bar, x, nloc, nx); st[0] = nloc; st[1] = nx; }
        const unsigned old = xb_add(&bar[XB_XSUB(x)], 1u);
        const unsigned gen = old / nloc;
        if (old + 1u == (gen + 1u) * nloc) {
            __builtin_amdgcn_fence(__ATOMIC_RELEASE, "agent");
            asm volatile("s_waitcnt vmcnt(0)" ::: "memory");
            const unsigned og = xb_add(&bar[XB_TOP], 1u);
            const unsigned tg = og / nx;
            if (og + 1u == (tg + 1u) * nx) xb_add(&bar[XB_TOPGEN], 1u);
            else XB_SPIN(xb_ld(&bar[XB_TOPGEN]) == tg, bar);
            __builtin_amdgcn_fence(__ATOMIC_ACQUIRE, "agent");
            xb_add(&bar[XB_XGEN(x)], 1u);
            asm volatile("s_waitcnt vmcnt(0)" ::: "memory");
        } else {
            XB_SPIN(xb_ld(&bar[XB_XGEN(x)]) == gen, bar);
            __builtin_amdgcn_fence(__ATOMIC_ACQUIRE, "agent");
            asm volatile("s_waitcnt vmcnt(0)" ::: "memory");
        }
    }
    __syncthreads();
}
#define GSYNC() xcd_barrier(get_pp()->bar, (volatile LAS unsigned*)(lds + 131072))
__device__ __forceinline__ void wave_lds_sync() { asm volatile("s_waitcnt lgkmcnt(0)" ::: "memory"); __builtin_amdgcn_wave_barrier(); }

namespace pg8 {
constexpr int BM = 256, BK = 64, HALF = 128, HTB = HALF * BK * 2, NXCD = 8, WGM = 8;
__device__ __forceinline__ int lds_byte(int r, int c) { const int st = (r >> 4) * 2 + (c >> 5), rr = r & 15, cc = c & 31, ob = rr * 64 + cc * 2; return st * 1024 + (ob ^ (((ob >> 9) & 1) << 5)); }
__device__ __forceinline__ void stage_rc(int b, int& R, int& C) { const int st = b / 1024, sb = b % 1024, swz = sb ^ (((sb >> 9) & 1) << 5); R = (st >> 1) * 16 + swz / 64; C = (st & 1) * 32 + (swz % 64) / 2; }
struct Unit { int pm, pn; };
struct Gemm { const bf16_t* A; const bf16_t* Bt; int M, N, K; };
struct StaticOrder {
    int nM, nN, nwg, G, c;
    __device__ void init(int M, int N, int G_, int c_) { nM = M / BM; nN = N / BM; nwg = nM * nN; G = G_; c = c_; }
    __device__ bool next(int i, Unit& u) const {
        const long L = (long)i * G + c; if (L >= nwg) return false;
        int wgid = (int)L; { const int q = nwg / NXCD, r = nwg % NXCD, xcd = wgid % NXCD, off = wgid / NXCD; wgid = (xcd < r ? xcd * (q + 1) : r * (q + 1) + (xcd - r) * q) + off; }
        const int nig = WGM * nN, gid = wgid / nig, fm = gid * WGM, gsz = (nM - fm) < WGM ? (nM - fm) : WGM;
        u.pm = fm + ((wgid % nig) % gsz); u.pn = (wgid % nig) / gsz; return true;
    }
};

template <class Epi, class Sched>
__device__ __forceinline__ void gemm_phase(LAS unsigned char* lds, const Gemm g, const Sched& S, const Epi& E) {
    const int tid = opaque_tid(), wid = __builtin_amdgcn_readfirstlane(tid >> 6), lane = tid & 63, wr = wid >> 2, wc = wid & 3, fr = lane & 15, fq = lane >> 4;
    const int K = g.K, nt = K / BK;
    unsigned voffA[2];
#pragma unroll
    for (int i = 0; i < 2; ++i) { int R, C; stage_rc(tid * 16 + i * 8192, R, C); voffA[i] = (unsigned)(R * K + C) * 2u; }
    const size_t kstep = (size_t)(BK * 2);
    const size_t hstep = (size_t)HALF * K * 2;
    const size_t tstep = 2 * hstep;
    const unsigned ldsw = (unsigned)wid * 1024u;
    const int aoff = lds_byte(wr * 64 + fr, fq * 8), boff = lds_byte(wc * 32 + fr, fq * 8);
#define PG8_SA(b, h) (((b) * 2 + (h)) * HTB)
#define PG8_SB(b, h) ((4 + (b) * 2 + (h)) * HTB)
#define PG8_STAGE(bufoff, gbase) do { _Pragma("unroll") for (int _i = 0; _i < 2; ++_i) \
        __builtin_amdgcn_global_load_lds((const unsigned*)((const char*)(gbase) + voffA[_i]), (LAS unsigned*)(lds + (bufoff) + ldsw + _i * 8192), 16, 0, 0); } while (0)
#define PG8_LDA(dst, b, h) do { _Pragma("unroll") for (int m = 0; m < 4; ++m) _Pragma("unroll") for (int k = 0; k < 2; ++k) dst[m][k] = *(const LAS bf16x8*)(lds + PG8_SA(b, h) + aoff + m * 2048 + k * 1024); } while (0)
#define PG8_LDB(dst, b, h) do { _Pragma("unroll") for (int n = 0; n < 2; ++n) _Pragma("unroll") for (int k = 0; k < 2; ++k) dst[n][k] = *(const LAS bf16x8*)(lds + PG8_SB(b, h) + boff + n * 2048 + k * 1024); } while (0)
#define PG8_MMA(ai, bj, At, Bt) do { __builtin_amdgcn_s_setprio(1); _Pragma("unroll") for (int m = 0; m < 4; ++m) _Pragma("unroll") for (int n = 0; n < 2; ++n) _Pragma("unroll") for (int k = 0; k < 2; ++k) \
        acc[ai][bj][m][n] = __builtin_amdgcn_mfma_f32_16x16x32_bf16(Bt[n][k], At[m][k], acc[ai][bj][m][n], 0, 0, 0); __builtin_amdgcn_s_setprio(0); } while (0)
#define PG8_WAIT_V(n) asm volatile("s_waitcnt vmcnt(" #n ")" ::: "memory")
#define PG8_WAIT_L(n) asm volatile("s_waitcnt lgkmcnt(" #n ")" ::: "memory")
#define PG8_BAR __builtin_amdgcn_s_barrier()
#define PG8_SCHED __builtin_amdgcn_sched_barrier(0)
    Unit cur, nxt; int ui = 0;
    if (!S.next(0, cur)) return;
    f32x4 acc[2][2][4][2];
#pragma unroll
    for (int a = 0; a < 2; ++a)
#pragma unroll
        for (int b = 0; b < 2; ++b)
#pragma unroll
            for (int m = 0; m < 4; ++m)
#pragma unroll
                for (int n = 0; n < 2; ++n) acc[a][b][m][n] = (f32x4){0.f, 0.f, 0.f, 0.f};
    bf16x8 At[4][2], B0[2][2], B1[2][2];
    const char* cA = (const char*)g.A + (size_t)cur.pm * tstep; const char* cB = (const char*)g.Bt + (size_t)cur.pn * tstep;
    PG8_STAGE(PG8_SB(0, 0), cB); PG8_STAGE(PG8_SA(0, 0), cA); PG8_STAGE(PG8_SB(0, 1), cB + hstep); PG8_STAGE(PG8_SA(0, 1), cA + hstep);
    if (wr == 1) PG8_BAR;
    PG8_WAIT_V(4); PG8_BAR;
    PG8_STAGE(PG8_SB(1, 0), cB + kstep); PG8_STAGE(PG8_SA(1, 0), cA + kstep); PG8_STAGE(PG8_SB(1, 1), cB + hstep + kstep);
    PG8_WAIT_V(6); PG8_BAR;
    for (;;) {
        const bool has_next = S.next(ui + 1, nxt);
        const char* nA = has_next ? (const char*)g.A + (size_t)nxt.pm * tstep : cA; const char* nB = has_next ? (const char*)g.Bt + (size_t)nxt.pn * tstep : cB;
        for (int t = 0; t < nt; t += 2) {
            const bool last = (t == nt - 2);
            const char* a1 = cA + (size_t)(t + 1) * kstep;
            const char* a2 = last ? nA : cA + (size_t)(t + 2) * kstep; const char* b2 = last ? nB : cB + (size_t)(t + 2) * kstep;
            const char* a3 = a2 + kstep; const char* b3 = b2 + kstep;
            PG8_LDB(B0, 0, 0); PG8_SCHED; PG8_LDA(At, 0, 0); PG8_STAGE(PG8_SA(1, 1), a1 + hstep);
            PG8_WAIT_L(8); PG8_BAR; PG8_WAIT_L(0); PG8_MMA(0, 0, At, B0); PG8_BAR; PG8_SCHED;
            PG8_LDB(B1, 0, 1); PG8_STAGE(PG8_SB(0, 0), b2);
            PG8_BAR; PG8_WAIT_L(0); PG8_MMA(0, 1, At, B1); PG8_BAR;
            PG8_LDA(At, 0, 1); PG8_STAGE(PG8_SA(0, 0), a2);
            PG8_BAR; PG8_WAIT_L(0); PG8_MMA(1, 0, At, B0); PG8_BAR; PG8_SCHED;
            PG8_STAGE(PG8_SB(0, 1), b2 + hstep);
            PG8_WAIT_V(6); PG8_BAR; PG8_MMA(1, 1, At, B1); PG8_BAR;
            PG8_LDB(B0, 1, 0); PG8_SCHED; PG8_LDA(At, 1, 0); PG8_STAGE(PG8_SA(0, 1), a2 + hstep);
            PG8_WAIT_L(8); PG8_BAR; PG8_WAIT_L(0); PG8_MMA(0, 0, At, B0); PG8_BAR; PG8_SCHED;
            PG8_LDB(B1, 1, 1); PG8_STAGE(PG8_SB(1, 0), b3);
            PG8_BAR; PG8_WAIT_L(0); PG8_MMA(0, 1, At, B1); PG8_BAR;
            PG8_LDA(At, 1, 1); PG8_STAGE(PG8_SA(1, 0), a3);
            PG8_BAR; PG8_WAIT_L(0); PG8_MMA(1, 0, At, B0); PG8_BAR; PG8_SCHED;
            PG8_STAGE(PG8_SB(1, 1), b3 + hstep);
            PG8_WAIT_V(6); PG8_BAR; PG8_MMA(1, 1, At, B1); PG8_BAR;
        }
        E(acc, cur, wr, wc, fr, fq);
        if (!has_next) break;
#pragma unroll
        for (int a = 0; a < 2; ++a)
#pragma unroll
            for (int b = 0; b < 2; ++b)
#pragma unroll
                for (int m = 0; m < 4; ++m)
#pragma unroll
                    for (int n = 0; n < 2; ++n) acc[a][b][m][n] = (f32x4){0.f, 0.f, 0.f, 0.f};
        cur = nxt; cA = nA; cB = nB; ++ui;
    }
    PG8_WAIT_V(0);
    if (wr == 0) PG8_BAR;
    PG8_BAR;
#undef PG8_SA
#undef PG8_SB
#undef PG8_STAGE
#undef PG8_LDA
#undef PG8_LDB
#undef PG8_MMA
#undef PG8_WAIT_V
#undef PG8_WAIT_L
#undef PG8_BAR
#undef PG8_SCHED
}
}
using pg8::Unit;
typedef f32x4 AccT[2][2][4][2];

struct EpiSwiglu {
    bf16_t* ACT; const float* rowss;
    __device__ __forceinline__ void operator()(const AccT& acc, const Unit& u, int wr, int wc, int fr, int fq) const {
        const int row0 = u.pm * 256 + wr * 64 + fr;
#pragma unroll
        for (int ai = 0; ai < 2; ++ai)
#pragma unroll
            for (int m = 0; m < 4; ++m) {
                const int r = row0 + ai * 128 + m * 16; const float rs = rowss ? rstd_of(rowss[r]) : 1.0f;
#pragma unroll
                for (int bj = 0; bj < 2; ++bj) {
                    const int col = (u.pn * 8 + bj * 4 + wc) * 16 + fq * 4;
                    float o[4];
#pragma unroll
                    for (int j = 0; j < 4; ++j) { const float a = acc[ai][bj][m][0][j] * rs, b = acc[ai][bj][m][1][j] * rs; o[j] = a * sigm(a) * b; }
                    u32x2 w; w.x = cvt_pk_bf16(o[0], o[1]); w.y = cvt_pk_bf16(o[2], o[3]);
                    *(u32x2*)(ACT + (size_t)r * DFF + col) = w;
                }
            }
    }
};
struct EpiResid {
    const float* src0; const float* src1; float* X; bf16_t* XB; float* rowss_next; float scale;
    __device__ __forceinline__ void operator()(const AccT& acc, const Unit& u, int wr, int wc, int fr, int fq) const {
        const int row0 = u.pm * 256 + wr * 64 + fr; const int col0 = u.pn * 256 + wc * 32 + fq * 4;
#pragma unroll
        for (int ai = 0; ai < 2; ++ai)
#pragma unroll
            for (int m = 0; m < 4; ++m) {
                const int r = row0 + ai * 128 + m * 16;
                const float* xs = (r < MP) ? src0 + (size_t)r * DM : src1 + (size_t)(r - MP) * DM;
                float ss = 0.f;
#pragma unroll
                for (int bj = 0; bj < 2; ++bj)
#pragma unroll
                    for (int n = 0; n < 2; ++n) {
                        const int col = col0 + bj * 128 + n * 16;
                        const f32x4 xo = *(const f32x4*)(xs + col);
                        const f32x4 v = xo + acc[ai][bj][m][n] * scale;
                        *(f32x4*)(X + (size_t)r * DM + col) = v;
                        ss += v[0] * v[0] + v[1] * v[1] + v[2] * v[2] + v[3] * v[3];
                        if (XB) { u32x2 w; w.x = cvt_pk_bf16(v[0], v[1]); w.y = cvt_pk_bf16(v[2], v[3]); *(u32x2*)(XB + (size_t)r * DM + col) = w; }
                    }
                ss += __shfl_xor(ss, 16); ss += __shfl_xor(ss, 32);
                if (fq == 0) __hip_atomic_fetch_add(rowss_next + r, ss, __ATOMIC_RELAXED, __HIP_MEMORY_SCOPE_AGENT);
            }
    }
};
struct EpiWin {
    PP P;
    __device__ __forceinline__ void operator()(const AccT& acc, const Unit& u, int wr, int wc, int fr, int fq) const {
        PP p = P; const float* rowss = p->rowss + MT;
        const int row0 = u.pm * 256 + wr * 64 + fr; const int pn = u.pn;
#pragma unroll
        for (int ai = 0; ai < 2; ++ai)
#pragma unroll
            for (int m = 0; m < 4; ++m) {
                const int r = row0 + ai * 128 + m * 16; const float rs = rstd_of(rowss[r]);
                const bool samp = r >= MP; const int rb = (r - MP) >> 3, rt = (r - MP) & 7;
                const int pos = samp ? MP + rt : r;
                const int krow = samp ? MP + rb * SBS + 128 + rt : r;
#pragma unroll
                for (int bj = 0; bj < 2; ++bj) {
                    if (pn < 2 || (pn == 2 && bj == 0)) {
                        const int grp = wc & 1, d = grp * 16 + fq * 4;
                        const f32x4 cs0 = *(const f32x4*)(p->rope + (size_t)pos * 64 + d * 2), cs1 = *(const f32x4*)(p->rope + (size_t)pos * 64 + d * 2 + 4);
                        const float cc[4] = {cs0[0], cs0[2], cs1[0], cs1[2]}, sn[4] = {cs0[1], cs0[3], cs1[1], cs1[3]};
                        float o1[4], o2[4];
#pragma unroll
                        for (int j = 0; j < 4; ++j) { const float x1 = acc[ai][bj][m][0][j] * rs, x2 = acc[ai][bj][m][1][j] * rs; o1[j] = x1 * cc[j] - x2 * sn[j]; o2[j] = x2 * cc[j] + x1 * sn[j]; }
                        if (pn < 2) {
                            const int head = pn * 4 + bj * 2 + (wc >> 1);
                            u32x2 w1, w2; w1.x = cvt_pk_bf16(o1[0] * 0.125f, o1[1] * 0.125f); w1.y = cvt_pk_bf16(o1[2] * 0.125f, o1[3] * 0.125f);
                            w2.x = cvt_pk_bf16(o2[0] * 0.125f, o2[1] * 0.125f); w2.y = cvt_pk_bf16(o2[2] * 0.125f, o2[3] * 0.125f);
                            bf16_t* qp = p->Q + (size_t)r * 512 + head * 64 + d;
                            *(u32x2*)qp = w1; *(u32x2*)(qp + 32) = w2;
                        } else {
                            const int kvh = wc >> 1;
                            u32x2 w1, w2; w1.x = cvt_pk_bf16(o1[0], o1[1]); w1.y = cvt_pk_bf16(o1[2], o1[3]); w2.x = cvt_pk_bf16(o2[0], o2[1]); w2.y = cvt_pk_bf16(o2[2], o2[3]);
                            bf16_t* kp = p->Kb + (size_t)krow * 128 + kvh * 64 + d;
                            *(u32x2*)kp = w1; *(u32x2*)(kp + 32) = w2;
                            float* op = nullptr;
                            if (samp) op = p->out + OFF_WKS + ((size_t)rb * 128 + 120 + rt) * 128 + kvh * 64 + d;
                            else if (r >= MP - 128) op = p->out + OFF_WKP + (size_t)(r - (MP - 128)) * 128 + kvh * 64 + d;
                            if (op) { *(f32x4*)op = (f32x4){o1[0], o1[1], o1[2], o1[3]}; *(f32x4*)(op + 32) = (f32x4){o2[0], o2[1], o2[2], o2[3]}; }
                        }
                    } else if (pn == 2) {
                        const int kvh = wc >> 1;
                        float* op = nullptr;
                        if (samp) op = p->out + OFF_WVS + ((size_t)rb * 128 + 120 + rt) * 128 + kvh * 64;
                        else if (r >= MP - 128) op = p->out + OFF_WVP + (size_t)(r - (MP - 128)) * 128 + kvh * 64;
#pragma unroll
                        for (int n = 0; n < 2; ++n) {
                            const int d = (wc & 1) * 32 + n * 16 + fq * 4;
                            const f32x4 v = acc[ai][bj][m][n] * rs;
#pragma unroll
                            for (int j = 0; j < 4; ++j) p->Vt[(size_t)(kvh * 64 + d + j) * KROWS + krow] = (bf16_t)(cvt_pk_bf16(v[j], 0.f) & 0xffffu);
                            if (op) *(f32x4*)(op + d) = v;
                        }
                    } else if (pn < 5) {
#pragma unroll
                        for (int n = 0; n < 2; ++n) {
                            const int col = (pn - 3) * 256 + bj * 128 + wc * 32 + n * 16 + fq * 4;
                            *(f32x4*)(p->U + (size_t)r * 512 + col) = acc[ai][bj][m][n] * rs;
                        }
                    } else {
                        const int col = (pn - 5) * 256 + bj * 128 + wc * 32 + fq * 8;
                        const f32x4 a = acc[ai][bj][m][0] * rs, b = acc[ai][bj][m][1] * rs;
                        u32x4 w; w.x = cvt_pk_bf16(sigm(a[0]), sigm(a[1])); w.y = cvt_pk_bf16(sigm(a[2]), sigm(a[3]));
                        w.z = cvt_pk_bf16(sigm(b[0]), sigm(b[1])); w.w = cvt_pk_bf16(sigm(b[2]), sigm(b[3]));
                        *(u32x4*)(p->SG + (size_t)r * 2048 + col) = w;
                    }
                }
            }
    }
};
__device__ __forceinline__ f32x4 ld_bf16x4(const bf16_t* ptr) { const u32x2 w = *(const u32x2*)ptr; f32x4 r; r[0] = __uint_as_float(w.x << 16); r[1] = __uint_as_float(w.x & 0xffff0000u); r[2] = __uint_as_float(w.y << 16); r[3] = __uint_as_float(w.y & 0xffff0000u); return r; }
struct EpiAttnUp {
    float* TMP; const bf16_t* SG;
    __device__ __forceinline__ void operator()(const AccT& acc, const Unit& u, int wr, int wc, int fr, int fq) const {
        const int row0 = u.pm * 256 + wr * 64 + fr; const int col0 = u.pn * 256 + wc * 32 + fq * 4;
#pragma unroll
        for (int ai = 0; ai < 2; ++ai)
#pragma unroll
            for (int m = 0; m < 4; ++m) {
                const int r = row0 + ai * 128 + m * 16;
#pragma unroll
                for (int bj = 0; bj < 2; ++bj)
#pragma unroll
                    for (int n = 0; n < 2; ++n) {
                        const int col = col0 + bj * 128 + n * 16;
                        const f32x4 g = ld_bf16x4(SG + (size_t)r * 2048 + col);
                        *(f32x4*)(TMP + (size_t)r * DM + col) = g * acc[ai][bj][m][n];
                    }
            }
    }
};
struct EpiSsmGlu {
    const float* TMP; const bf16_t* SG; bf16_t* MERGED;
    __device__ __forceinline__ void operator()(const AccT& acc, const Unit& u, int wr, int wc, int fr, int fq) const {
        const int row0 = u.pm * 256 + wr * 64 + fr;
#pragma unroll
        for (int ai = 0; ai < 2; ++ai)
#pragma unroll
            for (int m = 0; m < 4; ++m) {
                const int r = row0 + ai * 128 + m * 16;
#pragma unroll
                for (int bj = 0; bj < 2; ++bj) {
                    const int col = (u.pn * 8 + bj * 4 + wc) * 16 + fq * 4;
                    const f32x4 t = *(const f32x4*)(TMP + (size_t)r * DM + col);
                    const f32x4 g = ld_bf16x4(SG + (size_t)r * 2048 + 1024 + col);
                    float o[4];
#pragma unroll
                    for (int j = 0; j < 4; ++j) { const float ga = acc[ai][bj][m][0][j], gb = acc[ai][bj][m][1][j]; o[j] = t[j] + g[j] * ga * sigm(gb); }
                    u32x2 w; w.x = cvt_pk_bf16(o[0], o[1]); w.y = cvt_pk_bf16(o[2], o[3]);
                    *(u32x2*)(MERGED + (size_t)r * DM + col) = w;
                }
            }
    }
};
struct EpiXq {
    bf16_t* XQ; const float* rowss;
    __device__ __forceinline__ void operator()(const AccT& acc, const Unit& u, int wr, int wc, int fr, int fq) const {
        const int row0 = u.pm * 256 + wr * 64 + fr;
#pragma unroll
        for (int ai = 0; ai < 2; ++ai)
#pragma unroll
            for (int m = 0; m < 4; ++m) {
                const int r = row0 + ai * 128 + m * 16; const float rs = rstd_of(rowss[r]);
#pragma unroll
                for (int bj = 0; bj < 2; ++bj) {
                    const int col = u.pn * 256 + bj * 128 + wc * 32 + fq * 8;
                    const f32x4 a = acc[ai][bj][m][0] * rs, b = acc[ai][bj][m][1] * rs;
                    u32x4 w; w.x = cvt_pk_bf16(a[0], a[1]); w.y = cvt_pk_bf16(a[2], a[3]); w.z = cvt_pk_bf16(b[0], b[1]); w.w = cvt_pk_bf16(b[2], b[3]);
                    *(u32x4*)(XQ + (size_t)r * DM + col) = w;
                }
            }
    }
};
struct EpiMemKV {
    float* out; const float* rowss;
    __device__ __forceinline__ void operator()(const AccT& acc, const Unit& u, int wr, int wc, int fr, int fq) const {
        const int row0 = wr * 64 + fr; const int col0 = (u.pn & 3) * 256 + wc * 32 + fq * 4;
        float* ob = out + (u.pn < 4 ? OFF_MKP : OFF_MVP);
#pragma unroll
        for (int ai = 0; ai < 2; ++ai)
#pragma unroll
            for (int m = 0; m < 4; ++m) {
                const int r = row0 + ai * 128 + m * 16;
#pragma unroll
                for (int bj = 0; bj < 2; ++bj)
#pragma unroll
                    for (int n = 0; n < 2; ++n) *(f32x4*)(ob + (size_t)r * DM + col0 + bj * 128 + n * 16) = acc[ai][bj][m][n];
            }
    }
};
__device__ __forceinline__ void memkv_convert(PP p) {
    const int gt = blockIdx.x * 512 + opaque_tid(), ntot = gridDim.x * 512;
    for (int i = gt; i < 256 * 1024; i += ntot) p->MK[i] = (bf16_t)(cvt_pk_bf16(p->out[OFF_MKP + i], 0.f) & 0xffffu);
    for (int i = gt; i < 256 * 1024; i += ntot) {
        const int r = i & 255, col = i >> 8;
        p->MVt[i] = (bf16_t)(cvt_pk_bf16(p->out[OFF_MVP + (size_t)r * 1024 + col], 0.f) & 0xffffu);
    }
}

struct SmallEpi { const float* src; float* X; bf16_t* XB; float* rowss_next; float scale; const float* rowss; bf16_t* XQ; float* TMP; const bf16_t* SG; bf16_t* MERGED; int ntn; };
template <int EP>
__device__ __forceinline__ void small_gemm_sample(unsigned char* smem, const bf16_t* A, const bf16_t* Bt, int K, const SmallEpi E) {
    const int tid = opaque_tid(), wid = tid >> 6, lane = tid & 63, fr = lane & 15, fq = lane >> 4;
    float* part = (float*)smem;
    const int nks = K >> 8;
    const int ntn = E.ntn ? E.ntn : 16;
    for (int t = blockIdx.x; t < 16 * ntn; t += gridDim.x) {
        const int tm = t / ntn, tn = t - tm * ntn;
        const bf16_t* ap = A + (size_t)(MP + tm * 64 + fr) * K + wid * (K >> 3) + fq * 8;
        const bf16_t* bp = Bt + (size_t)(tn * 64 + fr) * K + wid * (K >> 3) + fq * 8;
        f32x4 acc[4][4];
#pragma unroll
        for (int mi = 0; mi < 4; ++mi)
#pragma unroll
            for (int ni = 0; ni < 4; ++ni) acc[mi][ni] = (f32x4){0.f, 0.f, 0.f, 0.f};
        bf16x8 Af[2][4], Bf[2][4];
#pragma unroll
        for (int i = 0; i < 4; ++i) { Af[0][i] = *(const bf16x8*)(ap + (size_t)(i * 16) * K); Bf[0][i] = *(const bf16x8*)(bp + (size_t)(i * 16) * K); }
        for (int ks = 0; ks < nks; ks += 2) {
            if (ks + 1 < nks) {
#pragma unroll
                for (int i = 0; i < 4; ++i) { Af[1][i] = *(const bf16x8*)(ap + (size_t)(i * 16) * K + (ks + 1) * 32); Bf[1][i] = *(const bf16x8*)(bp + (size_t)(i * 16) * K + (ks + 1) * 32); }
            }
#pragma unroll
            for (int mi = 0; mi < 4; ++mi)
#pragma unroll
                for (int ni = 0; ni < 4; ++ni) acc[mi][ni] = __builtin_amdgcn_mfma_f32_16x16x32_bf16(Af[0][mi], Bf[0][ni], acc[mi][ni], 0, 0, 0);
            if (ks + 1 < nks) {
                if (ks + 2 < nks) {
#pragma unroll
                    for (int i = 0; i < 4; ++i) { Af[0][i] = *(const bf16x8*)(ap + (size_t)(i * 16) * K + (ks + 2) * 32); Bf[0][i] = *(const bf16x8*)(bp + (size_t)(i * 16) * K + (ks + 2) * 32); }
                }
#pragma unroll
                for (int mi = 0; mi < 4; ++mi)
#pragma unroll
                    for (int ni = 0; ni < 4; ++ni) acc[mi][ni] = __builtin_amdgcn_mfma_f32_16x16x32_bf16(Af[1][mi], Bf[1][ni], acc[mi][ni], 0, 0, 0);
            }
        }
        __syncthreads();
#pragma unroll
        for (int mi = 0; mi < 4; ++mi)
#pragma unroll
            for (int ni = 0; ni < 4; ++ni)
#pragma unroll
                for (int j = 0; j < 4; ++j) part[wid * 4096 + (mi * 16 + fq * 4 + j) * 64 + ni * 16 + fr] = acc[mi][ni][j];
        __syncthreads();
        const int m = tid >> 3, n8 = (tid & 7) * 8;
        f32x4 s0 = (f32x4){0.f, 0.f, 0.f, 0.f}, s1 = s0;
#pragma unroll
        for (int w = 0; w < 8; ++w) { s0 += *(const f32x4*)(part + w * 4096 + m * 64 + n8); s1 += *(const f32x4*)(part + w * 4096 + m * 64 + n8 + 4); }
        const int r = MP + tm * 64 + m, c0 = tn * 64 + n8;
        if (EP == 0) {
            const float* xs = E.src + (size_t)(r - MP) * DM + c0;
            const f32x4 v0 = *(const f32x4*)xs + s0 * E.scale, v1 = *(const f32x4*)(xs + 4) + s1 * E.scale;
            *(f32x4*)(E.X + (size_t)r * DM + c0) = v0; *(f32x4*)(E.X + (size_t)r * DM + c0 + 4) = v1;
            if (E.XB) { u32x4 w; w.x = cvt_pk_bf16(v0[0], v0[1]); w.y = cvt_pk_bf16(v0[2], v0[3]); w.z = cvt_pk_bf16(v1[0], v1[1]); w.w = cvt_pk_bf16(v1[2], v1[3]); *(u32x4*)(E.XB + (size_t)r * DM + c0) = w; }
            float ss = v0[0] * v0[0] + v0[1] * v0[1] + v0[2] * v0[2] + v0[3] * v0[3] + v1[0] * v1[0] + v1[1] * v1[1] + v1[2] * v1[2] + v1[3] * v1[3];
            ss += __shfl_xor(ss, 1); ss += __shfl_xor(ss, 2); ss += __shfl_xor(ss, 4);
            if ((tid & 7) == 0) __hip_atomic_fetch_add(E.rowss_next + r, ss, __ATOMIC_RELAXED, __HIP_MEMORY_SCOPE_AGENT);
        } else if (EP == 1) {
            const float rs = rstd_of(E.rowss[r]);
#pragma unroll
            for (int e = 0; e < 8; ++e) {
                const int cp = c0 + e, sl = cp & 31, nn = sl >> 4, ii = sl & 15; const int col = (cp & ~31) + 8 * (ii >> 2) + 4 * nn + (ii & 3);
                const float v = (e < 4 ? s0[e & 3] : s1[e & 3]) * rs;
                E.XQ[(size_t)r * DM + col] = (bf16_t)(cvt_pk_bf16(v, 0.f) & 0xffffu);
            }
        } else if (EP == 2) {
            const f32x4 g0 = ld_bf16x4(E.SG + (size_t)r * 2048 + c0), g1 = ld_bf16x4(E.SG + (size_t)r * 2048 + c0 + 4);
            *(f32x4*)(E.TMP + (size_t)r * DM + c0) = g0 * s0; *(f32x4*)(E.TMP + (size_t)r * DM + c0 + 4) = g1 * s1;
        } else {
            f32x4 b0, b1;
#pragma unroll
            for (int e = 0; e < 4; ++e) { b0[e] = __shfl_down(s0[e], 2); b1[e] = __shfl_down(s1[e], 2); }
            if ((c0 & 16) == 0) {
                const int o = (c0 >> 5) * 16 + (c0 & 15);
                const f32x4 t0 = *(const f32x4*)(E.TMP + (size_t)r * DM + o), t1 = *(const f32x4*)(E.TMP + (size_t)r * DM + o + 4);
                const f32x4 g0 = ld_bf16x4(E.SG + (size_t)r * 2048 + 1024 + o), g1 = ld_bf16x4(E.SG + (size_t)r * 2048 + 1024 + o + 4);
                float m[8];
#pragma unroll
                for (int e = 0; e < 4; ++e) { m[e] = t0[e] + g0[e] * s0[e] * sigm(b0[e]); m[4 + e] = t1[e] + g1[e] * s1[e] * sigm(b1[e]); }
                u32x4 w; w.x = cvt_pk_bf16(m[0], m[1]); w.y = cvt_pk_bf16(m[2], m[3]); w.z = cvt_pk_bf16(m[4], m[5]); w.w = cvt_pk_bf16(m[6], m[7]);
                *(u32x4*)(E.MERGED + (size_t)r * DM + o) = w;
            }
        }
    }
    __syncthreads();
}

__device__ __forceinline__ int src_col(int mode, int H, int np) {
    if (mode == 3) { if (np < 640) { const int pp = np & 63, grp = pp >> 5, s = pp & 31, n = s >> 4, i = s & 15; return (np & ~63) + grp * 16 + i + n * 32; }
                     if (np < 1280) return np; mode = 1; }
    if (mode == 0) return np;
    const int s = np & 31, n = s >> 4, i = s & 15;
    if (mode == 1) return (np & ~31) + 8 * (i >> 2) + 4 * n + (i & 3);
    return n * H + (np >> 5) * 16 + i;
}
__device__ __forceinline__ void sincos_d(double ang, double& s, double& c) {
    const double x = ang * 0.63661977236758134308;
    const double q = rint(x); const double r = (ang - q * 1.57079632679489655800) - q * 6.12323399573676603587e-17;
    const double r2 = r * r;
    double sp = -7.6471637318198164759e-13; sp = sp * r2 + 1.6059043836821614599e-10; sp = sp * r2 - 2.5052108385441718775e-08; sp = sp * r2 + 2.7557319223985890653e-06;
    sp = sp * r2 - 1.9841269841269841270e-04; sp = sp * r2 + 8.3333333333333332177e-03; sp = sp * r2 - 1.6666666666666665741e-01; sp = r + r * r2 * sp;
    double cp = 4.7794773323873852974e-14; cp = cp * r2 - 1.1470745597729724714e-11; cp = cp * r2 + 2.0876756987868098979e-09; cp = cp * r2 - 2.7557319223985888e-07;
    cp = cp * r2 + 2.4801587301587301566e-05; cp = cp * r2 - 1.3888888888888889419e-03; cp = cp * r2 + 4.1666666666666664354e-02; cp = cp * r2 - 0.5; cp = 1.0 + r2 * cp;
    const int qi = ((int)(long long)q) & 3;
    s = (qi == 0) ? sp : (qi == 1) ? cp : (qi == 2) ? -sp : -cp;
    c = (qi == 0) ? cp : (qi == 1) ? -sp : (qi == 2) ? -cp : sp;
}

__device__ __forceinline__ void conv_weight(const float* src, const float* g, bf16_t* dst, int K, int ld, int Np, int mode, int H, float scale, int tile0, int wv, int nwv, int lane) {
    const int nkt = K >> 6, ntile = (Np >> 8) * nkt;
    for (int t = wv - tile0; t < ntile; t += nwv) {
        if (t < 0) continue;
        const int tn = t / nkt, tk = t - tn * nkt; const int n0 = tn * 256 + lane * 4, k0 = tk * 64;
        const float* sp = src + (size_t)k0 * ld + src_col(mode, H, n0);
        bf16_t* dp = dst + (size_t)n0 * K + k0;
#pragma unroll 1
        for (int ss = 0; ss < 4; ++ss) {
            f32x4 v[16];
#pragma unroll
            for (int e = 0; e < 16; ++e) { const float gv = g ? g[k0 + ss * 16 + e] * scale : scale; v[e] = *(const f32x4*)(sp + (size_t)(ss * 16 + e) * ld) * gv; }
#pragma unroll
            for (int q = 0; q < 4; ++q) {
                u32x4 w0, w1;
                w0.x = cvt_pk_bf16(v[0][q], v[1][q]); w0.y = cvt_pk_bf16(v[2][q], v[3][q]); w0.z = cvt_pk_bf16(v[4][q], v[5][q]); w0.w = cvt_pk_bf16(v[6][q], v[7][q]);
                w1.x = cvt_pk_bf16(v[8][q], v[9][q]); w1.y = cvt_pk_bf16(v[10][q], v[11][q]); w1.z = cvt_pk_bf16(v[12][q], v[13][q]); w1.w = cvt_pk_bf16(v[14][q], v[15][q]);
                *(u32x4*)(dp + (size_t)q * K + ss * 16) = w0; *(u32x4*)(dp + (size_t)q * K + ss * 16 + 8) = w1;
            }
        }
    }
}
__device__ __forceinline__ void conv_weight_set(PP p, int set, int wv, int nwv, int lane) {
    if (set == 0) {
        conv_weight(p->w_ffn1_in, p->g_ffn1, p->Wt1, 1024, 5632, 5632, 2, 2816, 1.f, 0, wv, nwv, lane);
        conv_weight(p->w_xk, p->g_mem, p->Wtkv, 1024, 1024, 1024, 0, 0, 1.f, 352 % nwv, wv, nwv, lane);
        conv_weight(p->w_xv, p->g_mem, p->Wtkv + 1024 * 1024, 1024, 1024, 1024, 0, 0, 1.f, 416 % nwv, wv, nwv, lane);
        conv_weight(p->w_ffn1_out, nullptr, p->Wt2, 2816, 1024, 1024, 0, 0, 1.f, 480 % nwv, wv, nwv, lane);
        conv_weight(p->w_in, p->g_mix, p->Wt3, 1024, 3328, 3328, 3, 0, 1.f, 656 % nwv, wv, nwv, lane);
    } else if (set == 1) {
        (void)wv; (void)nwv;
    } else {
        conv_weight(p->w_attn_up, nullptr, p->Wt4, 512, 1024, 1024, 0, 0, 1.f, 0, wv, nwv, lane);
        conv_weight(p->w_ssm_glu, nullptr, p->Wt5, 512, 2048, 2048, 2, 1024, 1.f, 32 % nwv, wv, nwv, lane);
        conv_weight(p->w_out, nullptr, p->Wt6, 1024, 1024, 1024, 0, 0, 1.f, 96 % nwv, wv, nwv, lane);
        conv_weight(p->w_xq, p->g_xattn, p->Wt7, 1024, 1024, 1024, 1, 0, 0.0625f, 160 % nwv, wv, nwv, lane);
        conv_weight(p->w_xo, nullptr, p->Wt8, 1024, 1024, 1024, 0, 0, 1.f, 224 % nwv, wv, nwv, lane);
        conv_weight(p->w_ffn2_in, p->g_ffn2, p->Wt9, 1024, 5632, 5632, 2, 2816, 1.f, 288 % nwv, wv, nwv, lane);
        conv_weight(p->w_ffn2_out, nullptr, p->Wt10, 2816, 1024, 1024, 0, 0, 1.f, 640 % nwv, wv, nwv, lane);
    }
}
__device__ __forceinline__ void prep_rope(PP p, int wg, int nwg) {
    const int gt = wg * 512 + opaque_tid(), ntot = nwg * 512;
    for (int i = gt; i < 16392 * 32; i += ntot) {
        const int pos = i >> 5, d = i & 31;
        const double inv = exp(-(double)d * (9.21034037197618273607 / 32.0));
        double s, c; sincos_d((double)pos * inv, s, c);
        p->rope[(size_t)i * 2] = (float)c; p->rope[(size_t)i * 2 + 1] = (float)s;
    }
}
__device__ __forceinline__ void prep_tables(PP p, int wg, int nwg) {
    const int tid = opaque_tid(), wid = tid >> 6, lane = tid & 63;
    const int gw = wg * 8 + wid, nw = nwg * 8;
    const int gt = wg * 512 + tid, ntot = nwg * 512;
    for (int gn = gt; gn < 2048; gn += ntot) {
        const int g = gn >> 6;
        const double are = p->a_re[gn], aim = p->a_im[gn], dt = exp((double)p->log_dt[g]);
        double s, c; sincos_d(aim * dt, s, c); const double mag = exp(are * dt);
        const double lbr = mag * c, lbi = mag * s;
        double s64, c64; sincos_d(aim * dt * 64.0, s64, c64); const double mag64 = exp(are * dt * 64.0);
        const double den = are * are + aim * aim, nr = lbr - 1.0, ni = lbi;
        const double kre = (nr * are + ni * aim) / den, kim = (ni * are - nr * aim) / den;
        float* tb = p->ssmtab;
        tb[gn * 2] = (float)lbr; tb[gn * 2 + 1] = (float)lbi;
        tb[4096 + gn * 2] = (float)(mag64 * c64); tb[4096 + gn * 2 + 1] = (float)(mag64 * s64);
#pragma unroll
        for (int ch = 0; ch < 16; ++ch) {
            const double br = p->b_re[gn * 16 + ch], bi = p->b_im[gn * 16 + ch];
            tb[8192 + gn * 32 + ch] = (float)(kre * br - kim * bi);
            tb[8192 + gn * 32 + 16 + ch] = (float)(kre * bi + kim * br);
        }
    }
}
__device__ __forceinline__ void prep_ctx(PP p, int wg, int nwg) {
    const int tid = opaque_tid(), wid = tid >> 6, lane = tid & 63;
    const int gw = wg * 8 + wid, nw = nwg * 8;
    const int gt = wg * 512 + tid, ntot = nwg * 512;
    for (int i4 = gt; i4 < 128 * 128 * 32; i4 += ntot) {
        const int i = i4 * 4; const int cidx = i & 127, w = (i >> 7) & 127, b = i >> 14;
        const f32x4 kv = *(const f32x4*)(p->cache_win_k + i), vv = *(const f32x4*)(p->cache_win_v + i);
        u32x2 kw; kw.x = cvt_pk_bf16(kv[0], kv[1]); kw.y = cvt_pk_bf16(kv[2], kv[3]);
        *(u32x2*)(p->Kb + (size_t)(MP + b * SBS + w) * 128 + cidx) = kw;
        if (w >= 8) { *(f32x4*)(p->out + OFF_WKS + ((size_t)b * 128 + (w - 8)) * 128 + cidx) = kv; *(f32x4*)(p->out + OFF_WVS + ((size_t)b * 128 + (w - 8)) * 128 + cidx) = vv; }
    }
    for (int it = gw; it < 128 * 2 * 16; it += nw) {
        const int cg8 = it & 15, half = (it >> 4) & 1, b = it >> 5; const int w = half * 64 + lane;
        const float* vp = p->cache_win_v + ((size_t)b * 128 + w) * 128 + cg8 * 8;
        const f32x4 v0 = *(const f32x4*)vp, v1 = *(const f32x4*)(vp + 4);
        bf16_t* dp = p->Vt + (size_t)(cg8 * 8) * KROWS + MP + b * SBS + w;
#pragma unroll
        for (int e = 0; e < 4; ++e) { dp[(size_t)e * KROWS] = (bf16_t)(cvt_pk_bf16(v0[e], 0.f) & 0xffffu); dp[(size_t)(e + 4) * KROWS] = (bf16_t)(cvt_pk_bf16(v1[e], 0.f) & 0xffffu); }
    }
}
__device__ __forceinline__ void phase_prep(PP p, unsigned char* smem) {
    const int tid = opaque_tid(), wid = tid >> 6, lane = tid & 63;
    const int gw = blockIdx.x * 8 + wid, nw = gridDim.x * 8;
    const int gt = blockIdx.x * 512 + tid, ntot = gridDim.x * 512;
    conv_weight_set(p, 0, gw, nw, lane);
    for (int r0 = gw; r0 < MT + 256; r0 += 2 * nw) {
        f32x4 v[2][4]; float ss[2];
#pragma unroll
        for (int q = 0; q < 2; ++q) {
            int r = r0 + q * nw; r = r < MT + 256 ? r : r0;
            const float* xs = (r < MP) ? p->x_prompt + (size_t)r * DM : (r < MT) ? p->x_sample + (size_t)(r - MP) * DM : p->mem_prompt + (size_t)(r - MT) * DM;
            ss[q] = 0.f;
#pragma unroll
            for (int i = 0; i < 4; ++i) { v[q][i] = *(const f32x4*)(xs + i * 256 + lane * 4); ss[q] += v[q][i][0] * v[q][i][0] + v[q][i][1] * v[q][i][1] + v[q][i][2] * v[q][i][2] + v[q][i][3] * v[q][i][3]; }
        }
#pragma unroll
        for (int o = 1; o < 64; o <<= 1) { ss[0] += __shfl_xor(ss[0], o); ss[1] += __shfl_xor(ss[1], o); }
#pragma unroll
        for (int q = 0; q < 2; ++q) {
            const int r = r0 + q * nw; if (r >= MT + 256) continue;
            bf16_t* xb = (r < MT) ? p->XB + (size_t)r * DM : p->MEMB + (size_t)(r - MT) * DM;
            const float rs = rstd_of(ss[q]);
#pragma unroll
            for (int i = 0; i < 4; ++i) { u32x2 w; w.x = cvt_pk_bf16(v[q][i][0] * rs, v[q][i][1] * rs); w.y = cvt_pk_bf16(v[q][i][2] * rs, v[q][i][3] * rs); *(u32x2*)(xb + i * 256 + lane * 4) = w; }
        }
    }
    for (int i = gt; i < 4 * MT; i += ntot) p->rowss[MT + i] = 0.f;
    prep_rope(p, blockIdx.x, gridDim.x);
}

__device__ __forceinline__ bf16x8 mk_bf16x8(u32x2 lo, u32x2 hi) { u32x4 w; w.x = lo.x; w.y = lo.y; w.z = hi.x; w.w = hi.y; return __builtin_bit_cast(bf16x8, w); }

__device__ __forceinline__ void swa_item(PP p, int item, int lane) {
    const int fr = lane & 15, fq = lane >> 4;
    int head, kvh, tq, qrow, krow_base, row_hi;
    if (item < 8192) { head = item & 7; const int p0 = (item >> 3) * 16; kvh = head >> 2; tq = fr; qrow = p0 + fr; krow_base = p0 - 128; row_hi = MP + 127; }
    else { const int it = item - 8192; const int b = it >> 2; kvh = (it >> 1) & 1; head = kvh * 4 + (it & 1) * 2 + (fr >> 3); tq = fr & 7; qrow = MP + b * 8 + tq; krow_base = MP + b * SBS; row_hi = krow_base + 135; }
    const float sink = p->sinks[head];
    const bf16_t* Kb = p->Kb + kvh * 64 + fq * 8;
    const bf16_t* Vt = p->Vt + (size_t)(kvh * 64 + fr) * KROWS;
    bf16x8 Qf[2];
#pragma unroll
    for (int ks = 0; ks < 2; ++ks) Qf[ks] = *(const bf16x8*)(p->Q + (size_t)qrow * 512 + head * 64 + ks * 32 + fq * 8);
    float mrun = sink, lrun = (fq == 0) ? 1.f : 0.f;
    f32x4 Oa[4];
#pragma unroll
    for (int db = 0; db < 4; ++db) Oa[db] = (f32x4){0.f, 0.f, 0.f, 0.f};
    const int koff = (fr >> 2) * 8 + (fr & 3);
    const int cstart = krow_base < 0 ? ((-krow_base) >> 5) : 0;
    bf16x8 Kf[2][2], Vf[4];
    auto load_chunk = [&](int cc) {
        const int rbase = krow_base + cc * 32;
#pragma unroll
        for (int kb = 0; kb < 2; ++kb) {
            int kr = rbase + koff + kb * 4; kr = kr < 0 ? 0 : (kr > row_hi ? row_hi : kr);
            const bf16_t* kp = Kb + (size_t)kr * 128;
            Kf[kb][0] = *(const bf16x8*)kp; Kf[kb][1] = *(const bf16x8*)(kp + 32);
        }
        int vt = rbase + fq * 8; vt = vt < 0 ? 0 : (vt > row_hi - 7 ? row_hi - 7 : vt);
#pragma unroll
        for (int db = 0; db < 4; ++db) Vf[db] = *(const bf16x8*)(Vt + (size_t)db * 16 * KROWS + vt);
    };
    load_chunk(cstart);
    for (int cc = cstart; cc < 5; ++cc) {
        const int c0 = cc * 32;
        f32x4 S[2];
#pragma unroll
        for (int kb = 0; kb < 2; ++kb) {
            S[kb] = __builtin_amdgcn_mfma_f32_16x16x32_bf16(Kf[kb][0], Qf[0], (f32x4){0.f, 0.f, 0.f, 0.f}, 0, 0, 0);
            S[kb] = __builtin_amdgcn_mfma_f32_16x16x32_bf16(Kf[kb][1], Qf[1], S[kb], 0, 0, 0);
        }
        bf16x8 Vc[4];
#pragma unroll
        for (int db = 0; db < 4; ++db) Vc[db] = Vf[db];
        if (cc + 1 < 5) load_chunk(cc + 1);
        bool valid[2][4]; float mx = -1e30f;
#pragma unroll
        for (int kb = 0; kb < 2; ++kb)
#pragma unroll
            for (int j = 0; j < 4; ++j) { const int c = c0 + fq * 8 + kb * 4 + j; valid[kb][j] = (c >= tq) && (c <= 128 + tq) && (krow_base + c >= 0); if (valid[kb][j]) mx = fmaxf(mx, S[kb][j]); }
        mx = fmaxf(mx, __shfl_xor(mx, 16)); mx = fmaxf(mx, __shfl_xor(mx, 32));
        const float mnew = fmaxf(mrun, mx); const float alpha = __expf(mrun - mnew); mrun = mnew;
        float ps = 0.f; float pv[2][4];
#pragma unroll
        for (int kb = 0; kb < 2; ++kb)
#pragma unroll
            for (int j = 0; j < 4; ++j) { pv[kb][j] = valid[kb][j] ? __expf(S[kb][j] - mnew) : 0.f; ps += pv[kb][j]; }
        lrun = lrun * alpha + ps;
        u32x4 pw; pw.x = cvt_pk_bf16(pv[0][0], pv[0][1]); pw.y = cvt_pk_bf16(pv[0][2], pv[0][3]); pw.z = cvt_pk_bf16(pv[1][0], pv[1][1]); pw.w = cvt_pk_bf16(pv[1][2], pv[1][3]);
        const bf16x8 Pf = __builtin_bit_cast(bf16x8, pw);
#pragma unroll
        for (int db = 0; db < 4; ++db) {
            Oa[db] = Oa[db] * alpha;
            Oa[db] = __builtin_amdgcn_mfma_f32_16x16x32_bf16(Vc[db], Pf, Oa[db], 0, 0, 0);
        }
    }
    lrun += __shfl_xor(lrun, 16); lrun += __shfl_xor(lrun, 32);
    const float inv = 1.0f / lrun;
#pragma unroll
    for (int db = 0; db < 4; ++db) {
        u32x2 w; w.x = cvt_pk_bf16(Oa[db][0] * inv, Oa[db][1] * inv); w.y = cvt_pk_bf16(Oa[db][2] * inv, Oa[db][3] * inv);
        *(u32x2*)(p->O + (size_t)qrow * 512 + head * 64 + db * 16 + fq * 4) = w;
    }
}

__device__ __forceinline__ void swa_lds_core(const bf16_t* LK, const bf16_t* LV, const bf16x8 Qf0, const bf16x8 Qf1, float sink, int tq, int lbase, int cmin, int krmax, int vtmax, int cstart,
                                             f32x4 (&Oa)[4], float& inv, int fr, int fq) {
    const int koff = (fr >> 2) * 8 + (fr & 3);
    float mrun = sink, lrun = (fq == 0) ? 1.f : 0.f;
#pragma unroll
    for (int db = 0; db < 4; ++db) Oa[db] = (f32x4){0.f, 0.f, 0.f, 0.f};
    for (int cc = cstart; cc < 5; ++cc) {
        const int c0 = cc * 32, rbase = lbase + c0;
        f32x4 S[2];
#pragma unroll
        for (int kb = 0; kb < 2; ++kb) {
            int kr = rbase + koff + kb * 4; kr = kr > krmax ? krmax : kr;
            const bf16_t* kp = LK + kr * 72 + fq * 8;
            S[kb] = __builtin_amdgcn_mfma_f32_16x16x32_bf16(*(const bf16x8*)kp, Qf0, (f32x4){0.f, 0.f, 0.f, 0.f}, 0, 0, 0);
            S[kb] = __builtin_amdgcn_mfma_f32_16x16x32_bf16(*(const bf16x8*)(kp + 32), Qf1, S[kb], 0, 0, 0);
        }
        bool valid[2][4]; float mx = -1e30f;
#pragma unroll
        for (int kb = 0; kb < 2; ++kb)
#pragma unroll
            for (int j = 0; j < 4; ++j) { const int c = c0 + fq * 8 + kb * 4 + j; valid[kb][j] = (c >= tq) && (c <= 128 + tq) && (c >= cmin); if (valid[kb][j]) mx = fmaxf(mx, S[kb][j]); }
        mx = fmaxf(mx, __shfl_xor(mx, 16)); mx = fmaxf(mx, __shfl_xor(mx, 32));
        const float mnew = fmaxf(mrun, mx); const float alpha = __expf(mrun - mnew); mrun = mnew;
        float ps = 0.f; float pv[2][4];
#pragma unroll
        for (int kb = 0; kb < 2; ++kb)
#pragma unroll
            for (int j = 0; j < 4; ++j) { pv[kb][j] = valid[kb][j] ? __expf(S[kb][j] - mnew) : 0.f; ps += pv[kb][j]; }
        lrun = lrun * alpha + ps;
        u32x4 pw; pw.x = cvt_pk_bf16(pv[0][0], pv[0][1]); pw.y = cvt_pk_bf16(pv[0][2], pv[0][3]); pw.z = cvt_pk_bf16(pv[1][0], pv[1][1]); pw.w = cvt_pk_bf16(pv[1][2], pv[1][3]);
        const bf16x8 Pf = __builtin_bit_cast(bf16x8, pw);
        int vt = rbase + fq * 8; vt = vt > vtmax ? vtmax : vt;
#pragma unroll
        for (int db = 0; db < 4; ++db) {
            Oa[db] = Oa[db] * alpha;
            Oa[db] = __builtin_amdgcn_mfma_f32_16x16x32_bf16(*(const bf16x8*)(LV + (db * 16 + fr) * 264 + vt), Pf, Oa[db], 0, 0, 0);
        }
    }
    lrun += __shfl_xor(lrun, 16); lrun += __shfl_xor(lrun, 32);
    inv = 1.0f / lrun;
}
__device__ __forceinline__ void swa_prompt_block(PP p, unsigned char* smem, int item) {
    const int tid = opaque_tid(), wid = tid >> 6, lane = tid & 63, fr = lane & 15, fq = lane >> 4;
    const int kvh = item & 1, tile = item >> 1;
    const int key0 = tile * 128 - 128;
    bf16_t* LK = (bf16_t*)smem; bf16_t* LV = (bf16_t*)(smem + 256 * 144);
    __syncthreads();
#pragma unroll
    for (int j = 0; j < 4; ++j) {
        const int pi = tid + 512 * j;
        { const int row = pi >> 3, cp = pi & 7; int gr = key0 + row; gr = gr < 0 ? 0 : gr;
          *(u32x4*)(LK + row * 72 + cp * 8) = *(const u32x4*)(p->Kb + (size_t)gr * 128 + kvh * 64 + cp * 8); }
        { const int d = pi >> 5, cp = pi & 31; int gk = key0 + cp * 8; gk = gk < 0 ? 0 : gk;
          *(u32x4*)(LV + d * 264 + cp * 8) = *(const u32x4*)(p->Vt + (size_t)(kvh * 64 + d) * KROWS + gk); }
    }
    __syncthreads();
    const int p0 = tile * 128 + wid * 16, lbase = wid * 16;
    const int cstart = (tile == 0) ? ((128 - lbase) >> 5) : 0;
    const int cmin = (key0 + lbase) < 0 ? -(key0 + lbase) : 0;
#pragma unroll 1
    for (int hh = 0; hh < 4; ++hh) {
        const int head = kvh * 4 + hh;
        const bf16_t* qp = p->Q + (size_t)(p0 + fr) * 512 + head * 64 + fq * 8;
        f32x4 Oa[4]; float inv;
        swa_lds_core(LK, LV, *(const bf16x8*)qp, *(const bf16x8*)(qp + 32), p->sinks[head], fr, lbase, cmin, 255, 248, cstart, Oa, inv, fr, fq);
#pragma unroll
        for (int db = 0; db < 4; ++db) {
            u32x2 w; w.x = cvt_pk_bf16(Oa[db][0] * inv, Oa[db][1] * inv); w.y = cvt_pk_bf16(Oa[db][2] * inv, Oa[db][3] * inv);
            *(u32x2*)(p->O + (size_t)(p0 + fr) * 512 + head * 64 + db * 16 + fq * 4) = w;
        }
    }
}
__device__ __forceinline__ void swa_sample_block(PP p, unsigned char* smem, int item) {
    const int tid = opaque_tid(), wid = tid >> 6, lane = tid & 63, fr = lane & 15, fq = lane >> 4;
    const int kvh = item & 1, b = item >> 1;
    const int row0 = MP + b * SBS;
    bf16_t* LK = (bf16_t*)smem; bf16_t* LV = (bf16_t*)(smem + 256 * 144);
    __syncthreads();
    for (int pi = tid; pi < 1088; pi += 512) {
        { const int row = pi >> 3, cp = pi & 7;
          *(u32x4*)(LK + row * 72 + cp * 8) = *(const u32x4*)(p->Kb + (size_t)(row0 + row) * 128 + kvh * 64 + cp * 8); }
        { const int d = pi / 17, cp = pi - d * 17;
          *(u32x4*)(LV + d * 264 + cp * 8) = *(const u32x4*)(p->Vt + (size_t)(kvh * 64 + d) * KROWS + row0 + cp * 8); }
    }
    __syncthreads();
    if (wid < 2) {
        const int head = kvh * 4 + wid * 2 + (fr >> 3), tq = fr & 7, qrow = MP + b * 8 + tq;
        const bf16_t* qp = p->Q + (size_t)qrow * 512 + head * 64 + fq * 8;
        f32x4 Oa[4]; float inv;
        swa_lds_core(LK, LV, *(const bf16x8*)qp, *(const bf16x8*)(qp + 32), p->sinks[head], tq, 0, 0, 135, 128, 0, Oa, inv, fr, fq);
#pragma unroll
        for (int db = 0; db < 4; ++db) {
            u32x2 w; w.x = cvt_pk_bf16(Oa[db][0] * inv, Oa[db][1] * inv); w.y = cvt_pk_bf16(Oa[db][2] * inv, Oa[db][3] * inv);
            *(u32x2*)(p->O + (size_t)qrow * 512 + head * 64 + db * 16 + fq * 4) = w;
        }
    }
}

__device__ __forceinline__ void ssm_stage_u(const float* U, int row0, int g, int ntok, float* us, int lane) {
    if (lane < ntok) {
        const float* gp = U + (size_t)(row0 + lane) * 512 + g * 16;
        const f32x4 v0 = *(const f32x4*)gp, v1 = *(const f32x4*)(gp + 4), v2 = *(const f32x4*)(gp + 8), v3 = *(const f32x4*)(gp + 12);
        float* up = us + lane * 16;
        *(f32x4*)up = v0; *(f32x4*)(up + 4) = v1; *(f32x4*)(up + 8) = v2; *(f32x4*)(up + 12) = v3;
    }
    wave_lds_sync();
}
__device__ __forceinline__ void ssm_pass1(PP p, unsigned char* smem) {
    const int tid = opaque_tid(), wid = tid >> 6, lane = tid & 63;
    float* hb = (float*)(smem + wid * 12800);
    float* us = (float*)(smem + wid * 12800 + 8704);
    const int tsub = lane >> 4, ch = lane & 15;
    for (int item = blockIdx.x * 8 + wid; item < 8192; item += gridDim.x * 8) {
        const int c = item >> 5, g = item & 31, gn = g * 64 + lane;
        ssm_stage_u(p->U, c * 64, g, 64, us, lane);
        f32x4 bX[8];
#pragma unroll
        for (int cb = 0; cb < 8; ++cb) bX[cb] = *(const f32x4*)(p->ssmtab + 8192 + (size_t)(g * 64 + cb * 8 + (ch >> 1)) * 32 + (ch & 1) * 16 + tsub * 4);
        const float lbr = p->ssmtab[gn * 2], lbi = p->ssmtab[gn * 2 + 1];
        float hr = 0.f, hi = 0.f;
        for (int t0 = 0; t0 < 64; t0 += 16) {
            const f32x4 uA = *(const f32x4*)(us + (t0 + ch) * 16 + tsub * 4);
#pragma unroll
            for (int cb = 0; cb < 8; ++cb) {
                f32x4 xv = (f32x4){0.f, 0.f, 0.f, 0.f};
#pragma unroll
                for (int q = 0; q < 4; ++q) xv = __builtin_amdgcn_mfma_f32_16x16x4f32(uA[q], bX[cb][q], xv, 0, 0, 0);
#pragma unroll
                for (int j = 0; j < 4; ++j) hb[(tsub * 4 + j) * 132 + cb * 16 + ch] = xv[j];
            }
            wave_lds_sync();
            f32x2 xq[16];
#pragma unroll
            for (int t = 0; t < 16; ++t) xq[t] = *(const f32x2*)(hb + t * 132 + lane * 2);
#pragma unroll
            for (int t = 0; t < 16; ++t) { const float nr = lbr * hr - lbi * hi + xq[t][0], ni = lbr * hi + lbi * hr + xq[t][1]; hr = nr; hi = ni; }
            wave_lds_sync();
        }
        p->Schunk[((size_t)c * 2048 + gn) * 2] = hr; p->Schunk[((size_t)c * 2048 + gn) * 2 + 1] = hi;
    }
}
__device__ __forceinline__ void ssm_pass2(PP p) {
    const int gn = blockIdx.x * 512 + opaque_tid();
    if (gn >= 2048) return;
    const float lr = p->ssmtab[4096 + gn * 2], li = p->ssmtab[4096 + gn * 2 + 1];
    float hr = 0.f, hi = 0.f;
#pragma unroll 8
    for (int c = 0; c < 256; ++c) {
        p->Carry[((size_t)c * 2048 + gn) * 2] = hr; p->Carry[((size_t)c * 2048 + gn) * 2 + 1] = hi;
        const float sr = p->Schunk[((size_t)c * 2048 + gn) * 2], si = p->Schunk[((size_t)c * 2048 + gn) * 2 + 1];
        const float nr = lr * hr - li * hi + sr, ni = lr * hi + li * hr + si; hr = nr; hi = ni;
    }
    p->out[OFF_SRP + gn] = hr; p->out[OFF_SIP + gn] = hi;
}
__device__ __forceinline__ void ssm_pass3(PP p, unsigned char* smem, int wg, int nwg) {
    const int tid = opaque_tid(), wid = tid >> 6, lane = tid & 63;
    float* hb = (float*)(smem + wid * 12800);
    float* us = (float*)(smem + wid * 12800 + 8704);
    const int tsub = lane >> 4, ch = lane & 15;
    float cHr = 0.f, cHi = 0.f; int cj = 0, cg = -1;
    f32x4 bX[8]; float cB[32]; float lbr = 0.f, lbi = 0.f, lr = 0.f, li = 0.f, dsk = 0.f; int cgc = -1;
    for (int item = wg * 8 + wid; item < 8192 + 4096; item += nwg * 8) {
        int g, row0, ntok, sb = 0, c = 0; float hr, hi;
        if (item < 8192) { c = item >> 5; g = item & 31; row0 = c * 64; ntok = 64; }
        else { const int it = item - 8192; sb = it >> 5; g = it & 31; row0 = MP + sb * 8; ntok = 8; }
        const int gn = g * 64 + lane;
        f32x4 su0, su1, su2, su3;
        if (lane < ntok) { const float* gp = p->U + (size_t)(row0 + lane) * 512 + g * 16; su0 = *(const f32x4*)gp; su1 = *(const f32x4*)(gp + 4); su2 = *(const f32x4*)(gp + 8); su3 = *(const f32x4*)(gp + 12); }
        if (g != cgc) {
            cgc = g;
#pragma unroll
            for (int cb = 0; cb < 8; ++cb) bX[cb] = *(const f32x4*)(p->ssmtab + 8192 + (size_t)(g * 64 + cb * 8 + (ch >> 1)) * 32 + (ch & 1) * 16 + tsub * 4);
            lbr = p->ssmtab[gn * 2]; lbi = p->ssmtab[gn * 2 + 1]; lr = p->ssmtab[4096 + gn * 2]; li = p->ssmtab[4096 + gn * 2 + 1];
#pragma unroll
            for (int i = 0; i < 4; ++i) { const f32x4 a = *(const f32x4*)(p->c_re + (size_t)(g * 16 + ch) * 64 + tsub * 16 + i * 4), b = *(const f32x4*)(p->c_im + (size_t)(g * 16 + ch) * 64 + tsub * 16 + i * 4);
#pragma unroll
                for (int j = 0; j < 4; ++j) { cB[(i * 4 + j) * 2] = a[j]; cB[(i * 4 + j) * 2 + 1] = -b[j]; } }
            dsk = p->ssm_d[g * 16 + ch];
        }
        if (item < 8192) {
            const float* sp = p->Schunk + (size_t)gn * 2;
            if (g != cg || cj > c) { cHr = 0.f; cHi = 0.f; cj = 0; cg = g; }
            int j = cj;
            for (; j + 32 <= c; j += 32) {
                f32x2 sv[32];
#pragma unroll
                for (int e = 0; e < 32; ++e) sv[e] = *(const f32x2*)(sp + (size_t)(j + e) * 4096);
                __builtin_amdgcn_sched_barrier(0);
#pragma unroll
                for (int e = 0; e < 32; ++e) { const float nr = lr * cHr - li * cHi + sv[e][0], ni = lr * cHi + li * cHr + sv[e][1]; cHr = nr; cHi = ni; }
            }
            for (; j + 8 <= c; j += 8) {
                f32x2 sv[8];
#pragma unroll
                for (int e = 0; e < 8; ++e) sv[e] = *(const f32x2*)(sp + (size_t)(j + e) * 4096);
#pragma unroll
                for (int e = 0; e < 8; ++e) { const float nr = lr * cHr - li * cHi + sv[e][0], ni = lr * cHi + li * cHr + sv[e][1]; cHr = nr; cHi = ni; }
            }
            for (; j < c; ++j) { const float sr = sp[(size_t)j * 4096], si = sp[(size_t)j * 4096 + 1]; const float nr = lr * cHr - li * cHi + sr, ni = lr * cHi + li * cHr + si; cHr = nr; cHi = ni; }
            cj = c; hr = cHr; hi = cHi;
        } else { hr = p->state_re[(size_t)sb * 2048 + gn]; hi = p->state_im[(size_t)sb * 2048 + gn]; }
        if (lane < ntok) { float* up = us + lane * 16; *(f32x4*)up = su0; *(f32x4*)(up + 4) = su1; *(f32x4*)(up + 8) = su2; *(f32x4*)(up + 12) = su3; }
        wave_lds_sync();
        for (int t0 = 0; t0 < ntok; t0 += 16) {
            const int nt = (ntok - t0) < 16 ? (ntok - t0) : 16;
            {
                const f32x4 uA = *(const f32x4*)(us + (t0 + ch) * 16 + tsub * 4);
#pragma unroll
                for (int cb = 0; cb < 8; ++cb) {
                    f32x4 xv = (f32x4){0.f, 0.f, 0.f, 0.f};
#pragma unroll
                    for (int q = 0; q < 4; ++q) xv = __builtin_amdgcn_mfma_f32_16x16x4f32(uA[q], bX[cb][q], xv, 0, 0, 0);
#pragma unroll
                    for (int j = 0; j < 4; ++j) hb[(tsub * 4 + j) * 132 + cb * 16 + ch] = xv[j];
                }
            }
            wave_lds_sync();
            for (int tb = 0; tb < nt; tb += 4) {
                f32x2 xq[4];
#pragma unroll
                for (int tt = 0; tt < 4; ++tt) xq[tt] = *(const f32x2*)(hb + (tb + tt) * 132 + lane * 2);
#pragma unroll
                for (int tt = 0; tt < 4; ++tt) {
                    const float nr = lbr * hr - lbi * hi + xq[tt][0], ni = lbr * hi + lbi * hr + xq[tt][1]; hr = nr; hi = ni;
                    *(f32x2*)(hb + (tb + tt) * 132 + lane * 2) = (f32x2){hr, hi};
                }
            }
            wave_lds_sync();
            {
                f32x4 hA[8];
#pragma unroll
                for (int e = 0; e < 8; ++e) hA[e] = *(const f32x4*)(hb + ch * 132 + tsub * 32 + e * 4);
                f32x4 yv = (f32x4){0.f, 0.f, 0.f, 0.f};
#pragma unroll
                for (int e = 0; e < 8; ++e)
#pragma unroll
                    for (int q = 0; q < 4; ++q) yv = __builtin_amdgcn_mfma_f32_16x16x4f32(hA[e][q], cB[e * 4 + q], yv, 0, 0, 0);
#pragma unroll
                for (int j = 0; j < 4; ++j) {
                    const int t = tsub * 4 + j;
                    if (t < nt) {
                        const int row = row0 + t0 + t;
                        const float uval = us[(t0 + t) * 16 + ch];
                        const float y = yv[j] + dsk * uval;
                        const float inner = 0.7978845608028654f * (y + 0.044715f * y * y * y);
                        const float e2 = __expf(2.0f * inner);
                        const float th = 1.0f - 2.0f * __builtin_amdgcn_rcpf(e2 + 1.0f);
                        const float z = 0.5f * y * (1.0f + th);
                        p->Z[(size_t)row * 512 + g * 16 + ch] = (bf16_t)(cvt_pk_bf16(z, 0.f) & 0xffffu);
                    }
                }
            }
            wave_lds_sync();
        }
        if (item >= 8192) { p->out[OFF_SRS + (size_t)sb * 2048 + gn] = hr; p->out[OFF_SIS + (size_t)sb * 2048 + gn] = hi; }
        else if ((item >> 5) == 255) { p->out[OFF_SRP + gn] = hr; p->out[OFF_SIP + gn] = hi; }
    }
}

__device__ __forceinline__ void xattn_prompt_item(PP p, int item, int lane) {
    const int fr = lane & 15, fq = lane >> 4;
    const int h = item & 3, q0 = (item >> 2) * 16;
    bf16x8 Qf[8];
#pragma unroll
    for (int ks = 0; ks < 8; ++ks) Qf[ks] = *(const bf16x8*)(p->XQ + (size_t)(q0 + fr) * DM + h * 256 + ks * 32 + fq * 8);
    const bf16_t* kbase = p->MK + (size_t)((fr >> 2) * 8 + (fr & 3)) * DM + h * 256 + fq * 8;
    f32x4 S[16];
    bf16x8 Kf[2][8];
#pragma unroll
    for (int ks = 0; ks < 8; ++ks) Kf[0][ks] = *(const bf16x8*)(kbase + ks * 32);
#pragma unroll
    for (int kb = 0; kb < 16; ++kb) {
        if (kb + 1 < 16) {
            const bf16_t* kp = kbase + (size_t)(((kb + 1) >> 1) * 32 + ((kb + 1) & 1) * 4) * DM;
#pragma unroll
            for (int ks = 0; ks < 8; ++ks) Kf[(kb + 1) & 1][ks] = *(const bf16x8*)(kp + ks * 32);
        }
        __builtin_amdgcn_sched_barrier(0);
        S[kb] = (f32x4){0.f, 0.f, 0.f, 0.f};
#pragma unroll
        for (int ks = 0; ks < 8; ++ks) S[kb] = __builtin_amdgcn_mfma_f32_16x16x32_bf16(Kf[kb & 1][ks], Qf[ks], S[kb], 0, 0, 0);
        __builtin_amdgcn_sched_barrier(0);
    }
    float mx = -1e30f;
#pragma unroll
    for (int kb = 0; kb < 16; ++kb)
#pragma unroll
        for (int j = 0; j < 4; ++j) mx = fmaxf(mx, S[kb][j]);
    mx = fmaxf(mx, __shfl_xor(mx, 16)); mx = fmaxf(mx, __shfl_xor(mx, 32));
    float l = 0.f;
#pragma unroll
    for (int kb = 0; kb < 16; ++kb)
#pragma unroll
        for (int j = 0; j < 4; ++j) { S[kb][j] = __expf(S[kb][j] - mx); l += S[kb][j]; }
    l += __shfl_xor(l, 16); l += __shfl_xor(l, 32);
    const float inv = 1.0f / l;
    bf16x8 Pf[8];
#pragma unroll
    for (int kk = 0; kk < 8; ++kk) {
        u32x4 pw; pw.x = cvt_pk_bf16(S[2 * kk][0] * inv, S[2 * kk][1] * inv); pw.y = cvt_pk_bf16(S[2 * kk][2] * inv, S[2 * kk][3] * inv);
        pw.z = cvt_pk_bf16(S[2 * kk + 1][0] * inv, S[2 * kk + 1][1] * inv); pw.w = cvt_pk_bf16(S[2 * kk + 1][2] * inv, S[2 * kk + 1][3] * inv);
        Pf[kk] = __builtin_bit_cast(bf16x8, pw);
    }
    const bf16_t* vbase = p->MVt + (size_t)(h * 256 + fr) * 256 + fq * 8;
    bf16x8 Vf[2][4][4];
#pragma unroll
    for (int k4 = 0; k4 < 4; ++k4)
#pragma unroll
        for (int db = 0; db < 4; ++db) Vf[0][k4][db] = *(const bf16x8*)(vbase + (size_t)db * 16 * 256 + k4 * 32);
    f32x4 Oa[4];
#pragma unroll
    for (int bt = 0; bt < 8; ++bt) {
        const int dh = bt >> 1, kh = bt & 1;
        if (bt + 1 < 8) {
            const int dh1 = (bt + 1) >> 1, kh1 = (bt + 1) & 1;
#pragma unroll
            for (int k4 = 0; k4 < 4; ++k4)
#pragma unroll
                for (int db = 0; db < 4; ++db) Vf[(bt + 1) & 1][k4][db] = *(const bf16x8*)(vbase + (size_t)(dh1 * 64 + db * 16) * 256 + (kh1 * 4 + k4) * 32);
        }
        __builtin_amdgcn_sched_barrier(0);
        if (kh == 0) {
#pragma unroll
            for (int db = 0; db < 4; ++db) Oa[db] = (f32x4){0.f, 0.f, 0.f, 0.f};
        }
#pragma unroll
        for (int k4 = 0; k4 < 4; ++k4)
#pragma unroll
            for (int db = 0; db < 4; ++db) Oa[db] = __builtin_amdgcn_mfma_f32_16x16x32_bf16(Vf[bt & 1][k4][db], Pf[kh * 4 + k4], Oa[db], 0, 0, 0);
        if (kh == 1) {
#pragma unroll
            for (int db = 0; db < 4; ++db) {
                u32x2 w; w.x = cvt_pk_bf16(Oa[db][0], Oa[db][1]); w.y = cvt_pk_bf16(Oa[db][2], Oa[db][3]);
                *(u32x2*)(p->XO + (size_t)(q0 + fr) * DM + h * 256 + dh * 64 + db * 16 + fq * 4) = w;
            }
        }
        __builtin_amdgcn_sched_barrier(0);
    }
}
__device__ __forceinline__ void xattn_prompt_block(PP p, unsigned char* smem, int item) {
    const int tid = opaque_tid(), wid = tid >> 6, lane = tid & 63, fr = lane & 15, fq = lane >> 4;
    const int h = item & 3, q0 = (item >> 2) * 128 + wid * 16;
    bf16_t* L = (bf16_t*)smem;
    bf16x8 Qf[8];
#pragma unroll
    for (int ks = 0; ks < 8; ++ks) Qf[ks] = *(const bf16x8*)(p->XQ + (size_t)(q0 + fr) * DM + h * 256 + ks * 32 + fq * 8);
    f32x4 S[16];
#pragma unroll
    for (int kb = 0; kb < 16; ++kb) S[kb] = (f32x4){0.f, 0.f, 0.f, 0.f};
    u32x4 stg[4];
    const bf16_t* ksrc = p->MK + (size_t)(tid >> 5) * DM + h * 256 + (tid & 31) * 8;
    bf16_t* kdst = L + (tid >> 5) * 264 + (tid & 31) * 8;
#pragma unroll
    for (int j = 0; j < 4; ++j) stg[j] = *(const u32x4*)(ksrc + (size_t)(16 * j) * DM);
    const int krow = (fr >> 2) * 8 + (fr & 3);
#pragma unroll 1
    for (int ck = 0; ck < 4; ++ck) {
        __syncthreads();
#pragma unroll
        for (int j = 0; j < 4; ++j) *(u32x4*)(kdst + (16 * j) * 264) = stg[j];
        __syncthreads();
        if (ck < 3) {
#pragma unroll
            for (int j = 0; j < 4; ++j) stg[j] = *(const u32x4*)(ksrc + (size_t)((ck + 1) * 64 + 16 * j) * DM);
        }
#pragma unroll
        for (int b = 0; b < 4; ++b) {
            const bf16_t* kp = L + ((b >> 1) * 32 + (b & 1) * 4 + krow) * 264 + fq * 8;
            f32x4 acc = (f32x4){0.f, 0.f, 0.f, 0.f};
#pragma unroll
            for (int ks = 0; ks < 8; ++ks) acc = __builtin_amdgcn_mfma_f32_16x16x32_bf16(*(const bf16x8*)(kp + ks * 32), Qf[ks], acc, 0, 0, 0);
#pragma unroll
            for (int c4 = 0; c4 < 4; ++c4) if (c4 == ck) S[c4 * 4 + b] = acc;
        }
    }
    float mx = -1e30f;
#pragma unroll
    for (int kb = 0; kb < 16; ++kb)
#pragma unroll
        for (int j = 0; j < 4; ++j) mx = fmaxf(mx, S[kb][j]);
    mx = fmaxf(mx, __shfl_xor(mx, 16)); mx = fmaxf(mx, __shfl_xor(mx, 32));
    float l = 0.f;
#pragma unroll
    for (int kb = 0; kb < 16; ++kb)
#pragma unroll
        for (int j = 0; j < 4; ++j) { S[kb][j] = __expf(S[kb][j] - mx); l += S[kb][j]; }
    l += __shfl_xor(l, 16); l += __shfl_xor(l, 32);
    const float inv = 1.0f / l;
    bf16x8 Pf[8];
#pragma unroll
    for (int kk = 0; kk < 8; ++kk) {
        u32x4 pw; pw.x = cvt_pk_bf16(S[2 * kk][0] * inv, S[2 * kk][1] * inv); pw.y = cvt_pk_bf16(S[2 * kk][2] * inv, S[2 * kk][3] * inv);
        pw.z = cvt_pk_bf16(S[2 * kk + 1][0] * inv, S[2 * kk + 1][1] * inv); pw.w = cvt_pk_bf16(S[2 * kk + 1][2] * inv, S[2 * kk + 1][3] * inv);
        Pf[kk] = __builtin_bit_cast(bf16x8, pw);
    }
    f32x4 Oa[16];
#pragma unroll
    for (int db = 0; db < 16; ++db) Oa[db] = (f32x4){0.f, 0.f, 0.f, 0.f};
    const bf16_t* vsrc = p->MVt + (size_t)(h * 256 + (tid >> 3)) * 256 + (tid & 7) * 8;
    bf16_t* vdst = L + (tid >> 3) * 72 + (tid & 7) * 8;
#pragma unroll
    for (int j = 0; j < 4; ++j) stg[j] = *(const u32x4*)(vsrc + (size_t)(64 * j) * 256);
#pragma unroll 1
    for (int ck = 0; ck < 4; ++ck) {
        __syncthreads();
#pragma unroll
        for (int j = 0; j < 4; ++j) *(u32x4*)(vdst + (64 * j) * 72) = stg[j];
        __syncthreads();
        if (ck < 3) {
#pragma unroll
            for (int j = 0; j < 4; ++j) stg[j] = *(const u32x4*)(vsrc + (size_t)(64 * j) * 256 + (ck + 1) * 64);
        }
        bf16x8 P0 = Pf[0], P1 = Pf[1];
#pragma unroll
        for (int c4 = 1; c4 < 4; ++c4) if (c4 == ck) { P0 = Pf[2 * c4]; P1 = Pf[2 * c4 + 1]; }
#pragma unroll
        for (int db = 0; db < 16; ++db) {
            const bf16_t* vp = L + (db * 16 + fr) * 72 + fq * 8;
            Oa[db] = __builtin_amdgcn_mfma_f32_16x16x32_bf16(*(const bf16x8*)vp, P0, Oa[db], 0, 0, 0);
            Oa[db] = __builtin_amdgcn_mfma_f32_16x16x32_bf16(*(const bf16x8*)(vp + 32), P1, Oa[db], 0, 0, 0);
        }
    }
#pragma unroll
    for (int db = 0; db < 16; ++db) {
        u32x2 w; w.x = cvt_pk_bf16(Oa[db][0], Oa[db][1]); w.y = cvt_pk_bf16(Oa[db][2], Oa[db][3]);
        *(u32x2*)(p->XO + (size_t)(q0 + fr) * DM + h * 256 + db * 16 + fq * 4) = w;
    }
    __syncthreads();
}
__device__ __forceinline__ bf16x8 cvt8(const f32x4 a, const f32x4 b) { u32x4 w; w.x = cvt_pk_bf16(a[0], a[1]); w.y = cvt_pk_bf16(a[2], a[3]); w.z = cvt_pk_bf16(b[0], b[1]); w.w = cvt_pk_bf16(b[2], b[3]); return __builtin_bit_cast(bf16x8, w); }

__device__ __forceinline__ void xattn_sample(PP p, unsigned char* smem) {
    const int tid = opaque_tid(), wid = tid >> 6, lane = tid & 63, fr = lane & 15, fq = lane >> 4;
    float* sc = (float*)smem;
    float* red = (float*)(smem + 8192);
    for (int item = blockIdx.x; item < 512; item += gridDim.x) {
        const int b = item >> 2, h = item & 3;
        {
            bf16x8 Qf[8];
#pragma unroll
            for (int ks = 0; ks < 8; ++ks) Qf[ks] = *(const bf16x8*)(p->XQ + (size_t)(MP + b * 8 + (fr & 7)) * DM + h * 256 + ks * 32 + fq * 8);
            f32x4 Kr[2][16];
#pragma unroll
            for (int kb = 0; kb < 2; ++kb) {
                const float* kp = p->cache_mem_k + (((size_t)b * 256 + wid * 32 + kb * 16 + fr) * 4 + h) * 256 + fq * 8;
#pragma unroll
                for (int ks = 0; ks < 8; ++ks) { Kr[kb][2 * ks] = *(const f32x4*)(kp + ks * 32); Kr[kb][2 * ks + 1] = *(const f32x4*)(kp + ks * 32 + 4); }
            }
            __builtin_amdgcn_sched_barrier(0);
#pragma unroll
            for (int kb = 0; kb < 2; ++kb) {
                f32x4 S = (f32x4){0.f, 0.f, 0.f, 0.f};
#pragma unroll
                for (int ks = 0; ks < 8; ++ks) S = __builtin_amdgcn_mfma_f32_16x16x32_bf16(cvt8(Kr[kb][2 * ks], Kr[kb][2 * ks + 1]), Qf[ks], S, 0, 0, 0);
                if (fr < 8) *(f32x4*)(sc + fr * 256 + wid * 32 + kb * 16 + fq * 4) = S;
            }
        }
        __syncthreads();
        {
            f32x4 v = *(const f32x4*)(sc + wid * 256 + lane * 4);
            float mx = fmaxf(fmaxf(v[0], v[1]), fmaxf(v[2], v[3]));
#pragma unroll
            for (int o = 1; o < 64; o <<= 1) mx = fmaxf(mx, __shfl_xor(mx, o));
            v[0] = __expf(v[0] - mx); v[1] = __expf(v[1] - mx); v[2] = __expf(v[2] - mx); v[3] = __expf(v[3] - mx);
            float l = v[0] + v[1] + v[2] + v[3];
#pragma unroll
            for (int o = 1; o < 64; o <<= 1) l += __shfl_xor(l, o);
            const float inv = 1.0f / l;
            *(f32x4*)(sc + wid * 256 + lane * 4) = v * inv;
        }
        __syncthreads();
        {
            f32x4 acc[8];
#pragma unroll
            for (int q = 0; q < 8; ++q) acc[q] = (f32x4){0.f, 0.f, 0.f, 0.f};
            const float* vp = p->cache_mem_v + (((size_t)b * 256 + wid * 32) * 4 + h) * 256 + lane * 4;
#pragma unroll 8
            for (int kk = 0; kk < 32; ++kk) {
                const f32x4 vv = *(const f32x4*)(vp + (size_t)kk * 1024);
#pragma unroll
                for (int q = 0; q < 8; ++q) { const float pq = sc[q * 256 + wid * 32 + kk]; acc[q] += vv * pq; }
            }
#pragma unroll
            for (int q = 0; q < 8; ++q) *(f32x4*)(red + ((size_t)wid * 8 + q) * 256 + lane * 4) = acc[q];
        }
        __syncthreads();
        {
            const int q = tid >> 6, d = (tid & 63) * 4;
            f32x4 s = (f32x4){0.f, 0.f, 0.f, 0.f};
#pragma unroll
            for (int w = 0; w < 8; ++w) s += *(const f32x4*)(red + ((size_t)w * 8 + q) * 256 + d);
            u32x2 o; o.x = cvt_pk_bf16(s[0], s[1]); o.y = cvt_pk_bf16(s[2], s[3]);
            *(u32x2*)(p->XO + (size_t)(MP + b * 8 + q) * DM + h * 256 + d) = o;
        }
        __syncthreads();
    }
}

__device__ __forceinline__ void final_norm(PP p) {
    const int tid = opaque_tid(), wid = tid >> 6, lane = tid & 63;
    f32x4 gv[4];
#pragma unroll
    for (int i = 0; i < 4; ++i) gv[i] = *(const f32x4*)(p->g_final + i * 256 + lane * 4);
    for (int r = blockIdx.x * 8 + wid; r < MT; r += gridDim.x * 8) {
        const float rs = rstd_of(p->rowss[4 * MT + r]);
#pragma unroll
        for (int i = 0; i < 4; ++i) {
            const f32x4 v = *(const f32x4*)(p->X + (size_t)r * DM + i * 256 + lane * 4);
            *(f32x4*)(p->out + OFF_Y + (size_t)r * DM + i * 256 + lane * 4) = v * rs * gv[i];
        }
    }
}


#ifndef DBG_STOP
#define DBG_STOP -1
#endif
#if DBG_STOP >= 0
__device__ __forceinline__ void dump_bf16(const bf16_t* buf, int rows, int len, float*& dst) {
    const int tid = opaque_tid(), wid = tid >> 6, lane = tid & 63;
    for (int r = blockIdx.x * 8 + wid; r < rows; r += gridDim.x * 8) {
        float s = 0.f; for (int i = lane; i < len; i += 64) s += __uint_as_float(((unsigned)buf[(size_t)r * len + i]) << 16);
        for (int o = 1; o < 64; o <<= 1) s += __shfl_xor(s, o);
        if (lane == 0) dst[r] = s;
    }
    dst += rows;
}
__device__ __forceinline__ void dump_f32(const float* buf, int rows, int len, float*& dst) {
    const int tid = opaque_tid(), wid = tid >> 6, lane = tid & 63;
    for (int r = blockIdx.x * 8 + wid; r < rows; r += gridDim.x * 8) {
        float s = 0.f; for (int i = lane; i < len; i += 64) s += buf[(size_t)r * len + i];
        for (int o = 1; o < 64; o <<= 1) s += __shfl_xor(s, o);
        if (lane == 0) dst[r] = s;
    }
    dst += rows;
}
__device__ __forceinline__ void zero_f32(float* buf, size_t n) { for (size_t i = (size_t)blockIdx.x * 512 + opaque_tid(); i < n; i += (size_t)gridDim.x * 512) buf[i] = 0.f; }
__device__ __forceinline__ void dbg_dump(PP p, int k) {
    float* out = p->out;
    zero_f32(out + OFF_Y, (size_t)MT * DM);
    if (k < 1) { zero_f32(out + OFF_MKP, 2 * 262144); }
    if (k < 3) { zero_f32(out + OFF_WKP, 2 * 16384); for (int b = blockIdx.x; b < 128; b += gridDim.x) for (int i = opaque_tid(); i < 1024; i += 512) { out[OFF_WKS + ((size_t)b * 128 + 120) * 128 + i] = 0.f; out[OFF_WVS + ((size_t)b * 128 + 120) * 128 + i] = 0.f; } }
    if (k < 5) { zero_f32(out + OFF_SRP, 4096); }
    if (k < 6) { zero_f32(out + OFF_SRS, 2 * 262144); }
    asm volatile("s_waitcnt vmcnt(0)" ::: "memory"); __syncthreads();
}
__device__ __forceinline__ void dbg_dump2(PP p, int k) {
    float* dst = p->out + OFF_Y;
    dump_bf16(p->XB, MT, 1024, dst);
    dump_bf16(p->MEMB, 256, 1024, dst);
    dump_bf16(p->Wt1, 5632, 1024, dst); dump_bf16(p->Wt2, 1024, 2816, dst); dump_bf16(p->Wt3, 3328, 1024, dst); dump_bf16(p->Wt4, 1024, 512, dst); dump_bf16(p->Wt5, 2048, 512, dst);
    dump_bf16(p->Wt6, 1024, 1024, dst); dump_bf16(p->Wt7, 1024, 1024, dst); dump_bf16(p->Wtkv, 2048, 1024, dst); dump_bf16(p->Wt8, 1024, 1024, dst); dump_bf16(p->Wt9, 5632, 1024, dst); dump_bf16(p->Wt10, 1024, 2816, dst);
    dump_f32(p->rope, 16392, 64, dst); dump_f32(p->ssmtab, 2304, 32, dst);
    if (k == 1 || k == 2) dump_bf16(p->ACT, MT, DFF, dst);
    if (k >= 2) { dump_f32(p->X, MT, 1024, dst); dump_f32(p->rowss + MT, 4 * MT / 32, 32, dst); }
    if (k >= 3 && k <= 6) { dump_bf16(p->Q, MT, 512, dst); dump_bf16(p->SG, MT, 2048, dst); dump_bf16(p->Kb, MP, 128, dst); }
    if (k >= 3 && k <= 5) { dump_f32(p->U, MT, 512, dst); }
    if (k >= 4) { dump_bf16(p->O, MT, 512, dst); dump_f32(p->Schunk, 256, 4096, dst); dump_bf16(p->MK, 256, 1024, dst); dump_bf16(p->MVt, 1024, 256, dst); }
    if (k >= 5) { dump_f32(p->TMP, MT, 1024, dst); dump_f32(p->Carry, 256, 4096, dst); }
    if (k >= 6) { dump_bf16(p->Z, MT, 512, dst); }
    if (k >= 7) { dump_bf16(p->MERGED, MT, 1024, dst); }
    if (k >= 9 && k <= 11) { dump_bf16(p->XQ, MT, 1024, dst); }
    if (k == 10 || k == 11) { dump_bf16(p->XO, MT, 1024, dst); }
    if (k == 12 || k == 13) dump_bf16(p->ACT, MT, DFF, dst);
}
#define DBG_CHECK(k) do { if (DBG_STOP == (k)) { dbg_dump(get_pp(), (k)); GSYNC(); dbg_dump2(get_pp(), (k)); return; } } while (0)
#else
#define DBG_CHECK(k) do { } while (0)
#endif

__global__ void __launch_bounds__(512, 2) fwd_megakernel(Params kernarg_params) {
    extern __shared__ __attribute__((aligned(16))) unsigned char smem[];
    LAS unsigned char* lds = (LAS unsigned char*)smem;
    cg::grid_group grid = cg::this_grid();
    const int G = gridDim.x, c = blockIdx.x;
    { unsigned* bar0 = get_pp()->bar; if (blockIdx.x == 0) for (int i = threadIdx.x; i < XCD_BAR_WORDS; i += 512) bar0[i] = 0u; }
    { PP p = get_pp(); phase_prep(p, smem); }
    asm volatile("s_waitcnt vmcnt(0) lgkmcnt(0)" ::: "memory");
    grid.sync();
    __builtin_amdgcn_fence(__ATOMIC_ACQUIRE, "agent");
    asm volatile("s_waitcnt vmcnt(0)" ::: "memory");
    { unsigned* bar0 = get_pp()->bar; if (threadIdx.x == 0) { volatile LAS unsigned* st = (volatile LAS unsigned*)(lds + 131072); st[0] = 0u; st[1] = 0u; (void)xb_add(&bar0[XB_XCNT(xb_xcc_id())], 1u); } }
    __syncthreads();
    DBG_CHECK(0);
    {
        PP p = get_pp();
        pg8::Gemm g{p->XB, p->Wt1, MT, 5632, 1024}; pg8::StaticOrder S; S.init(MT, 5632, G, c); EpiSwiglu E{p->ACT, nullptr};
        pg8::gemm_phase(lds, g, S, E);
        if (G < 64) { const int tid = opaque_tid(); conv_weight_set(p, 1, c * 8 + (tid >> 6), G * 8, tid & 63); }
        else if (c >= G - 40 && c < G - 8) { const int tid = opaque_tid(); conv_weight_set(p, 1, (c - (G - 40)) * 8 + (tid >> 6), 32 * 8, tid & 63); }
        if (G < 8) { pg8::Gemm g2{p->MEMB, p->Wtkv, 256, 2048, 1024}; pg8::StaticOrder S2; S2.init(256, 2048, G, c); EpiMemKV E2{p->out, p->rowss + 5 * MT}; pg8::gemm_phase(lds, g2, S2, E2); }
        else if (c >= G - 8) { pg8::Gemm g2{p->MEMB, p->Wtkv, 256, 2048, 1024}; pg8::StaticOrder S2; S2.init(256, 2048, 8, c - (G - 8)); EpiMemKV E2{p->out, p->rowss + 5 * MT}; pg8::gemm_phase(lds, g2, S2, E2); }
    }
    GSYNC();
    DBG_CHECK(1);
    {
        PP p = get_pp();
        pg8::Gemm g{p->ACT, p->Wt2, MP, 1024, 2816}; pg8::StaticOrder S; S.init(MP, 1024, G, c); EpiResid E{p->x_prompt, p->x_sample, p->X, p->XB, p->rowss + MT, 0.5f};
        pg8::gemm_phase(lds, g, S, E);
        { SmallEpi se{}; se.src = p->x_sample; se.X = p->X; se.XB = p->XB; se.rowss_next = p->rowss + MT; se.scale = 0.5f; small_gemm_sample<0>(smem, p->ACT, p->Wt2, 2816, se); }
        prep_ctx(p, c, G);
    }
    GSYNC();
    DBG_CHECK(2);
    {
        PP p = get_pp();
        pg8::Gemm g{p->XB, p->Wt3, MT, 3328, 1024}; pg8::StaticOrder S; S.init(MT, 3328, G, c); EpiWin E{p};
        pg8::gemm_phase(lds, g, S, E);
        if (G <= 148) { const int tid = opaque_tid(); conv_weight_set(p, 2, c * 8 + (tid >> 6), G * 8, tid & 63); prep_tables(p, c, G); }
        else if (c >= 116) { const int tid = opaque_tid(); conv_weight_set(p, 2, (c - 116) * 8 + (tid >> 6), (G - 116) * 8, tid & 63); prep_tables(p, c - 116, G - 116); }
    }
    GSYNC();
    DBG_CHECK(3);
    {
        PP p = get_pp();
        for (int item = c; item < 256; item += G) swa_prompt_block(p, smem, item);
        for (int item = c; item < 256; item += G) swa_sample_block(p, smem, item);
        __syncthreads();
        ssm_pass1(p, smem);
        memkv_convert(p);
    }
    GSYNC();
    DBG_CHECK(4);
    {
        PP p = get_pp();
        pg8::Gemm g{p->O, p->Wt4, MP, 1024, 512}; pg8::StaticOrder S; S.init(MP, 1024, G, c); EpiAttnUp E{p->TMP, p->SG};
        pg8::gemm_phase(lds, g, S, E);
        { SmallEpi se{}; se.TMP = p->TMP; se.SG = p->SG; small_gemm_sample<2>(smem, p->O, p->Wt4, 512, se); }
        ssm_pass3(p, smem, c, G);
    }
    GSYNC();
    DBG_CHECK(6);
    {
        PP p = get_pp();
        pg8::Gemm g{p->Z, p->Wt5, MP, 2048, 512}; pg8::StaticOrder S; S.init(MP, 2048, G, c); EpiSsmGlu E{p->TMP, p->SG, p->MERGED};
        pg8::gemm_phase(lds, g, S, E);
        { SmallEpi se{}; se.TMP = p->TMP; se.SG = p->SG; se.MERGED = p->MERGED; se.ntn = 32; small_gemm_sample<3>(smem, p->Z, p->Wt5, 512, se); }
    }
    GSYNC();
    DBG_CHECK(7);
    {
        PP p = get_pp();
        pg8::Gemm g{p->MERGED, p->Wt6, MP, 1024, 1024}; pg8::StaticOrder S; S.init(MP, 1024, G, c); EpiResid E{p->X, p->X + (size_t)MP * DM, p->X, p->XB, p->rowss + 2 * MT, 1.0f};
        pg8::gemm_phase(lds, g, S, E);
        { SmallEpi se{}; se.src = p->X + (size_t)MP * DM; se.X = p->X; se.XB = p->XB; se.rowss_next = p->rowss + 2 * MT; se.scale = 1.0f; small_gemm_sample<0>(smem, p->MERGED, p->Wt6, 1024, se); }
    }
    GSYNC();
    DBG_CHECK(8);
    {
        PP p = get_pp();
        pg8::Gemm g{p->XB, p->Wt7, MP, 1024, 1024}; pg8::StaticOrder S; S.init(MP, 1024, G, c); EpiXq E{p->XQ, p->rowss + 2 * MT};
        pg8::gemm_phase(lds, g, S, E);
        { SmallEpi se{}; se.rowss = p->rowss + 2 * MT; se.XQ = p->XQ; small_gemm_sample<1>(smem, p->XB, p->Wt7, 1024, se); }
    }
    GSYNC();
    DBG_CHECK(9);
    {
        PP p = get_pp();
#if defined(DBG_NO_XS)
        for (size_t i = (size_t)blockIdx.x * 512 + opaque_tid(); i < (size_t)1024 * 1024; i += (size_t)gridDim.x * 512) p->XO[(size_t)MP * DM + i] = 0;
#else
        xattn_sample(p, smem);
#endif
        for (int item = c; item < 512; item += G) xattn_prompt_block(p, smem, item);
    }
    GSYNC();
    DBG_CHECK(10);
    {
        PP p = get_pp();
        pg8::Gemm g{p->XO, p->Wt8, MP, 1024, 1024}; pg8::StaticOrder S; S.init(MP, 1024, G, c); EpiResid E{p->X, p->X + (size_t)MP * DM, p->X, p->XB, p->rowss + 3 * MT, 1.0f};
        pg8::gemm_phase(lds, g, S, E);
        { SmallEpi se{}; se.src = p->X + (size_t)MP * DM; se.X = p->X; se.XB = p->XB; se.rowss_next = p->rowss + 3 * MT; se.scale = 1.0f; small_gemm_sample<0>(smem, p->XO, p->Wt8, 1024, se); }
    }
    GSYNC();
    DBG_CHECK(11);
    {
        PP p = get_pp();
        pg8::Gemm g{p->XB, p->Wt9, MT, 5632, 1024}; pg8::StaticOrder S; S.init(MT, 5632, G, c); EpiSwiglu E{p->ACT, p->rowss + 3 * MT};
        pg8::gemm_phase(lds, g, S, E);
    }
    GSYNC();
    DBG_CHECK(12);
    {
        PP p = get_pp();
        pg8::Gemm g{p->ACT, p->Wt10, MP, 1024, 2816}; pg8::StaticOrder S; S.init(MP, 1024, G, c); EpiResid E{p->X, p->X + (size_t)MP * DM, p->X, nullptr, p->rowss + 4 * MT, 0.5f};
        pg8::gemm_phase(lds, g, S, E);
        { SmallEpi se{}; se.src = p->X + (size_t)MP * DM; se.X = p->X; se.XB = nullptr; se.rowss_next = p->rowss + 4 * MT; se.scale = 0.5f; small_gemm_sample<0>(smem, p->ACT, p->Wt10, 2816, se); }
    }
    GSYNC();
    DBG_CHECK(13);
    { PP p = get_pp(); final_norm(p); }
}

extern "C" void kernel_launch(void* const* d_in, const int* in_sizes, int n_in, void* d_out, int out_size, void* d_ws, size_t ws_size, hipStream_t stream) {
    static int grid_blocks = 0;
    if (!grid_blocks) {
        int dev = 0, cus = 0, per_cu = 0;
        hipGetDevice(&dev);
        hipDeviceGetAttribute(&cus, hipDeviceAttributeMultiprocessorCount, dev);
        hipFuncSetAttribute((const void*)fwd_megakernel, hipFuncAttributeMaxDynamicSharedMemorySize, LDS_BYTES);
        hipOccupancyMaxActiveBlocksPerMultiprocessor(&per_cu, (const void*)fwd_megakernel, 512, LDS_BYTES);
        if (per_cu < 1) per_cu = 1;
        grid_blocks = cus * per_cu;
    }
    Params p; memset(&p, 0, sizeof(p));
    const float** ins = (const float**)&p;
    for (int i = 0; i < 36; ++i) ins[i] = (const float*)d_in[i];
    p.out = (float*)d_out;
    unsigned char* w = (unsigned char*)d_ws; size_t off = 0;
    auto take = [&](size_t bytes) { unsigned char* r = w + off; off += (bytes + 255) & ~(size_t)255; return r; };
    p.Wt1 = (bf16_t*)take((size_t)5632 * 1024 * 2); p.Wt2 = (bf16_t*)take((size_t)1024 * 2816 * 2); p.Wt3 = (bf16_t*)take((size_t)3328 * 1024 * 2);
    p.Wt4 = (bf16_t*)take((size_t)1024 * 512 * 2); p.Wt5 = (bf16_t*)take((size_t)2048 * 512 * 2); p.Wt6 = (bf16_t*)take((size_t)1024 * 1024 * 2);
    p.Wt7 = (bf16_t*)take((size_t)1024 * 1024 * 2); p.Wtkv = (bf16_t*)take((size_t)2048 * 1024 * 2); p.Wt8 = (bf16_t*)take((size_t)1024 * 1024 * 2);
    p.Wt9 = (bf16_t*)take((size_t)5632 * 1024 * 2); p.Wt10 = (bf16_t*)take((size_t)1024 * 2816 * 2);
    p.XB = (bf16_t*)take((size_t)MT * 1024 * 2);
    {
        unsigned char* ra = take((size_t)MT * DFF * 2);
        p.ACT = (bf16_t*)ra; p.SG = (bf16_t*)ra; p.Q = (bf16_t*)(ra + (size_t)MT * 2048 * 2);
        p.XQ = (bf16_t*)ra; p.XO = (bf16_t*)(ra + (size_t)MT * 1024 * 2);
    }
    p.Kb = (bf16_t*)take((size_t)KROWS * 128 * 2); p.Vt = (bf16_t*)take((size_t)128 * KROWS * 2);
    p.O = (bf16_t*)take((size_t)MT * 512 * 2); p.Z = (bf16_t*)take((size_t)MT * 512 * 2);
    p.MEMB = (bf16_t*)take((size_t)256 * 1024 * 2); p.MK = (bf16_t*)take((size_t)256 * 1024 * 2); p.MVt = (bf16_t*)take((size_t)1024 * 256 * 2);
    p.X = (float*)take((size_t)MT * 1024 * 4); p.TMP = (float*)take((size_t)MT * 1024 * 4);
    p.U = (float*)take((size_t)MT * 512 * 4); p.MERGED = (bf16_t*)p.U;
    p.rowss = (float*)take((size_t)(5 * MT + 256) * 4); p.rope = (float*)take((size_t)16392 * 64 * 4); p.ssmtab = (float*)take((size_t)(8192 + 2048 * 32) * 4);
    p.Schunk = (float*)take((size_t)256 * 2048 * 2 * 4); p.Carry = (float*)take((size_t)256 * 2048 * 2 * 4);
    p.bar = (unsigned*)take(XCD_BAR_WORDS * 4);
    if (off > ws_size) { fprintf(stderr, "kernel_launch: workspace too small (%zu > %zu)\n", off, ws_size); return; }
    void* args[] = {&p};
    hipError_t e = hipLaunchCooperativeKernel((const void*)fwd_megakernel, dim3(grid_blocks), dim3(512), args, LDS_BYTES, stream);
    if (e != hipSuccess) fprintf(stderr, "cooperative launch failed: %s (grid %d)\n", hipGetErrorString(e), grid_blocks);
}
```
